# Optimizing an MI355X kernel written in HIP

```python
import jax
import jax.numpy as jnp
from jax import lax
import numpy as np

D_MODEL = 1024
BATCH = 2
SEQ = 8192
DEPTH = 4
DEC_BATCH = 128
DEC_SEQ = 4
PAST_LEN = 8192
PAGE_SIZE = 128

A_HEADS = 8
A_KV_HEADS = 2
A_GROUP = A_HEADS // A_KV_HEADS
A_HEAD_DIM = 64
WINDOW = 128
A_ROT_DIM = A_HEAD_DIM // 4
ROPE_THETA_A = 500000.0
B_HEADS = 4
B_DK = 128
B_DV = 128
RET_CHUNK = 128
ROPE_THETA_B = 10000.0
EPS = 1e-6

A_WIDTH = A_HEADS * A_HEAD_DIM
A_KV_WIDTH = A_KV_HEADS * A_HEAD_DIM
B_QK_WIDTH = B_HEADS * B_DK
B_V_WIDTH = B_HEADS * B_DV
MIX_WIDTH = A_WIDTH + B_V_WIDTH
SPLITS = (A_WIDTH, A_KV_WIDTH, A_KV_WIDTH, A_WIDTH, B_QK_WIDTH, B_QK_WIDTH, B_V_WIDTH, B_V_WIDTH)
IN_WIDTH = A_WIDTH + 2 * A_KV_WIDTH + A_WIDTH + 2 * B_QK_WIDTH + 2 * B_V_WIDTH

kernel_name = 'hymba_swa_sink_retention_step'


def rms_norm(x, g=None):
    xf = x.astype(jnp.float32)
    y = xf * lax.rsqrt(jnp.mean(xf * xf, axis=-1, keepdims=True) + EPS)
    if g is not None:
        y = y * g.astype(jnp.float32)
    return y.astype(x.dtype)


def rotary(x, pos, rot_dim, theta):
    half = rot_dim // 2
    inv_freq = theta ** (-jnp.arange(half, dtype=jnp.float32) / half)
    ang = pos.astype(jnp.float32)[:, None] * inv_freq[None, :]
    cos = jnp.cos(ang)[:, None, :]
    sin = jnp.sin(ang)[:, None, :]
    xr = x[..., :rot_dim].astype(jnp.float32)
    x1, x2 = xr[..., :half], xr[..., half:]
    rot = jnp.concatenate([x1 * cos - x2 * sin, x2 * cos + x1 * sin], axis=-1)
    return jnp.concatenate([rot.astype(x.dtype), x[..., rot_dim:]], axis=-1)


def project(x, pos, w_in, norm_g, q_norm_g, k_norm_g):
    N, T, _ = x.shape
    h = rms_norm(x, norm_g)
    p = jnp.einsum('ntd,de->nte', h, w_in)
    offs = np.cumsum(SPLITS)[:-1].tolist()
    qa, ka, va, ga, qb, kb, vb, gb = jnp.split(p, offs, axis=-1)
    qa = rotary(rms_norm(qa.reshape(N, T, A_HEADS, A_HEAD_DIM), q_norm_g), pos, A_ROT_DIM, ROPE_THETA_A)
    ka = rotary(rms_norm(ka.reshape(N, T, A_KV_HEADS, A_HEAD_DIM), k_norm_g), pos, A_ROT_DIM, ROPE_THETA_A)
    va = va.reshape(N, T, A_KV_HEADS, A_HEAD_DIM)
    qb = rotary(qb.reshape(N, T, B_HEADS, B_DK), pos, B_DK, ROPE_THETA_B)
    kb = rotary(kb.reshape(N, T, B_HEADS, B_DK), pos, B_DK, ROPE_THETA_B) * (B_DK ** -0.5)
    vb = vb.reshape(N, T, B_HEADS, B_DV)
    return qa, ka, va, ga, qb, kb, vb, gb


def attend_with_sinks(q, kk, vv, mask, sinks):
    s = jnp.einsum('...qgrd,...kgd->...grqk', q, kk, preferred_element_type=jnp.float32) * (A_HEAD_DIM ** -0.5)
    s = jnp.where(mask, s, -jnp.inf)
    sk = sinks.astype(jnp.float32).reshape(A_KV_HEADS, A_GROUP)[:, :, None, None]
    m = jnp.maximum(jnp.max(s, axis=-1, keepdims=True), sk)
    p = jnp.exp(s - m)
    denom = jnp.sum(p, axis=-1, keepdims=True) + jnp.exp(sk - m)
    p = (p / denom).astype(vv.dtype)
    return jnp.einsum('...grqk,...kgd->...qgrd', p, vv)


def swa_prompt(qa, ka, va, sinks):
    N, T = qa.shape[:2]
    nb = T // WINDOW
    qblk = qa.reshape(N, nb, WINDOW, A_KV_HEADS, A_GROUP, A_HEAD_DIM)
    kblk = ka.reshape(N, nb, WINDOW, A_KV_HEADS, A_HEAD_DIM)
    vblk = va.reshape(N, nb, WINDOW, A_KV_HEADS, A_HEAD_DIM)
    kk = jnp.concatenate([jnp.concatenate([jnp.zeros_like(kblk[:, :1]), kblk[:, :-1]], axis=1), kblk], axis=2)
    vv = jnp.concatenate([jnp.concatenate([jnp.zeros_like(vblk[:, :1]), vblk[:, :-1]], axis=1), vblk], axis=2)
    qi = jnp.arange(WINDOW)[:, None] + WINDOW
    kj = jnp.arange(2 * WINDOW)[None, :]
    diff = qi - kj
    band = (diff >= 0) & (diff < WINDOW)
    has_prev = (jnp.arange(nb) > 0)[:, None, None] | (kj >= WINDOW)[None]
    mask = (band[None] & has_prev)[:, None, None]
    o = attend_with_sinks(qblk, kk, vv, mask, sinks)
    return o.reshape(N, T, A_WIDTH)


def swa_sample(qa, ka, va, cache_k, cache_v, sinks):
    N, T = qa.shape[:2]
    w_buf = cache_k.shape[1]
    kk = jnp.concatenate([cache_k.astype(ka.dtype), ka], axis=1)
    vv = jnp.concatenate([cache_v.astype(va.dtype), va], axis=1)
    diff = jnp.arange(T)[:, None] + w_buf - jnp.arange(w_buf + T)[None, :]
    mask = (diff >= 0) & (diff < WINDOW)
    o = attend_with_sinks(qa.reshape(N, T, A_KV_HEADS, A_GROUP, A_HEAD_DIM), kk, vv, mask, sinks)
    return o.reshape(N, T, A_WIDTH), kk[:, -w_buf:], vv[:, -w_buf:]


def retention_log_decay():
    return jnp.log(1.0 - 2.0 ** (-5.0 - jnp.arange(B_HEADS, dtype=jnp.float32)))


def retention_chunk(S, q, k, v):
    C = q.shape[1]
    lg = retention_log_decay()
    idx = jnp.arange(C, dtype=jnp.float32)
    diff = idx[:, None] - idx[None, :]
    decay = jnp.where(diff >= 0, jnp.exp(lg[:, None, None] * jnp.maximum(diff, 0.0)), 0.0)
    qf = q.astype(jnp.float32)
    kf = k.astype(jnp.float32)
    vf = v.astype(jnp.float32)
    scores = jnp.einsum('nihd,njhd->nhij', qf, kf) * decay
    inner = jnp.einsum('nhij,njhv->nihv', scores, vf)
    q_dec = jnp.exp(lg[None, :] * (idx[:, None] + 1.0))
    cross = jnp.einsum('nihd,nhdv->nihv', qf, S) * q_dec[None, :, :, None]
    k_dec = jnp.exp(lg[None, :] * (C - 1.0 - idx[:, None]))
    S_new = jnp.exp(lg * C)[None, :, None, None] * S + jnp.einsum('njhd,njhv->nhdv', kf * k_dec[None, :, :, None], vf)
    return S_new, inner + cross


def retention_prompt(qb, kb, vb):
    N, T = qb.shape[:2]
    C = min(RET_CHUNK, T)
    nc = T // C

    def to_chunks(a):
        return a.reshape(N, nc, C, *a.shape[2:]).swapaxes(0, 1)

    S0 = jnp.zeros((N, B_HEADS, B_DK, B_DV), jnp.float32)
    S, o = lax.scan(lambda S, xs: retention_chunk(S, *xs), S0, (to_chunks(qb), to_chunks(kb), to_chunks(vb)))
    return o.swapaxes(0, 1).reshape(N, T, B_HEADS, B_DV), S


def merge(x, attn, ret, ga, gb, w_out):
    N, T = x.shape[:2]
    ret = rms_norm(ret).reshape(N, T, B_V_WIDTH).astype(x.dtype)
    mixed = jnp.concatenate([jax.nn.silu(ga) * attn, jax.nn.silu(gb) * ret], axis=-1)
    return x + jnp.einsum('nte,ed->ntd', mixed, w_out)


def setup_inputs(seed: int = 0) -> dict:
    key = jax.random.key(seed)
    ks = jax.random.split(key, 11)
    w_buf = min(WINDOW, PAST_LEN)
    f32 = jnp.float32
    return {
        'x_prompt': jax.random.normal(ks[0], (BATCH, SEQ, D_MODEL), f32),
        'x_sample': jax.random.normal(ks[1], (DEC_BATCH, DEC_SEQ, D_MODEL), f32),
        'cache_swa_k': jax.random.normal(ks[2], (DEPTH, DEC_BATCH, w_buf, A_KV_HEADS, A_HEAD_DIM), f32),
        'cache_swa_v': jax.random.normal(ks[3], (DEPTH, DEC_BATCH, w_buf, A_KV_HEADS, A_HEAD_DIM), f32),
        'state_ret': 0.5 * jax.random.normal(ks[4], (DEPTH, DEC_BATCH, B_HEADS, B_DK, B_DV), f32),
        'w_in': jax.random.normal(ks[5], (DEPTH, D_MODEL, IN_WIDTH), f32) * (D_MODEL ** -0.5),
        'w_out': jax.random.normal(ks[6], (DEPTH, MIX_WIDTH, D_MODEL), f32) * (MIX_WIDTH ** -0.5),
        'norm_g': 1.0 + 0.02 * jax.random.normal(ks[7], (DEPTH, D_MODEL), f32),
        'q_norm_g': 1.0 + 0.02 * jax.random.normal(ks[8], (DEPTH, A_HEAD_DIM), f32),
        'k_norm_g': 1.0 + 0.02 * jax.random.normal(ks[9], (DEPTH, A_HEAD_DIM), f32),
        'sinks': 0.5 * jax.random.normal(ks[10], (DEPTH, A_HEADS), f32),
    }


def reference(x_prompt, x_sample, cache_swa_k, cache_swa_v, state_ret, w_in, w_out, norm_g, q_norm_g, k_norm_g, sinks):
    pos_p = jnp.arange(x_prompt.shape[1], dtype=jnp.int32)
    pos_s = PAST_LEN + jnp.arange(x_sample.shape[1], dtype=jnp.int32)
    w_p = min(WINDOW, x_prompt.shape[1])
    xp, xs = x_prompt, x_sample
    kp_l, vp_l, sp_l, ks_l, vs_l, ss_l = [], [], [], [], [], []
    for l in range(DEPTH):
        qa, ka, va, ga, qb, kb, vb, gb = project(xp, pos_p, w_in[l], norm_g[l], q_norm_g[l], k_norm_g[l])
        attn = swa_prompt(qa, ka, va, sinks[l])
        ret, S = retention_prompt(qb, kb, vb)
        xp = merge(xp, attn, ret, ga, gb, w_out[l])
        kp_l.append(ka[:, -w_p:])
        vp_l.append(va[:, -w_p:])
        sp_l.append(S.astype(xp.dtype))
        qa, ka, va, ga, qb, kb, vb, gb = project(xs, pos_s, w_in[l], norm_g[l], q_norm_g[l], k_norm_g[l])
        attn, k_buf, v_buf = swa_sample(qa, ka, va, cache_swa_k[l], cache_swa_v[l], sinks[l])
        S, ret = retention_chunk(state_ret[l].astype(jnp.float32), qb, kb, vb)
        xs = merge(xs, attn, ret, ga, gb, w_out[l])
        ks_l.append(k_buf)
        vs_l.append(v_buf)
        ss_l.append(S.astype(xs.dtype))
    return (xp, xs, jnp.stack(kp_l), jnp.stack(vp_l), jnp.stack(sp_l), jnp.stack(ks_l), jnp.stack(vs_l), jnp.stack(ss_l))
```

```cpp
#include <hip/hip_runtime.h>
#include <hip/hip_cooperative_groups.h>
#include <cstdio>
#include <cstdint>
#include <cmath>
namespace cg = cooperative_groups;

#ifndef MK_MULTI
#define MK_MULTI 0
#endif

#ifndef REP_P0
#define REP_P0 1
#endif
#ifndef REP_P1
#define REP_P1 1
#endif
#ifndef REP_P2
#define REP_P2 1
#endif
#ifndef REP_P3
#define REP_P3 1
#endif
#ifndef REP_P4
#define REP_P4 1
#endif
#ifndef REP_P5
#define REP_P5 1
#endif
#define LAS __attribute__((address_space(3)))
typedef unsigned short bf16_t;
typedef short bf16x8 __attribute__((ext_vector_type(8)));
typedef float f32x4 __attribute__((ext_vector_type(4)));
typedef float f32x2 __attribute__((ext_vector_type(2)));
typedef unsigned u32x4 __attribute__((ext_vector_type(4)));
typedef unsigned u32x2 __attribute__((ext_vector_type(2)));

constexpr int DM = 1024, SEQ = 8192, NBATCH = 2, MP = NBATCH * SEQ, MS = 512, MT = MP + MS, NIN = 3328, DEPTH = 4;
constexpr int NPOS = 8196;
constexpr float LOG2E = 1.4426950408889634f;
constexpr size_t O_Y = 0, O_KP = 17301504, O_VP = 17432576, O_SP = 17563648, O_KS = 18087936, O_VS = 26476544, O_SS = 34865152;
constexpr size_t MiB = 1u << 20;
constexpr size_t WS_ROWSS = 1 * MiB, WS_TABB = 2 * MiB, WS_TABA = 7 * MiB, WS_WIN = 8 * MiB, WS_WOUT = 36 * MiB, WS_XB = 44 * MiB, WS_MIX = 80 * MiB,
                 WS_P = 116 * MiB, WS_UT = 224 * MiB, WS_SPT = 256 * MiB, WS_XB2 = 272 * MiB, WS_DUMMY = 308 * MiB, WS_END = 312 * MiB;
constexpr int LDS_BYTES = 147456;

__device__ __forceinline__ unsigned pk(float lo, float hi) { unsigned r; asm("v_cvt_pk_bf16_f32 %0, %1, %2" : "=v"(r) : "v"(lo), "v"(hi)); return r; }
__device__ __forceinline__ float bflo(unsigned u) { return __uint_as_float(u << 16); }
__device__ __forceinline__ float bfhi(unsigned u) { return __uint_as_float(u & 0xffff0000u); }
__device__ __forceinline__ float bf2f(bf16_t h) { return __uint_as_float((unsigned)h << 16); }
__device__ __forceinline__ float ex2(float x) { return __builtin_amdgcn_exp2f(x); }
__device__ __forceinline__ float shx(float v, int m, int lane) { return __builtin_bit_cast(float, __builtin_amdgcn_ds_bpermute(((lane ^ m) & 63) << 2, __builtin_bit_cast(int, v))); }
__device__ __forceinline__ int shxi(int v, int m, int lane) { return __builtin_amdgcn_ds_bpermute(((lane ^ m) & 63) << 2, v); }
__device__ __forceinline__ float l2gamma(int h) { const int hb = __builtin_amdgcn_readfirstlane(h); const unsigned b = hb == 0 ? 0xbd3b9ca6u : hb == 1 ? 0xbcba1f74u : hb == 2 ? 0xbc3963ddu : 0xbbb906ceu; return __builtin_bit_cast(float, b); }

namespace pg8 {
constexpr int BM = 256, BK = 64, HALF = 128, HTB = HALF * BK * 2, STAGE_BYTES = 8 * HTB, NXCD = 8, WGM = 8;
__host__ __device__ __forceinline__ int lds_byte(int r, int c) { const int st = (r >> 4) * 2 + (c >> 5), rr = r & 15, cc = c & 31, ob = rr * 64 + cc * 2; return st * 1024 + (ob ^ (((ob >> 9) & 1) << 5)); }
__host__ __device__ __forceinline__ void stage_rc(int b, int& R, int& C) { const int st = b / 1024, sb = b % 1024, swz = sb ^ (((sb >> 9) & 1) << 5); R = (st >> 1) * 16 + swz / 64; C = (st & 1) * 32 + (swz % 64) / 2; }
struct Unit { int pm, pn; };
struct Gemm { const bf16_t* A; const bf16_t* Bt; int M, N, K; };
struct StaticOrder {
    int nM, nN, nwg, G, c;
    __host__ __device__ void init(int M, int N, int G_, int c_) { nM = M / BM; nN = N / BM; nwg = nM * nN; G = G_; c = c_; }
    __host__ __device__ bool next(int i, Unit& u) const {
        const long L = (long)i * G + c; if (L >= nwg) return false;
        int wgid = (int)L; { const int q = nwg / NXCD, r = nwg % NXCD, xcd = wgid % NXCD, off = wgid / NXCD; wgid = (xcd < r ? xcd * (q + 1) : r * (q + 1) + (xcd - r) * q) + off; }
        const int nig = WGM * nN, gid = wgid / nig, fm = gid * WGM, gsz = (nM - fm) < WGM ? (nM - fm) : WGM;
        u.pm = fm + ((wgid % nig) % gsz); u.pn = (wgid % nig) / gsz; return true;
    }
    __device__ __forceinline__ void a_ready(const Unit&) const {}
    __device__ __forceinline__ void done(const Unit&) const {}
};

template <class Epi, class Sched, bool ALIGN_EPI = false, bool SP2 = false>
__device__ __forceinline__ void gemm_phase(LAS unsigned char* lds, const Gemm g, const Sched& S, const Epi& E, const int tid) {
    const int wid = __builtin_amdgcn_readfirstlane(tid >> 6), lane = tid & 63, wr = wid >> 2, wc = wid & 3, fr = lane & 15, fq = lane >> 4;
    const int K = g.K, nt = K / BK;
    unsigned voffA[2], voffB[2];
#pragma unroll
    for (int i = 0; i < 2; ++i) { int R, C; stage_rc(tid * 16 + i * 8192, R, C); voffA[i] = (unsigned)(R * K + C) * 2u; voffB[i] = voffA[i]; }
    const size_t kstep = (size_t)(BK * 2);
    const size_t hstep = (size_t)HALF * K * 2;
    const size_t tstep = 2 * hstep;
    const unsigned ldsw = (unsigned)wid * 1024u;
    const int aoff = lds_byte(wr * 64 + fr, fq * 8), boff = lds_byte(wc * 32 + fr, fq * 8);
#define PG8_SA(b, h) (((b) * 2 + (h)) * HTB)
#define PG8_SB(b, h) ((4 + (b) * 2 + (h)) * HTB)
#define PG8_STAGE(bufoff, gbase, voff) do { _Pragma("unroll") for (int _i = 0; _i < 2; ++_i) \
        __builtin_amdgcn_global_load_lds((const unsigned*)((const char*)(gbase) + (voff)[_i]), (LAS unsigned*)(lds + (bufoff) + ldsw + _i * 8192), 16, 0, 0); } while (0)
#define PG8_LDA(dst, b, h) do { _Pragma("unroll") for (int m = 0; m < 4; ++m) _Pragma("unroll") for (int k = 0; k < 2; ++k) dst[m][k] = *(const LAS bf16x8*)(lds + PG8_SA(b, h) + aoff + m * 2048 + k * 1024); } while (0)
#define PG8_LDB(dst, b, h) do { _Pragma("unroll") for (int n = 0; n < 2; ++n) _Pragma("unroll") for (int k = 0; k < 2; ++k) dst[n][k] = *(const LAS bf16x8*)(lds + PG8_SB(b, h) + boff + n * 2048 + k * 1024); } while (0)
#define PG8_MMA(ai, bj, At, Bt) do { __builtin_amdgcn_s_setprio(1); _Pragma("unroll") for (int m = 0; m < 4; ++m) _Pragma("unroll") for (int n = 0; n < 2; ++n) _Pragma("unroll") for (int k = 0; k < 2; ++k) \
        acc[ai][bj][m][n] = __builtin_amdgcn_mfma_f32_16x16x32_bf16(Bt[n][k], At[m][k], acc[ai][bj][m][n], 0, 0, 0); __builtin_amdgcn_s_setprio(0); } while (0)
#define PG8_WAIT_V(n) asm volatile("s_waitcnt vmcnt(" #n ")" ::: "memory")
#define PG8_WAIT_L(n) asm volatile("s_waitcnt lgkmcnt(" #n ")" ::: "memory")
#define PG8_BAR __builtin_amdgcn_s_barrier()
#define PG8_SCHED __builtin_amdgcn_sched_barrier(0)
    Unit cur, nxt; int ui = 0;
    if (!S.next(0, cur)) return;
    f32x4 acc[2][2][4][2];
#pragma unroll
    for (int a = 0; a < 2; ++a)
#pragma unroll
        for (int b = 0; b < 2; ++b)
#pragma unroll
            for (int m = 0; m < 4; ++m)
#pragma unroll
                for (int n = 0; n < 2; ++n) acc[a][b][m][n] = (f32x4){0.f, 0.f, 0.f, 0.f};
    bf16x8 At[4][2], B0[2][2], B1[2][2];
    const char* cA = (const char*)g.A + (size_t)cur.pm * tstep; const char* cB = (const char*)g.Bt + (size_t)cur.pn * tstep;
    S.a_ready(cur);
    if constexpr (SP2) {
        PG8_STAGE(PG8_SB(0, 0), cB, voffB); PG8_STAGE(PG8_SB(0, 1), cB + hstep, voffB); PG8_STAGE(PG8_SA(0, 0), cA, voffA); PG8_STAGE(PG8_SA(0, 1), cA + hstep, voffA);
        if (wr == 1) PG8_BAR;
        PG8_WAIT_V(2); PG8_BAR;
        PG8_STAGE(PG8_SB(1, 0), cB + kstep, voffB); PG8_STAGE(PG8_SA(1, 0), cA + kstep, voffA); PG8_STAGE(PG8_SB(1, 1), cB + hstep + kstep, voffB);
        PG8_WAIT_V(6); PG8_BAR;
    } else {
        PG8_STAGE(PG8_SB(0, 0), cB, voffB); PG8_STAGE(PG8_SA(0, 0), cA, voffA); PG8_STAGE(PG8_SB(0, 1), cB + hstep, voffB); PG8_STAGE(PG8_SA(0, 1), cA + hstep, voffA);
        if (wr == 1) PG8_BAR;
        PG8_WAIT_V(4); PG8_BAR;
        PG8_STAGE(PG8_SB(1, 0), cB + kstep, voffB); PG8_STAGE(PG8_SA(1, 0), cA + kstep, voffA); PG8_STAGE(PG8_SB(1, 1), cB + hstep + kstep, voffB);
        PG8_WAIT_V(6); PG8_BAR;
    }
    for (;;) {
        const bool has_next = S.next(ui + 1, nxt);
        const char* nA = has_next ? (const char*)g.A + (size_t)nxt.pm * tstep : cA; const char* nB = has_next ? (const char*)g.Bt + (size_t)nxt.pn * tstep : cB;
        for (int t = 0; t < nt; t += 2) {
            const bool last = (t == nt - 2);
            const char* a1 = cA + (size_t)(t + 1) * kstep;
            const char* a2 = last ? nA : cA + (size_t)(t + 2) * kstep; const char* b2 = last ? nB : cB + (size_t)(t + 2) * kstep;
            const char* a3 = a2 + kstep; const char* b3 = b2 + kstep;
            if (last && has_next) S.a_ready(nxt);
            if constexpr (SP2) {
            PG8_LDB(B0, 0, 0); PG8_LDB(B1, 0, 1); PG8_SCHED; PG8_LDA(At, 0, 0); PG8_STAGE(PG8_SA(1, 1), a1 + hstep, voffA);
            PG8_WAIT_V(8); PG8_WAIT_L(0); PG8_BAR; PG8_MMA(0, 0, At, B0); PG8_MMA(0, 1, At, B1); PG8_BAR; PG8_SCHED;
            PG8_LDA(At, 0, 1); PG8_STAGE(PG8_SB(0, 0), b2, voffB); PG8_STAGE(PG8_SB(0, 1), b2 + hstep, voffB); PG8_STAGE(PG8_SA(0, 0), a2, voffA);
            PG8_WAIT_V(8); PG8_WAIT_L(0); PG8_BAR; PG8_MMA(1, 0, At, B0); PG8_MMA(1, 1, At, B1); PG8_BAR; PG8_SCHED;
            PG8_LDB(B0, 1, 0); PG8_LDB(B1, 1, 1); PG8_SCHED; PG8_LDA(At, 1, 0); PG8_STAGE(PG8_SA(0, 1), a2 + hstep, voffA);
            PG8_WAIT_V(8); PG8_WAIT_L(0); PG8_BAR; PG8_MMA(0, 0, At, B0); PG8_MMA(0, 1, At, B1); PG8_BAR; PG8_SCHED;
            PG8_LDA(At, 1, 1); PG8_STAGE(PG8_SB(1, 0), b3, voffB); PG8_STAGE(PG8_SB(1, 1), b3 + hstep, voffB); PG8_STAGE(PG8_SA(1, 0), a3, voffA);
            PG8_WAIT_V(8); PG8_WAIT_L(0); PG8_BAR; PG8_MMA(1, 0, At, B0); PG8_MMA(1, 1, At, B1); PG8_BAR; PG8_SCHED;
            } else {
            PG8_LDB(B0, 0, 0); PG8_SCHED; PG8_LDA(At, 0, 0); PG8_STAGE(PG8_SA(1, 1), a1 + hstep, voffA);
            PG8_WAIT_L(8); PG8_BAR; PG8_WAIT_L(0); PG8_MMA(0, 0, At, B0); PG8_BAR; PG8_SCHED;
            PG8_LDB(B1, 0, 1); PG8_STAGE(PG8_SB(0, 0), b2, voffB);
            PG8_BAR; PG8_WAIT_L(0); PG8_MMA(0, 1, At, B1); PG8_BAR;
            PG8_LDA(At, 0, 1); PG8_STAGE(PG8_SA(0, 0), a2, voffA);
            PG8_BAR; PG8_WAIT_L(0); PG8_MMA(1, 0, At, B0); PG8_BAR; PG8_SCHED;
            PG8_STAGE(PG8_SB(0, 1), b2 + hstep, voffB);
            PG8_WAIT_V(6); PG8_BAR; PG8_MMA(1, 1, At, B1); PG8_BAR;
            PG8_LDB(B0, 1, 0); PG8_SCHED; PG8_LDA(At, 1, 0); PG8_STAGE(PG8_SA(0, 1), a2 + hstep, voffA);
            PG8_WAIT_L(8); PG8_BAR; PG8_WAIT_L(0); PG8_MMA(0, 0, At, B0); PG8_BAR; PG8_SCHED;
            PG8_LDB(B1, 1, 1); PG8_STAGE(PG8_SB(1, 0), b3, voffB);
            PG8_BAR; PG8_WAIT_L(0); PG8_MMA(0, 1, At, B1); PG8_BAR;
            PG8_LDA(At, 1, 1); PG8_STAGE(PG8_SA(1, 0), a3, voffA);
            PG8_BAR; PG8_WAIT_L(0); PG8_MMA(1, 0, At, B0); PG8_BAR; PG8_SCHED;
            PG8_STAGE(PG8_SB(1, 1), b3 + hstep, voffB);
            PG8_WAIT_V(6); PG8_BAR; PG8_MMA(1, 1, At, B1); PG8_BAR;
            }
        }
        if constexpr (ALIGN_EPI) { if (wr == 0) PG8_BAR; }
        E(acc, cur, wr, wc, fr, fq); S.done(cur);
        if (!has_next) break;
#pragma unroll
        for (int a = 0; a < 2; ++a)
#pragma unroll
            for (int b = 0; b < 2; ++b)
#pragma unroll
                for (int m = 0; m < 4; ++m)
#pragma unroll
                    for (int n = 0; n < 2; ++n) acc[a][b][m][n] = (f32x4){0.f, 0.f, 0.f, 0.f};
        cur = nxt; cA = nA; cB = nB; ++ui;
        if constexpr (ALIGN_EPI) { if (wr == 1) PG8_BAR; }
    }
    PG8_WAIT_V(0);
    if constexpr (!ALIGN_EPI) { if (wr == 0) PG8_BAR; }
    PG8_BAR;
#undef PG8_SA
#undef PG8_SB
#undef PG8_STAGE
#undef PG8_LDA
#undef PG8_LDB
#undef PG8_MMA
#undef PG8_WAIT_V
#undef PG8_WAIT_L
#undef PG8_BAR
#undef PG8_SCHED
}
}

__device__ __forceinline__ int colmap_in(int np) {
    const int pn = np >> 8, c = np & 255;
    const int bj = c >> 7, wc = (c >> 5) & 3, n = (c >> 4) & 1, fq = (c >> 2) & 3, j = c & 3;
    const int cnat = 128 * bj + 32 * wc + 8 * fq + 4 * n + j;
    const int d64 = 16 * fq + 8 * bj + 4 * n + j;
    const int d128 = 64 * bj + 32 * (wc & 1) + 8 * fq + 4 * n + j;
    if (pn <= 1) return 64 * (4 * pn + wc) + d64;
    if (pn == 2) return (wc < 2 ? 512 + 64 * wc : 640 + 64 * (wc - 2)) + d64;
    if (pn <= 4) return 768 + 256 * (pn - 3) + cnat;
    if (pn <= 6) return 1280 + 128 * (2 * (pn - 5) + (wc >> 1)) + d128;
    if (pn <= 8) return 1792 + 128 * (2 * (pn - 7) + (wc >> 1)) + d128;
    if (pn <= 10) return 2304 + 256 * (pn - 9) + cnat;
    return 2816 + 256 * (pn - 11) + cnat;
}
__device__ __forceinline__ int colmap_out(int np) {
    const int pn = np >> 8, c = np & 255;
    const int bj = c >> 7, wc = (c >> 5) & 3, n = (c >> 4) & 1, fq = (c >> 2) & 3, j = c & 3;
    return 256 * pn + 128 * bj + 32 * wc + 8 * fq + 4 * n + j;
}

__device__ __forceinline__ int cm_c64(int d, int wc) { return 128 * ((d >> 3) & 1) + 32 * wc + 16 * ((d >> 2) & 1) + 4 * (d >> 4) + (d & 3); }
__device__ __forceinline__ int cm_nat(int x) { return 128 * (x >> 7) + 32 * ((x >> 5) & 3) + 16 * ((x >> 2) & 1) + 4 * ((x >> 3) & 3) + (x & 3); }
__device__ __forceinline__ int cm_c128(int d, int hsel) { return 128 * (d >> 6) + 32 * (2 * hsel + ((d >> 5) & 1)) + 16 * ((d >> 2) & 1) + 4 * ((d >> 3) & 3) + (d & 3); }
__device__ __forceinline__ int colinv_in(int col) {
    if (col < 512) { const int head = col >> 6; return 256 * (head >> 2) + cm_c64(col & 63, head & 3); }
    if (col < 640) { const int o = col - 512; return 512 + cm_c64(o & 63, o >> 6); }
    if (col < 768) { const int o = col - 640; return 512 + cm_c64(o & 63, 2 + (o >> 6)); }
    if (col < 1280) { const int o = col - 768; return 256 * (3 + (o >> 8)) + cm_nat(o & 255); }
    if (col < 1792) { const int o = col - 1280, head = o >> 7; return 256 * (5 + (head >> 1)) + cm_c128(o & 127, head & 1); }
    if (col < 2304) { const int o = col - 1792, head = o >> 7; return 256 * (7 + (head >> 1)) + cm_c128(o & 127, head & 1); }
    if (col < 2816) { const int o = col - 2304; return 256 * (9 + (o >> 8)) + cm_nat(o & 255); }
    const int o = col - 2816; return 256 * (11 + (o >> 8)) + cm_nat(o & 255);
}
__device__ __forceinline__ int colinv_out(int col) { return 256 * (col >> 8) + cm_nat(col & 255); }
struct EpiIn {
    bf16_t* P; const float* rowss; const float* qg; const float* kg; const float* tabA; const float* tabB;
    float* kp; float* vp; float* ks; float* vs;
    __device__ __forceinline__ void operator()(const f32x4 (&acc)[2][2][4][2], const pg8::Unit& u, int wr, int wc, int fr, int fq) const {
        const int pn = u.pn;
        const int rowb = u.pm * 256 + wr * 64 + fr;
        float rr[2][4];
#pragma unroll
        for (int ai = 0; ai < 2; ++ai)
#pragma unroll
            for (int m = 0; m < 4; ++m) rr[ai][m] = rowss[rowb + ai * 128 + m * 16];
        if (pn <= 2) {
            const bool isv = (pn == 2 && wc >= 2), isk = (pn == 2 && wc < 2);
            const int head = (pn == 2) ? (wc & 1) : 4 * pn + wc;
            const int colbase = ((pn == 2) ? (isv ? 640 : 512) : 0) + 64 * head + 16 * fq;
            const float* gp = isk ? kg : qg;
#pragma unroll
            for (int am = 0; am < 4; ++am) {
                const int ai = am >> 1;
                f32x4 ca[4][2], sa[4][2];
                if (!isv) {
#pragma unroll
                    for (int m = 2 * (am & 1); m < 2 * (am & 1) + 2; ++m) {
                        const int row = rowb + ai * 128 + m * 16;
                        const int pos = (row < MP) ? (row & 8191) : (8192 + ((row - MP) & 3));
#pragma unroll
                        for (int n = 0; n < 2; ++n) { ca[m][n] = *(const f32x4*)(tabA + pos * 16 + 4 * n); sa[m][n] = *(const f32x4*)(tabA + pos * 16 + 8 + 4 * n); }
                    }
                }
#pragma unroll
                for (int m = 2 * (am & 1); m < 2 * (am & 1) + 2; ++m) {
                    const int row = rowb + ai * 128 + m * 16;
                    const float r = rsqrtf(rr[ai][m] * (1.0f / 1024.0f) + 1e-6f);
                    const int pos = (row < MP) ? (row & 8191) : (8192 + ((row - MP) & 3));
                    f32x4 v[2][2];
#pragma unroll
                    for (int bj = 0; bj < 2; ++bj)
#pragma unroll
                        for (int n = 0; n < 2; ++n) v[bj][n] = acc[ai][bj][m][n] * r;
                    if (!isv) {
                        float ss = 0.f;
#pragma unroll
                        for (int bj = 0; bj < 2; ++bj)
#pragma unroll
                            for (int n = 0; n < 2; ++n) { const f32x4 x = v[bj][n]; ss += (x[0] * x[0] + x[1] * x[1]) + (x[2] * x[2] + x[3] * x[3]); }
                        ss += shx(ss, 16, (fq * 16 + fr)); ss += shx(ss, 32, (fq * 16 + fr));
                        const float rn = rsqrtf(ss * (1.0f / 64.0f) + 1e-6f);
#pragma unroll
                        for (int bj = 0; bj < 2; ++bj)
#pragma unroll
                            for (int n = 0; n < 2; ++n) v[bj][n] = v[bj][n] * rn * *(const f32x4*)(gp + 16 * fq + 8 * bj + 4 * n);
                        if (fq == 0) {
#pragma unroll
                            for (int n = 0; n < 2; ++n) {
                                const f32x4 c = ca[m][n], s = sa[m][n];
                                const f32x4 x1 = v[0][n], x2 = v[1][n];
                                v[0][n] = x1 * c - x2 * s; v[1][n] = x2 * c + x1 * s;
                            }
                        }
                    }
                    if (pn == 2) {
                        float* dst = nullptr;
                        if (row < MP) { if (pos >= SEQ - 128) dst = (isv ? vp : kp) + ((((row >> 13) * 128 + (pos - (SEQ - 128))) * 2 + head) * 64 + 16 * fq); }
                        else { const int sr = row - MP; dst = (isv ? vs : ks) + ((((sr >> 2) * 128 + 124 + (sr & 3)) * 2 + head) * 64 + 16 * fq); }
                        if (dst) {
#pragma unroll
                            for (int bj = 0; bj < 2; ++bj)
#pragma unroll
                                for (int n = 0; n < 2; ++n) *(f32x4*)(dst + 8 * bj + 4 * n) = v[bj][n];
                        }
                    }
                    bf16_t* pp = P + (size_t)row * NIN + colbase;
                    if (pn < 2) {
#pragma unroll
                        for (int bj = 0; bj < 2; ++bj)
#pragma unroll
                            for (int n = 0; n < 2; ++n) v[bj][n] = v[bj][n] * (0.125f * LOG2E);
                    }
#pragma unroll
                    for (int bj = 0; bj < 2; ++bj) {
                        u32x4 w; w.x = pk(v[bj][0][0], v[bj][0][1]); w.y = pk(v[bj][0][2], v[bj][0][3]);
                        w.z = pk(v[bj][1][0], v[bj][1][1]); w.w = pk(v[bj][1][2], v[bj][1][3]);
                        *(u32x4*)(pp + 8 * bj) = w;
                    }
                }
            }
        } else if (pn <= 4 || pn >= 9) {
            const bool silu = (pn <= 4 || pn >= 11);
            const int colbase = (pn <= 4 ? 768 + 256 * (pn - 3) : (pn <= 10 ? 2304 + 256 * (pn - 9) : 2816 + 256 * (pn - 11))) + 32 * wc + 8 * fq;
#pragma unroll
            for (int ai = 0; ai < 2; ++ai)
#pragma unroll
                for (int m = 0; m < 4; ++m) {
                    const int row = rowb + ai * 128 + m * 16;
                    const float r = rsqrtf(rr[ai][m] * (1.0f / 1024.0f) + 1e-6f);
                    bf16_t* pp = P + (size_t)row * NIN + colbase;
#pragma unroll
                    for (int bj = 0; bj < 2; ++bj) {
                        f32x4 v0 = acc[ai][bj][m][0] * r, v1 = acc[ai][bj][m][1] * r;
                        if (silu) {
#pragma unroll
                            for (int e = 0; e < 4; ++e) { v0[e] = v0[e] * __builtin_amdgcn_rcpf(1.0f + ex2(-v0[e] * LOG2E)); v1[e] = v1[e] * __builtin_amdgcn_rcpf(1.0f + ex2(-v1[e] * LOG2E)); }
                        }
                        u32x4 w; w.x = pk(v0[0], v0[1]); w.y = pk(v0[2], v0[3]); w.z = pk(v1[0], v1[1]); w.w = pk(v1[2], v1[3]);
                        *(u32x4*)(pp + 128 * bj) = w;
                    }
                }
        } else {
            const bool isk = pn >= 7;
            const int head = 2 * ((pn - 5) & 1) + (wc >> 1), hh = wc & 1;
            const int colbase = (isk ? 1792 : 1280) + 128 * head + 32 * hh + 8 * fq;
            const float post = __builtin_bit_cast(float, __builtin_amdgcn_readfirstlane(isk ? 0x3db504f3 : 0x3f800000));
#pragma unroll
            for (int am = 0; am < 4; ++am) {
                const int ai = am >> 1;
                f32x4 cc[4][2], sn[4][2];
#pragma unroll
                for (int m = 2 * (am & 1); m < 2 * (am & 1) + 2; ++m) {
                    const int row = rowb + ai * 128 + m * 16;
                    const int pos = (row < MP) ? (row & 8191) : (8192 + ((row - MP) & 3));
                    const float* tb = tabB + pos * 128 + 32 * hh + 8 * fq;
#pragma unroll
                    for (int n = 0; n < 2; ++n) { cc[m][n] = *(const f32x4*)(tb + 4 * n); sn[m][n] = *(const f32x4*)(tb + 64 + 4 * n); }
                }
#pragma unroll
                for (int m = 2 * (am & 1); m < 2 * (am & 1) + 2; ++m) {
                    const int row = rowb + ai * 128 + m * 16;
                    const float r = rsqrtf(rr[ai][m] * (1.0f / 1024.0f) + 1e-6f) * post;
                    f32x4 y1[2], y2[2];
#pragma unroll
                    for (int n = 0; n < 2; ++n) {
                        const f32x4 c = cc[m][n], s = sn[m][n];
                        const f32x4 x1 = acc[ai][0][m][n] * r, x2 = acc[ai][1][m][n] * r;
                        y1[n] = x1 * c - x2 * s; y2[n] = x2 * c + x1 * s;
                    }
                    bf16_t* pp = P + (size_t)row * NIN + colbase;
                    u32x4 w; w.x = pk(y1[0][0], y1[0][1]); w.y = pk(y1[0][2], y1[0][3]); w.z = pk(y1[1][0], y1[1][1]); w.w = pk(y1[1][2], y1[1][3]);
                    *(u32x4*)pp = w;
                    w.x = pk(y2[0][0], y2[0][1]); w.y = pk(y2[0][2], y2[0][3]); w.z = pk(y2[1][0], y2[1][1]); w.w = pk(y2[1][2], y2[1][3]);
                    *(u32x4*)(pp + 64) = w;
                }
            }
        }
    }
};

struct EpiOut {
    const float* xin_p; const float* xin_s;
    float* xout;
    const bf16_t* XBi; bf16_t* XB; float* rowss_next;
    __device__ __forceinline__ void operator()(const f32x4 (&acc)[2][2][4][2], const pg8::Unit& u, int wr, int wc, int fr, int fq) const {
        const int rowb = u.pm * 256 + wr * 64 + fr;
        const int colb = u.pn * 256 + 32 * wc + 8 * fq;
        const bool f32in = (xin_p != nullptr), last = (xout != nullptr);
#pragma unroll
        for (int ai = 0; ai < 2; ++ai) {
            f32x4 pre[4][2][2];
            if (f32in) {
#pragma unroll
                for (int m = 0; m < 4; ++m) { const int row = rowb + ai * 128 + m * 16;
                    const float* xr = (row < MP) ? xin_p + (size_t)row * DM : xin_s + (size_t)(row - MP) * DM;
#pragma unroll
                    for (int bj = 0; bj < 2; ++bj) { pre[m][bj][0] = *(const f32x4*)(xr + colb + 128 * bj); pre[m][bj][1] = *(const f32x4*)(xr + colb + 128 * bj + 4); } }
            } else {
                u32x4 pb[4][2];
#pragma unroll
                for (int m = 0; m < 4; ++m) { const int row = rowb + ai * 128 + m * 16;
#pragma unroll
                    for (int bj = 0; bj < 2; ++bj) pb[m][bj] = *(const u32x4*)(XBi + (size_t)row * DM + colb + 128 * bj); }
#pragma unroll
                for (int m = 0; m < 4; ++m)
#pragma unroll
                    for (int bj = 0; bj < 2; ++bj) { const u32x4 w = pb[m][bj];
                        pre[m][bj][0] = (f32x4){bflo(w.x), bfhi(w.x), bflo(w.y), bfhi(w.y)}; pre[m][bj][1] = (f32x4){bflo(w.z), bfhi(w.z), bflo(w.w), bfhi(w.w)}; }
            }
#pragma unroll
            for (int m = 0; m < 4; ++m) {
                const int row = rowb + ai * 128 + m * 16;
                float ss = 0.f;
#pragma unroll
                for (int bj = 0; bj < 2; ++bj) {
                    const int col = colb + 128 * bj;
                    const f32x4 v0 = pre[m][bj][0] + acc[ai][bj][m][0], v1 = pre[m][bj][1] + acc[ai][bj][m][1];
                    if (last) { *(f32x4*)(xout + (size_t)row * DM + col) = v0; *(f32x4*)(xout + (size_t)row * DM + col + 4) = v1; }
                    else {
                        u32x4 w; w.x = pk(v0[0], v0[1]); w.y = pk(v0[2], v0[3]); w.z = pk(v1[0], v1[1]); w.w = pk(v1[2], v1[3]);
                        *(u32x4*)(XB + (size_t)row * DM + col) = w;
                        ss += (v0[0] * v0[0] + v0[1] * v0[1]) + (v0[2] * v0[2] + v0[3] * v0[3]) + (v1[0] * v1[0] + v1[1] * v1[1]) + (v1[2] * v1[2] + v1[3] * v1[3]);
                    }
                }
                if (!last) { ss += shx(ss, 16, (fq * 16 + fr)); ss += shx(ss, 32, (fq * 16 + fr)); if (fq == 0) atomicAdd(rowss_next + row, ss); }
            }
        }
    }
};
struct OneUnit {
    int pm, pn;
    __device__ __forceinline__ bool next(int i, pg8::Unit& u) const { if (i > 0) return false; u.pm = pm; u.pn = pn; return true; }
    __device__ __forceinline__ void a_ready(const pg8::Unit&) const {}
    __device__ __forceinline__ void done(const pg8::Unit&) const {}
};

struct SampleFirstOrder {
    pg8::StaticOrder S; int spm, spn; unsigned* cnt;
    __device__ __forceinline__ bool next(int i, pg8::Unit& u) const {
        if (spm >= 0) { if (i == 0) { u.pm = spm; u.pn = spn; return true; } return S.next(i - 1, u); }
        return S.next(i, u);
    }
    __device__ __forceinline__ void a_ready(const pg8::Unit&) const {}
    __device__ __forceinline__ void done(const pg8::Unit& u) const {
        if (u.pm >= 64) {
            asm volatile("s_waitcnt vmcnt(0)" ::: "memory");
            __builtin_amdgcn_s_barrier();
            if (threadIdx.x == 0) { __builtin_amdgcn_fence(__ATOMIC_RELEASE, "agent"); asm volatile("s_waitcnt vmcnt(0)" ::: "memory"); __hip_atomic_fetch_add(cnt, 1u, __ATOMIC_RELAXED, __HIP_MEMORY_SCOPE_AGENT); }
        }
    }
};
__device__ __forceinline__ void p0_transpose_item(const float* W, int K, int N, const float* g, bf16_t* WT, bool is_in, LAS float* scr, int item, int lane) {
    const int nblk = N / 32, kb = item / nblk, nb = item % nblk, k0 = 64 * kb, s0 = 32 * nb;
    float tw[32];
#pragma unroll
    for (int i = 0; i < 32; ++i) tw[i] = W[(size_t)(k0 + 2 * i + (lane >> 5)) * N + s0 + (lane & 31)];
#pragma unroll
    for (int i = 0; i < 32; ++i) { const int kk = 2 * i + (lane >> 5); const float gvv = g ? g[k0 + kk] : 1.0f; scr[kk * 33 + (lane & 31)] = tw[i] * gvv; }
    asm volatile("s_waitcnt lgkmcnt(0)" ::: "memory");
    const int c = lane & 7;
#pragma unroll
    for (int j = 0; j < 4; ++j) { const int n = (lane >> 3) + 8 * j; const LAS float* s = scr + (8 * c) * 33 + n;
        const int drow = is_in ? colinv_in(s0 + n) : colinv_out(s0 + n);
        u32x4 o; o.x = pk(s[0 * 33], s[1 * 33]); o.y = pk(s[2 * 33], s[3 * 33]); o.z = pk(s[4 * 33], s[5 * 33]); o.w = pk(s[6 * 33], s[7 * 33]);
        *(u32x4*)(WT + (size_t)drow * K + k0 + 8 * c) = o; }
    asm volatile("s_waitcnt lgkmcnt(0)" ::: "memory");
}
__device__ __forceinline__ void sincos_d(double x, double& s, double& c) {
    const double kd = __builtin_rint(x * 0.63661977236758134308);
    const double r = (x - kd * 1.57079632673412561417e+00) - kd * 6.07710050650619224932e-11;
    const int k = ((int)kd) & 3;
    const double r2 = r * r;
    const double sp = r * (1.0 + r2 * (-1.0 / 6.0 + r2 * (1.0 / 120.0 + r2 * (-1.0 / 5040.0 + r2 * (1.0 / 362880.0 + r2 * (-1.0 / 39916800.0 + r2 * (1.0 / 6227020800.0)))))));
    const double cp = 1.0 + r2 * (-0.5 + r2 * (1.0 / 24.0 + r2 * (-1.0 / 720.0 + r2 * (1.0 / 40320.0 + r2 * (-1.0 / 3628800.0 + r2 * (1.0 / 479001600.0 + r2 * (-1.0 / 87178291200.0)))))));
    s = (k == 0) ? sp : (k == 1) ? cp : (k == 2) ? -sp : -cp;
    c = (k == 0) ? cp : (k == 1) ? -sp : (k == 2) ? -cp : sp;
}

struct Args { const float* in[11]; float* out; unsigned char* ws; double baseA, baseB; int ph_lo, ph_hi; };

__device__ __forceinline__ void p0_prologue(const Args& a, LAS unsigned char* lds, int tid, int G) {
    const int lane = tid & 63, wave = tid >> 6;
    LAS float* scr = (LAS float*)(lds + wave * 16384);
    const int gw = blockIdx.x * 8 + wave, NGW = G * 8;
    unsigned char* ws = a.ws;
    constexpr int I_IN = (DM / 64) * (NIN / 32), I_OUT = (DM / 64) * (DM / 32);
    for (int it = gw; it < DEPTH * (I_IN + I_OUT); it += NGW) {
        const int l = it / (I_IN + I_OUT); int r = it - l * (I_IN + I_OUT);
        if (r < I_IN) p0_transpose_item(a.in[5] + (size_t)l * DM * NIN, DM, NIN, a.in[7] + l * DM, (bf16_t*)(ws + WS_WIN) + (size_t)l * NIN * DM, true, scr, r, lane);
        else p0_transpose_item(a.in[6] + (size_t)l * DM * DM, DM, DM, nullptr, (bf16_t*)(ws + WS_WOUT) + (size_t)l * DM * DM, false, scr, r - I_IN, lane);
    }
    float* rowss = (float*)(ws + WS_ROWSS);
    bf16_t* XB = (bf16_t*)(ws + WS_XB);
    for (int m0 = gw; m0 < MT; m0 += 4 * NGW) {
        f32x4 v[4][4];
#pragma unroll
        for (int q = 0; q < 4; ++q) { const int m = m0 + q * NGW; if (m < MT) { const float* xr = (m < MP) ? a.in[0] + (size_t)m * DM : a.in[1] + (size_t)(m - MP) * DM;
#pragma unroll
            for (int j = 0; j < 4; ++j) v[q][j] = *(const f32x4*)(xr + 4 * lane + 256 * j); } }
#pragma unroll
        for (int q = 0; q < 4; ++q) { const int m = m0 + q * NGW; if (m < MT) {
            float s = 0.f;
#pragma unroll
            for (int j = 0; j < 4; ++j) { const f32x4 x = v[q][j]; s += (x[0] * x[0] + x[1] * x[1]) + (x[2] * x[2] + x[3] * x[3]);
                u32x2 w; w.x = pk(x[0], x[1]); w.y = pk(x[2], x[3]); *(u32x2*)(XB + (size_t)m * DM + 4 * lane + 256 * j) = w; }
#pragma unroll
            for (int o = 1; o < 64; o <<= 1) s += shx(s, o, lane);
            if (lane == 0) rowss[m] = s; } }
    }
    const int gt = blockIdx.x * 512 + tid, NGT = G * 512;
    for (int i = gt; i < 3 * MT; i += NGT) rowss[MT + i] = 0.f;
    float* tabB = (float*)(ws + WS_TABB); float* tabA = (float*)(ws + WS_TABA);
    for (int idx = gt; idx < NPOS * 72; idx += NGT) {
        const int pos = idx / 72, i = idx - pos * 72;
        const bool isB = i < 64; const int ii = isB ? i : i - 64; const double base = isB ? a.baseB : a.baseA;
        double p = 1.0; for (int k = 0; k < ii; ++k) p *= base;
        const float inv = (float)p; const float ang = (float)pos * inv;
        double s, c; sincos_d((double)ang, s, c);
        if (isB) { tabB[pos * 128 + ii] = (float)c; tabB[pos * 128 + 64 + ii] = (float)s; }
        else { tabA[pos * 16 + ii] = (float)c; tabA[pos * 16 + 8 + ii] = (float)s; }
    }
}


__device__ __forceinline__ void tr_write_sw(LAS bf16_t* img, int RS, int c8, int SM, int tok, u32x4 vv, int XL, int lane) {
    const bool odd = tok & 1;
    const unsigned s0 = odd ? vv.x : vv.z, s1 = odd ? vv.y : vv.w;
    const unsigned r0 = (unsigned)shxi((int)s0, XL, lane), r1 = (unsigned)shxi((int)s1, XL, lane);
    const unsigned a0 = odd ? r0 : vv.x, a1 = odd ? r1 : vv.y, b0 = odd ? vv.z : r0, b1 = odd ? vv.w : r1;
    LAS unsigned* p = (LAS unsigned*)(img + (8 * c8 + (odd ? 4 : 0)) * RS + ((((tok >> 3) ^ (c8 & SM)) << 3) + (tok & 6)));
    const int rs2 = RS >> 1;
    p[0] = (a0 & 0xffffu) | (b0 << 16); p[rs2] = (a0 >> 16) | (b0 & 0xffff0000u);
    p[2 * rs2] = (a1 & 0xffffu) | (b1 << 16); p[3 * rs2] = (a1 >> 16) | (b1 & 0xffff0000u);
}
__device__ __forceinline__ int sw_off(int d, int RS, int SM, int t0) { return d * RS + ((((t0 >> 3) ^ ((d >> 3) & SM)) << 3) + (t0 & 7)); }
struct AttnRegs { u32x4 kv[4], vv[4]; float sink; };
__device__ __forceinline__ void attn_load(AttnRegs& R, const bf16_t* P, int unit, int tid) {
    const int g = unit & 1, qb = (unit >> 1) & 63, n = unit >> 7;
    const int R0 = n * SEQ + qb * 128;
    const int lane = tid & 63, w = tid >> 6, fr = lane & 15, fq = lane >> 4;
#pragma unroll
    for (int i = 0; i < 4; ++i) {
        const int ch = tid + 512 * i, key = ch >> 3, c8 = ch & 7;
        R.kv[i] = (u32x4){0u, 0u, 0u, 0u};
        if (qb > 0 || key >= 128) R.kv[i] = *(const u32x4*)(P + (size_t)(R0 - 128 + key) * NIN + 512 + 64 * g + 8 * c8);
    }
#pragma unroll
    for (int i = 0; i < 4; ++i) { const int key = (tid >> 3) + 64 * i, c8 = tid & 7; R.vv[i] = (u32x4){0u, 0u, 0u, 0u};
        if (qb > 0 || key >= 128) R.vv[i] = *(const u32x4*)(P + (size_t)(R0 - 128 + key) * NIN + 640 + 64 * g + 8 * c8); }
}
__device__ __forceinline__ void attn_compute(LAS unsigned char* lds, const AttnRegs& R, const bf16_t* P, bf16_t* MIX, const float* sinks_l, int unit, int tid) {
    const int g = unit & 1, qb = (unit >> 1) & 63, n = unit >> 7;
    const int R0 = n * SEQ + qb * 128;
    LAS bf16_t* Ks = (LAS bf16_t*)lds;
    LAS bf16_t* Vt = (LAS bf16_t*)(lds + 256 * 144);
    const int lane = tid & 63, w = tid >> 6, fr = lane & 15, fq = lane >> 4;
    const int head = 4 * g + (w >> 1);
#pragma unroll
    for (int i = 0; i < 4; ++i) {
        const int ch = tid + 512 * i, key = ch >> 3, c8 = ch & 7;
        *(LAS u32x4*)(Ks + key * 72 + 8 * c8) = R.kv[i];
    }
#pragma unroll
    for (int i = 0; i < 4; ++i) tr_write_sw(Vt, 264, tid & 7, 7, (tid >> 3) + 64 * i, R.vv[i], 8, tid);
    __syncthreads();
    const float sink2 = sinks_l[head] * LOG2E;
#pragma unroll 1
    for (int qt = 0; qt < 4; ++qt) {
        const int qi = 64 * (w & 1) + 16 * qt + fr;
        const int row = R0 + qi;
        const bf16_t* qp = P + (size_t)row * NIN + 64 * head + 8 * fq;
        const bf16x8 bq0 = *(const bf16x8*)qp, bq1 = *(const bf16x8*)(qp + 32);
        u32x2 gts[4];
#pragma unroll
        for (int dt = 0; dt < 4; ++dt) gts[dt] = *(const u32x2*)(P + (size_t)row * NIN + 768 + 64 * head + 16 * dt + 4 * fq);
        f32x4 s[16];
#pragma unroll
        for (int kt = 0; kt < 16; ++kt) {
            const LAS bf16_t* kr = Ks + (16 * kt + fr) * 72 + 8 * fq;
            const bf16x8 a0 = *(const LAS bf16x8*)kr, a1 = *(const LAS bf16x8*)(kr + 32);
            f32x4 z = (f32x4){0.f, 0.f, 0.f, 0.f};
            z = __builtin_amdgcn_mfma_f32_16x16x32_bf16(a0, bq0, z, 0, 0, 0);
            s[kt] = __builtin_amdgcn_mfma_f32_16x16x32_bf16(a1, bq1, z, 0, 0, 0);
            if ((kt & 3) == 3) __builtin_amdgcn_sched_barrier(0);
        }
        float mx = -INFINITY;
#pragma unroll
        for (int kt = 0; kt < 16; ++kt)
#pragma unroll
            for (int r = 0; r < 4; ++r) {
                const int key = 16 * kt + 4 * fq + r;
                const bool valid = (kt < 8) ? (qb > 0 && key > qi) : (key - 128 <= qi);
                const float x = valid ? s[kt][r] : -INFINITY; s[kt][r] = x; mx = fmaxf(mx, x);
            }
        mx = fmaxf(mx, shx(mx, 16, lane)); mx = fmaxf(mx, shx(mx, 32, lane)); mx = fmaxf(mx, sink2);
        float sum = 0.f;
#pragma unroll
        for (int kt = 0; kt < 16; ++kt)
#pragma unroll
            for (int r = 0; r < 4; ++r) { const float p = ex2(s[kt][r] - mx); s[kt][r] = p; sum += p; }
        sum += shx(sum, 16, lane); sum += shx(sum, 32, lane); sum += ex2(sink2 - mx);
        f32x4 o[4];
#pragma unroll
        for (int dt = 0; dt < 4; ++dt) o[dt] = (f32x4){0.f, 0.f, 0.f, 0.f};
#pragma unroll
        for (int k2 = 0; k2 < 8; ++k2) {
            u32x4 pw; pw.x = pk(s[2 * k2][0], s[2 * k2][1]); pw.y = pk(s[2 * k2][2], s[2 * k2][3]); pw.z = pk(s[2 * k2 + 1][0], s[2 * k2 + 1][1]); pw.w = pk(s[2 * k2 + 1][2], s[2 * k2 + 1][3]);
            const bf16x8 pb = __builtin_bit_cast(bf16x8, pw);
#pragma unroll
            for (int dt = 0; dt < 4; ++dt) {
                const u32x2 lo = *(const LAS u32x2*)(Vt + sw_off(16 * dt + fr, 264, 7, 32 * k2 + 4 * fq)), hi = *(const LAS u32x2*)(Vt + sw_off(16 * dt + fr, 264, 7, 32 * k2 + 16 + 4 * fq));
                const u32x4 aw = (u32x4){lo.x, lo.y, hi.x, hi.y};
                o[dt] = __builtin_amdgcn_mfma_f32_16x16x32_bf16(__builtin_bit_cast(bf16x8, aw), pb, o[dt], 0, 0, 0);
            }
        }
        const float inv = 1.0f / sum;
#pragma unroll
        for (int dt = 0; dt < 4; ++dt) {
            const u32x2 gt = gts[dt];
            u32x2 wv; wv.x = pk(o[dt][0] * inv * bflo(gt.x), o[dt][1] * inv * bfhi(gt.x)); wv.y = pk(o[dt][2] * inv * bflo(gt.y), o[dt][3] * inv * bfhi(gt.y));
            *(u32x2*)(MIX + (size_t)row * DM + 64 * head + 16 * dt + 4 * fq) = wv;
        }
    }
    __syncthreads();
}

struct UcRegs { u32x4 kv[4], vv[4]; };
__device__ __forceinline__ void uc_load(UcRegs& R, const bf16_t* P, int unit, int tid) {
    const int h = unit & 3, c = (unit >> 2) & 63, n = unit >> 8;
    const int R0 = n * SEQ + c * 128;
#pragma unroll
    for (int i = 0; i < 4; ++i) { const int j = (tid >> 4) + 32 * i, c8 = tid & 15; const bf16_t* pr = P + (size_t)(R0 + j) * NIN + 128 * h + 8 * c8;
        R.kv[i] = *(const u32x4*)(pr + 1792); R.vv[i] = *(const u32x4*)(pr + 2304); }
}
__device__ __forceinline__ void uc_compute(LAS unsigned char* lds, const UcRegs& R, float* UT, int unit, int tid) {
    const int h = unit & 3;
    const float l2g = l2gamma(h);
    LAS bf16_t* Kt = (LAS bf16_t*)lds;
    LAS bf16_t* Vt = (LAS bf16_t*)(lds + 128 * 272);
    const int lane = tid & 63, w = tid >> 6, fr = lane & 15, fq = lane >> 4;
#pragma unroll
    for (int i = 0; i < 4; ++i) { const int j = (tid >> 4) + 32 * i, c8 = tid & 15; const u32x4 kv = R.kv[i];
        const float dec = ex2((float)(127 - j) * l2g);
        u32x4 kd; kd.x = pk(bflo(kv.x) * dec, bfhi(kv.x) * dec); kd.y = pk(bflo(kv.y) * dec, bfhi(kv.y) * dec);
        kd.z = pk(bflo(kv.z) * dec, bfhi(kv.z) * dec); kd.w = pk(bflo(kv.w) * dec, bfhi(kv.w) * dec);
        tr_write_sw(Kt, 136, c8, 15, j, kd, 16, tid); tr_write_sw(Vt, 136, c8, 15, j, R.vv[i], 16, tid); }
    __syncthreads();
    const int mt0 = 2 * (w & 3), nt0 = 4 * (w >> 2);
    f32x4 acc[2][4];
#pragma unroll
    for (int mi = 0; mi < 2; ++mi)
#pragma unroll
        for (int ni = 0; ni < 4; ++ni) acc[mi][ni] = (f32x4){0.f, 0.f, 0.f, 0.f};
#pragma unroll
    for (int ks = 0; ks < 4; ++ks) {
        bf16x8 af[2], bfr[4];
#pragma unroll
        for (int mi = 0; mi < 2; ++mi) af[mi] = *(const LAS bf16x8*)(Kt + sw_off(16 * (mt0 + mi) + fr, 136, 15, 32 * ks + 8 * fq));
#pragma unroll
        for (int ni = 0; ni < 4; ++ni) bfr[ni] = *(const LAS bf16x8*)(Vt + sw_off(16 * (nt0 + ni) + fr, 136, 15, 32 * ks + 8 * fq));
#pragma unroll
        for (int mi = 0; mi < 2; ++mi)
#pragma unroll
            for (int ni = 0; ni < 4; ++ni) acc[mi][ni] = __builtin_amdgcn_mfma_f32_16x16x32_bf16(af[mi], bfr[ni], acc[mi][ni], 0, 0, 0);
    }
    float* ub = UT + (size_t)unit * 16384;
#pragma unroll
    for (int mi = 0; mi < 2; ++mi)
#pragma unroll
        for (int ni = 0; ni < 4; ++ni) *(f32x4*)(ub + (16 * (nt0 + ni) + fr) * 128 + 16 * (mt0 + mi) + 4 * fq) = acc[mi][ni];
    __syncthreads();
}

__device__ __forceinline__ void sattn_unit(LAS unsigned char* lds, const bf16_t* P, bf16_t* MIX, const float* ck, const float* cv, float* kso, float* vso, const float* sinks_l, int unit, int tid) {
    const int n = unit >> 1, g = unit & 1;
    LAS float* Kc = (LAS float*)lds;
    LAS float* Vc = Kc + 132 * 68;
    LAS float* Qs = Vc + 132 * 68;
    LAS float* Sc = Qs + 1024;
    const float sink_pre = sinks_l[4 * g + ((tid >> 5) & 3)];
    bf16_t gate_pre[4];
    {
        const int lane_ = tid & 63, w_ = tid >> 6, d_ = 16 * (w_ & 3) + (lane_ & 15);
        const bf16_t* gp_ = P + (size_t)(MP + 4 * n + (lane_ >> 4)) * NIN + 768 + 64 * 4 * g + d_;
#pragma unroll
        for (int r = 0; r < 4; ++r) gate_pre[r] = gp_[64 * r];
    }
#pragma unroll
    for (int i = 0; i < 4; ++i) {
        const int ch = tid + 512 * i, wp = ch >> 4, c4 = ch & 15;
        const size_t src = (size_t)((n * 128 + wp) * 2 + g) * 64 + 4 * c4;
        const f32x4 kv = *(const f32x4*)(ck + src), vv = *(const f32x4*)(cv + src);
        *(LAS f32x4*)(Kc + wp * 68 + 4 * c4) = kv; *(LAS f32x4*)(Vc + wp * 68 + 4 * c4) = vv;
        if (wp >= 4) { const size_t dst = (size_t)((n * 128 + wp - 4) * 2 + g) * 64 + 4 * c4; *(f32x4*)(kso + dst) = kv; *(f32x4*)(vso + dst) = vv; }
    }
    if (tid < 64) {
        const int t = tid >> 4, c4 = tid & 15;
        const size_t src = (size_t)((n * 128 + 124 + t) * 2 + g) * 64 + 4 * c4;
        *(LAS f32x4*)(Kc + (128 + t) * 68 + 4 * c4) = *(const f32x4*)(kso + src); *(LAS f32x4*)(Vc + (128 + t) * 68 + 4 * c4) = *(const f32x4*)(vso + src);
    }
    const int qi = tid >> 5, ln = tid & 31;
    const int head = 4 * g + (qi & 3), row = MP + 4 * n + (qi >> 2);
    { const unsigned u = *(const unsigned*)(P + (size_t)row * NIN + 64 * head + 2 * ln); Qs[qi * 64 + 2 * ln] = bflo(u); Qs[qi * 64 + 2 * ln + 1] = bfhi(u); }
    __syncthreads();
    const int lane = tid & 63, w = tid >> 6, fr = lane & 15, fq = lane >> 4;
#pragma unroll 1
    for (int kt = w; kt < 9; kt += 8) {
        f32x4 z = (f32x4){0.f, 0.f, 0.f, 0.f};
#pragma unroll
        for (int st = 0; st < 16; ++st) z = __builtin_amdgcn_mfma_f32_16x16x4f32(Qs[fr * 64 + 4 * st + fq], Kc[(16 * kt + fr) * 68 + 4 * st + fq], z, 0, 0, 0);
        const int k = 16 * kt + fr;
        if (k < 132) {
            const bool valid = (k >= fq + 1) && (k <= fq + 128);
#pragma unroll
            for (int r = 0; r < 4; ++r) Sc[(4 * fq + r) * 136 + k] = valid ? z[r] : -INFINITY;
        }
    }
    __syncthreads();
    const float sink2 = sink_pre * LOG2E;
    float mx = -INFINITY;
    for (int k = ln; k < 132; k += 32) mx = fmaxf(mx, Sc[qi * 136 + k]);
#pragma unroll
    for (int o = 1; o < 32; o <<= 1) mx = fmaxf(mx, shx(mx, o, tid));
    mx = fmaxf(mx, sink2);
    float sum = 0.f;
    for (int k = ln; k < 132; k += 32) { const float p = ex2(Sc[qi * 136 + k] - mx); Sc[qi * 136 + k] = p; sum += p; }
#pragma unroll
    for (int o = 1; o < 32; o <<= 1) sum += shx(sum, o, tid);
    if (ln == 0) Sc[qi * 136 + 132] = 1.0f / (sum + ex2(sink2 - mx));
    __syncthreads();
    if (w < 4) {
        f32x4 o = (f32x4){0.f, 0.f, 0.f, 0.f};
#pragma unroll 11
        for (int st = 0; st < 33; ++st) o = __builtin_amdgcn_mfma_f32_16x16x4f32(Sc[fr * 136 + 4 * st + fq], Vc[(4 * st + fq) * 68 + 16 * w + fr], o, 0, 0, 0);
        const int d = 16 * w + fr, orow = MP + 4 * n + fq;
#pragma unroll
        for (int r = 0; r < 4; ++r) {
            const int hd = 4 * g + r;
            const float gate = bf2f(gate_pre[r]);
            MIX[(size_t)orow * DM + 64 * hd + d] = (bf16_t)(pk(o[r] * Sc[(4 * fq + r) * 136 + 132] * gate, 0.f) & 0xffffu);
        }
    }
    __syncthreads();
}

struct SretRegs { f32x4 s4[8]; float gate; unsigned qkv; unsigned vv; };
__device__ __forceinline__ void sret_load(SretRegs& R, const bf16_t* P, const float* Sin, int unit, int tid) {
    const int n = unit >> 2, h = unit & 3;
    const int v4 = tid & 31, dg = tid >> 5;
    const float* Sb = Sin + (size_t)unit * 16384;
    const int t = tid >> 7, d = tid & 127;
    const bf16_t* pr = P + (size_t)(MP + 4 * n + t) * NIN + 128 * h + d;
    R.qkv = (unsigned)pr[1280] | ((unsigned)pr[1792] << 16); R.vv = (unsigned)pr[2304];
    R.gate = bf2f(pr[2816]);
#pragma unroll
    for (int i = 0; i < 8; ++i) R.s4[i] = *(const f32x4*)(Sb + (8 * dg + i) * 128 + 4 * v4);
}
__device__ __forceinline__ void sret_compute(LAS unsigned char* lds, const SretRegs& R, bf16_t* MIX, float* Sout, int unit, int tid) {
    const int n = unit >> 2, h = unit & 3;
    const float l2g = l2gamma(h);
    LAS float* qs = (LAS float*)lds;
    LAS float* ks_ = qs + 512;
    LAS float* vs_ = qs + 1024;
    LAS float* qk = qs + 1536;
    LAS float* red = qs + 1552;
    LAS float* part = qs + 2048;
    const int v4 = tid & 31, dg = tid >> 5;
    float* So = Sout + (size_t)unit * 16384;
    qs[tid] = bflo(R.qkv); ks_[tid] = bfhi(R.qkv); vs_[tid] = bflo(R.vv);
    __syncthreads();
    f32x4 vj[4], cr[4];
#pragma unroll
    for (int j = 0; j < 4; ++j) { vj[j] = *(const LAS f32x4*)(vs_ + j * 128 + 4 * v4); cr[j] = (f32x4){0.f, 0.f, 0.f, 0.f}; }
    const float g1 = ex2(l2g), g2 = g1 * g1, g3 = g2 * g1, g4 = g2 * g2;
#pragma unroll
    for (int i = 0; i < 8; ++i) {
        const int d = 8 * dg + i;
#pragma unroll
        for (int t = 0; t < 4; ++t) cr[t] += R.s4[i] * qs[t * 128 + d];
        f32x4 sn = R.s4[i] * g4;
        sn += vj[0] * (g3 * ks_[0 * 128 + d]); sn += vj[1] * (g2 * ks_[1 * 128 + d]); sn += vj[2] * (g1 * ks_[2 * 128 + d]); sn += vj[3] * ks_[3 * 128 + d];
        *(f32x4*)(So + d * 128 + 4 * v4) = sn;
    }
#pragma unroll
    for (int t = 0; t < 4; ++t) *(LAS f32x4*)(part + (dg * 4 + t) * 128 + 4 * v4) = cr[t];
    {
        const int t = dg >> 2, j = dg & 3; float p = 0.f;
#pragma unroll
        for (int d = v4; d < 128; d += 32) p += qs[t * 128 + d] * ks_[j * 128 + d];
#pragma unroll
        for (int o = 1; o < 32; o <<= 1) p += shx(p, o, tid);
        if (v4 == 0) qk[dg] = p;
    }
    __syncthreads();
    const int t = tid >> 7, v = tid & 127;
    float cross = 0.f;
#pragma unroll
    for (int d2 = 0; d2 < 16; ++d2) cross += part[(d2 * 4 + t) * 128 + v];
    float o = cross * ex2((float)(t + 1) * l2g);
#pragma unroll
    for (int j = 0; j < 4; ++j) if (j <= t) o += qk[t * 4 + j] * ex2((float)(t - j) * l2g) * vs_[j * 128 + v];
    float ss = o * o;
#pragma unroll
    for (int of = 1; of < 64; of <<= 1) ss += shx(ss, of, tid);
    if ((tid & 63) == 0) red[tid >> 6] = ss;
    __syncthreads();
    const float rn = rsqrtf((red[2 * t] + red[2 * t + 1]) * (1.0f / 128.0f) + 1e-6f);
    const int row = MP + 4 * n + t;
    MIX[(size_t)row * DM + 512 + 128 * h + v] = (bf16_t)(pk(o * rn * R.gate, 0.f) & 0xffffu);
    __syncthreads();
}

__device__ __forceinline__ void sample_outproj_slice(LAS unsigned char* lds, const bf16_t* MIX, const bf16_t* Wt, const float* xs_f32, const bf16_t* XBi, bf16_t* XBn, float* yout, float* rowss_next, int b, int tid) {
    const int lane = tid & 63, w = tid >> 6, fr = lane & 15, fq = lane >> 4;
    const int r0 = MP + 32 * (b >> 4), c0 = 64 * (b & 15), k0 = 128 * w;
    f32x4 res;
    {
        const int mt = w >> 1, nt = w & 1;
        const int col = c0 + 32 * (mt >> 1) + 8 * fq + 4 * (mt & 1), row = r0 + 16 * nt + fr;
        if (xs_f32) res = *(const f32x4*)(xs_f32 + (size_t)(row - MP) * DM + col);
        else { const u32x2 u = *(const u32x2*)(XBi + (size_t)row * DM + col); res = (f32x4){bflo(u.x), bfhi(u.x), bflo(u.y), bfhi(u.y)}; }
    }
    bf16x8 af[4][4], bfr[2][4];
#pragma unroll
    for (int mt = 0; mt < 4; ++mt)
#pragma unroll
        for (int ks = 0; ks < 4; ++ks) af[mt][ks] = *(const bf16x8*)(Wt + (size_t)(c0 + 16 * mt + fr) * DM + k0 + 32 * ks + 8 * fq);
#pragma unroll
    for (int nt = 0; nt < 2; ++nt)
#pragma unroll
        for (int ks = 0; ks < 4; ++ks) bfr[nt][ks] = *(const bf16x8*)(MIX + (size_t)(r0 + 16 * nt + fr) * DM + k0 + 32 * ks + 8 * fq);
    f32x4 acc[4][2];
#pragma unroll
    for (int mt = 0; mt < 4; ++mt)
#pragma unroll
        for (int nt = 0; nt < 2; ++nt) { f32x4 z = (f32x4){0.f, 0.f, 0.f, 0.f};
#pragma unroll
            for (int ks = 0; ks < 4; ++ks) z = __builtin_amdgcn_mfma_f32_16x16x32_bf16(af[mt][ks], bfr[nt][ks], z, 0, 0, 0);
            acc[mt][nt] = z; }
    LAS f32x4* red = (LAS f32x4*)lds;
#pragma unroll
    for (int mt = 0; mt < 4; ++mt)
#pragma unroll
        for (int nt = 0; nt < 2; ++nt) red[(w * 8 + mt * 2 + nt) * 64 + lane] = acc[mt][nt];
    __syncthreads();
    const int mt = w >> 1, nt = w & 1;
    f32x4 v = (f32x4){0.f, 0.f, 0.f, 0.f};
#pragma unroll
    for (int ww = 0; ww < 8; ++ww) v += red[(ww * 8 + w) * 64 + lane];
    const int col = c0 + 32 * (mt >> 1) + 8 * fq + 4 * (mt & 1);
    const int row = r0 + 16 * nt + fr;
    v += res;
    if (yout) *(f32x4*)(yout + (size_t)row * DM + col) = v;
    else {
        u32x2 o; o.x = pk(v[0], v[1]); o.y = pk(v[2], v[3]);
        *(u32x2*)(XBn + (size_t)row * DM + col) = o;
        float ss = (v[0] * v[0] + v[1] * v[1]) + (v[2] * v[2] + v[3] * v[3]);
        ss += shx(ss, 16, lane); ss += shx(ss, 32, lane);
        if (fq == 0) atomicAdd(rowss_next + row, ss);
    }
    __syncthreads();
}

__device__ __forceinline__ void scan_phase(const float* UT, bf16_t* SPT, float* sp_out_l, int tid, int G) {
    for (int gid = blockIdx.x * 512 + tid; gid < 2 * 4 * 16384; gid += G * 512) {
        const int n = gid >> 16, h = (gid >> 14) & 3, e = gid & 16383;
        const float gd = ex2(128.0f * l2gamma(h));
        const size_t base = ((size_t)(n * 64) * 4 + h) * 16384 + e;
        float S = 0.f;
        for (int c0 = 0; c0 < 64; c0 += 32) {
            float uu[32];
#pragma unroll
            for (int k = 0; k < 32; ++k) uu[k] = UT[base + (size_t)(c0 + k) * 65536];
#pragma unroll
            for (int k = 0; k < 32; ++k) { SPT[base + (size_t)(c0 + k) * 65536] = (bf16_t)(pk(S, 0.f) & 0xffffu); S = gd * S + uu[k]; }
        }
        const int dv = e >> 7, dk = e & 127;
        sp_out_l[(size_t)(n * 4 + h) * 16384 + dk * 128 + dv] = S;
    }
}

__device__ __forceinline__ void ret_unit(LAS unsigned char* lds, const bf16_t* P, const bf16_t* SPT, bf16_t* MIX, int unit, int tid) {
    const int h = unit & 3, c = (unit >> 2) & 63, n = unit >> 8;
    const int R0 = n * SEQ + c * 128;
    const float l2g = l2gamma(h);
    LAS bf16_t* Ks = (LAS bf16_t*)lds;
    LAS bf16_t* Vt = (LAS bf16_t*)(lds + 128 * 272);
    LAS bf16_t* Ss = (LAS bf16_t*)(lds + 256 * 272);
    const int lane = tid & 63, w = __builtin_amdgcn_readfirstlane(tid >> 6), fr = lane & 15, fq = lane >> 4;
    const int qi = 16 * w + fr, row = R0 + qi;
    bf16x8 bq[4];
#pragma unroll
    for (int ks = 0; ks < 4; ++ks) bq[ks] = *(const bf16x8*)(P + (size_t)row * NIN + 1280 + 128 * h + 32 * ks + 8 * fq);
    u32x2 gts[8];
#pragma unroll
    for (int dt = 0; dt < 8; ++dt) gts[dt] = *(const u32x2*)(P + (size_t)row * NIN + 2816 + 128 * h + 16 * dt + 4 * fq);
#pragma unroll
    for (int i = 0; i < 4; ++i) {
        const int ch = tid + 512 * i, j = ch >> 4, c8 = ch & 15;
        const u32x4 kv = *(const u32x4*)(P + (size_t)(R0 + j) * NIN + 1792 + 128 * h + 8 * c8);
        const u32x4 sv = *(const u32x4*)(SPT + (size_t)unit * 16384 + j * 128 + 8 * c8);
        *(LAS u32x4*)(Ks + j * 136 + 8 * c8) = kv;
        *(LAS u32x4*)(Ss + j * 136 + 8 * c8) = sv;
    }
    {
        u32x4 vv[4];
#pragma unroll
        for (int i = 0; i < 4; ++i) vv[i] = *(const u32x4*)(P + (size_t)(R0 + (tid >> 4) + 32 * i) * NIN + 2304 + 128 * h + 8 * (tid & 15));
#pragma unroll
        for (int i = 0; i < 4; ++i) tr_write_sw(Vt, 136, tid & 15, 15, (tid >> 4) + 32 * i, vv[i], 16, tid);
    }
    __syncthreads();
    f32x4 o[8];
#pragma unroll
    for (int dt = 0; dt < 8; ++dt) {
        f32x4 z = (f32x4){0.f, 0.f, 0.f, 0.f};
#pragma unroll
        for (int ks = 0; ks < 4; ++ks) z = __builtin_amdgcn_mfma_f32_16x16x32_bf16(*(const LAS bf16x8*)(Ss + (16 * dt + fr) * 136 + 32 * ks + 8 * fq), bq[ks], z, 0, 0, 0);
        o[dt] = z * ex2((float)(qi + 1) * l2g);
    }
    f32x4 sc[8];
#pragma unroll
    for (int jt = 0; jt < 8; ++jt) {
        f32x4 z = (f32x4){0.f, 0.f, 0.f, 0.f};
        if (jt <= w) {
#pragma unroll
            for (int ks = 0; ks < 4; ++ks) z = __builtin_amdgcn_mfma_f32_16x16x32_bf16(*(const LAS bf16x8*)(Ks + (16 * jt + fr) * 136 + 32 * ks + 8 * fq), bq[ks], z, 0, 0, 0);
#pragma unroll
            for (int r = 0; r < 4; ++r) { const int j = 16 * jt + 4 * fq + r; z[r] = (qi >= j) ? z[r] * ex2((float)(qi - j) * l2g) : 0.f; }
        }
        sc[jt] = z;
    }
#pragma unroll
    for (int k2 = 0; k2 < 4; ++k2) {
        if (2 * k2 <= w) {
            u32x4 pw; pw.x = pk(sc[2 * k2][0], sc[2 * k2][1]); pw.y = pk(sc[2 * k2][2], sc[2 * k2][3]); pw.z = pk(sc[2 * k2 + 1][0], sc[2 * k2 + 1][1]); pw.w = pk(sc[2 * k2 + 1][2], sc[2 * k2 + 1][3]);
            const bf16x8 pb = __builtin_bit_cast(bf16x8, pw);
#pragma unroll
            for (int dt = 0; dt < 8; ++dt) {
                const u32x2 lo = *(const LAS u32x2*)(Vt + sw_off(16 * dt + fr, 136, 15, 32 * k2 + 4 * fq)), hi = *(const LAS u32x2*)(Vt + sw_off(16 * dt + fr, 136, 15, 32 * k2 + 16 + 4 * fq));
                const u32x4 aw = (u32x4){lo.x, lo.y, hi.x, hi.y};
                o[dt] = __builtin_amdgcn_mfma_f32_16x16x32_bf16(__builtin_bit_cast(bf16x8, aw), pb, o[dt], 0, 0, 0);
            }
        }
    }
    float ss = 0.f;
#pragma unroll
    for (int dt = 0; dt < 8; ++dt) ss += (o[dt][0] * o[dt][0] + o[dt][1] * o[dt][1]) + (o[dt][2] * o[dt][2] + o[dt][3] * o[dt][3]);
    ss += shx(ss, 16, lane); ss += shx(ss, 32, lane);
    const float rn = rsqrtf(ss * (1.0f / 128.0f) + 1e-6f);
#pragma unroll
    for (int dt = 0; dt < 8; ++dt) {
        const u32x2 gt = gts[dt];
        u32x2 wv; wv.x = pk(o[dt][0] * rn * bflo(gt.x), o[dt][1] * rn * bfhi(gt.x)); wv.y = pk(o[dt][2] * rn * bflo(gt.y), o[dt][3] * rn * bfhi(gt.y));
        *(u32x2*)(MIX + (size_t)row * DM + 512 + 128 * h + 16 * dt + 4 * fq) = wv;
    }
    __syncthreads();
}


#define XB_TMO      128
#define XB_XCNT(j)  (256  + 64 * (j))
#define XB_XSUB(j)  (1280 + 64 * (j))
#define XB_XGEN(j)  (2304 + 64 * (j))
#define XB_TOP      3328
#define XB_TOPGEN   3392
#define XCD_BAR_WORDS 3456
#define XB_SPIN_CAP (1u << 22)
__device__ __forceinline__ unsigned xb_ld(unsigned* p)              { return __hip_atomic_load(p, __ATOMIC_RELAXED, __HIP_MEMORY_SCOPE_AGENT); }
__device__ __forceinline__ unsigned xb_add(unsigned* p, unsigned v) { return __hip_atomic_fetch_add(p, v, __ATOMIC_RELAXED, __HIP_MEMORY_SCOPE_AGENT); }
__device__ __forceinline__ unsigned xb_xcc_id() { return (unsigned)__builtin_amdgcn_s_getreg((3 << 11) | 20) & 0xFu; }
#define XB_SPIN(cond, bar) do { unsigned _sp = 0; while (cond) { __builtin_amdgcn_s_sleep(1); \
    if ((++_sp & 255u) == 0u) { if (xb_ld(&(bar)[XB_TMO])) break; if (_sp > XB_SPIN_CAP) { atomicAdd(&(bar)[XB_TMO], 1u); break; } } } } while (0)
struct XcdBarrier { unsigned* bar; unsigned x; volatile LAS unsigned* st; };
__device__ __forceinline__ XcdBarrier xcd_barrier_post(unsigned* bar, volatile LAS unsigned* st) {
    XcdBarrier b; b.bar = bar; b.x = xb_xcc_id(); b.st = st;
    if (threadIdx.x == 0) (void)xb_add(&bar[XB_XCNT(b.x)], 1u);
    return b;
}
__device__ __forceinline__ void xcd_barrier_complete(unsigned* bar, unsigned x, unsigned& nloc, unsigned& nx) {
    const unsigned G = gridDim.x * gridDim.y * gridDim.z;
    unsigned sum, cnt, mine, sp = 0u;
    for (;;) {
        sum = 0u; cnt = 0u; mine = 0u;
#pragma unroll
        for (unsigned j = 0; j < 16; ++j) { const unsigned c = xb_ld(&bar[XB_XCNT(j)]); sum += c; cnt += (c > 0u) ? 1u : 0u; mine = (j == x) ? c : mine; }
        if (sum == G) break;
        __builtin_amdgcn_s_sleep(1);
        if ((++sp & 255u) == 0u) { if (xb_ld(&bar[XB_TMO])) break; if (sp > XB_SPIN_CAP) { atomicAdd(&bar[XB_TMO], 1u); break; } }
    }
    nloc = mine > 0u ? mine : 1u; nx = cnt > 0u ? cnt : 1u;
}
__device__ __forceinline__ void xcd_barrier(const XcdBarrier& b0) {
    XcdBarrier b = b0;
    asm volatile("" : "+s"(b.x));
    asm volatile("s_waitcnt vmcnt(0)" ::: "memory");
    __syncthreads();
    if (threadIdx.x == 0) {
        unsigned* bar = b.bar;
        asm volatile("" : "+s"(bar));
        __builtin_amdgcn_s_waitcnt(0);
        unsigned nloc = b.st[0], nx = b.st[1];
        if (nloc == 0u) { xcd_barrier_complete(bar, b.x, nloc, nx); b.st[0] = nloc; b.st[1] = nx; }
        const unsigned old = xb_add(&bar[XB_XSUB(b.x)], 1u);
        const unsigned gen = old / nloc;
        if (old + 1u == (gen + 1u) * nloc) {
            __builtin_amdgcn_fence(__ATOMIC_RELEASE, "agent");
            asm volatile("s_waitcnt vmcnt(0)" ::: "memory");
            const unsigned og = xb_add(&bar[XB_TOP], 1u);
            const unsigned tg = og / nx;
            if (og + 1u == (tg + 1u) * nx) xb_add(&bar[XB_TOPGEN], 1u);
            else XB_SPIN(xb_ld(&bar[XB_TOPGEN]) == tg, bar);
            __builtin_amdgcn_fence(__ATOMIC_ACQUIRE, "agent");
            xb_add(&bar[XB_XGEN(b.x)], 1u);
            asm volatile("s_waitcnt vmcnt(0)" ::: "memory");
        } else {
            XB_SPIN(xb_ld(&bar[XB_XGEN(b.x)]) == gen, bar);
            __builtin_amdgcn_fence(__ATOMIC_ACQUIRE, "agent");
            asm volatile("s_waitcnt vmcnt(0)" ::: "memory");
        }
    }
    __syncthreads();
}
constexpr int MISC_OFF = 131072 + 320;
__device__ __forceinline__ int launder_tid() { int t = threadIdx.x; asm volatile("" : "+v"(t)); return t; }
__global__ void __launch_bounds__(512, 2) hymba_fwd(Args a) {
    extern __shared__ __attribute__((aligned(16))) unsigned char lds_raw[];
    LAS unsigned char* lds = (LAS unsigned char*)lds_raw;
    const int tid = threadIdx.x, G = gridDim.x;
    unsigned char* ws = a.ws;
    float* out = a.out;
    bf16_t* P = (bf16_t*)(ws + WS_P); bf16_t* MIX = (bf16_t*)(ws + WS_MIX);
    float* UT = (float*)(ws + WS_UT); bf16_t* SPT = (bf16_t*)(ws + WS_SPT);
    float* rowss = (float*)(ws + WS_ROWSS);
    const float* tabB = (const float*)(ws + WS_TABB); const float* tabA = (const float*)(ws + WS_TABA);
    const int lo = a.ph_lo, hi = a.ph_hi;
    volatile LAS unsigned* MISC = (volatile LAS unsigned*)(lds + MISC_OFF);
    if (tid < 32) MISC[tid] = 0u;
    __syncthreads();
    XcdBarrier bar = xcd_barrier_post((unsigned*)ws, MISC + 8);
    if (a.ph_lo < 0) cg::this_grid().sync();
#if MK_MULTI
#define IN(k) (lo <= (k) && (k) < hi)
#else
#define IN(k) true
#endif
#define LT() launder_tid()
#define SEAM(k) do { if (IN(k) && IN((k) + 1)) { xcd_barrier(bar); } } while (0)
#ifndef SKIP_P0
    if (IN(0)) for (int rep = 0; rep < REP_P0; ++rep) { p0_prologue(a, lds, tid, G); if (rep + 1 < REP_P0) xcd_barrier(bar); }
#endif
    SEAM(0);
    for (int l = 0; l < DEPTH; ++l) {
        const int pb = 1 + 5 * l;
        const float* sinks_l = a.in[10] + 8 * l;
        bf16_t* XB = (bf16_t*)(ws + ((l & 1) ? WS_XB2 : WS_XB)); bf16_t* XBn = (bf16_t*)(ws + ((l & 1) ? WS_XB : WS_XB2));
#ifndef SKIP_P1
        if (IN(pb)) for (int rep = 0; rep < REP_P1; ++rep) {
            const int b = (int)blockIdx.x;
            unsigned* cnt = (unsigned*)(ws + 14336) + 64 * l;
            pg8::Gemm g{XB, (const bf16_t*)(ws + WS_WIN) + (size_t)l * NIN * DM, MT, NIN, DM};
            EpiIn E{P, rowss + l * MT, a.in[8] + 64 * l, a.in[9] + 64 * l, tabA, tabB,
                    out + O_KP + (size_t)l * 32768, out + O_VP + (size_t)l * 32768, out + O_KS + (size_t)l * 2097152, out + O_VS + (size_t)l * 2097152};
            {
                SampleFirstOrder S; S.S.init(MP, NIN, G, b); S.cnt = cnt;
                const bool hs = (b >= 64 && b < 90);
                S.spm = hs ? 64 + (b - 64) / 13 : -1; S.spn = hs ? (b - 64) % 13 : 0;
                pg8::gemm_phase<EpiIn, SampleFirstOrder, true, true>(lds, g, S, E, LT());
            }
            if (b >= 90) {
                if (threadIdx.x == 0) {
                    XB_SPIN(xb_ld(cnt) < 26u * (unsigned)(rep + 1), (unsigned*)ws);
                    __builtin_amdgcn_fence(__ATOMIC_ACQUIRE, "agent"); asm volatile("s_waitcnt vmcnt(0)" ::: "memory");
                }
                __syncthreads();
                const float* ck = a.in[2] + (size_t)l * 2097152; const float* cv = a.in[3] + (size_t)l * 2097152;
                float* kso = out + O_KS + (size_t)l * 2097152; float* vso = out + O_VS + (size_t)l * 2097152;
                const float* sin_l = a.in[4] + (size_t)l * 8388608; float* sout_l = out + O_SS + (size_t)l * 8388608;
                {
                    const int stride = G - 90;
                    int u = b - 90;
                    if (u < 512) {
                        SretRegs cur; sret_load(cur, P, sin_l, u, LT());
#pragma unroll 1
                        for (; u < 512; u += stride) {
                            const int nx = u + stride;
                            SretRegs nxt = cur;
                            if (nx < 512) sret_load(nxt, P, sin_l, nx, LT());
                            sret_compute(lds, cur, MIX, sout_l, u, LT());
                            cur = nxt;
                        }
                    }
#pragma unroll 1
                    for (; u < 768; u += stride) sattn_unit(lds, P, MIX, ck, cv, kso, vso, sinks_l, u - 512, LT());
                }
            }
        }
#endif
        SEAM(pb);
#ifndef SKIP_P2
        if (IN(pb + 1)) for (int rep = 0; rep < REP_P2; ++rep) {
            const int b = (int)blockIdx.x;
            UcRegs u1, u2; AttnRegs ar;
            uc_load(u1, P, b, LT());
            uc_load(u2, P, b + 256, LT());
            uc_compute(lds, u1, UT, b, LT());
            attn_load(ar, P, b, LT());
            uc_compute(lds, u2, UT, b + 256, LT());
            attn_compute(lds, ar, P, MIX, sinks_l, b, LT());
        }
#endif
        SEAM(pb + 1);
#ifndef SKIP_SCAN
        if (IN(pb + 2)) for (int rep = 0; rep < REP_P3; ++rep) {
            const bool lastl = (l == DEPTH - 1);
            sample_outproj_slice(lds, MIX, (const bf16_t*)(ws + WS_WOUT) + (size_t)l * DM * DM, l == 0 ? a.in[1] : nullptr, XB, XBn, lastl ? out : nullptr,
                                 lastl ? nullptr : (rep == 0 ? rowss + (l + 1) * MT : (float*)(ws + WS_DUMMY)), (int)blockIdx.x, LT());
            scan_phase(UT, SPT, out + O_SP + (size_t)l * 131072, LT(), G);
        }
#endif
        SEAM(pb + 2);
#ifndef SKIP_RET
        if (IN(pb + 3)) for (int rep = 0; rep < REP_P4; ++rep) { for (int u = blockIdx.x; u < 512; u += G) ret_unit(lds, P, SPT, MIX, u, LT()); }
#endif
        SEAM(pb + 3);
#ifndef SKIP_P5
        if (IN(pb + 4)) for (int rep = 0; rep < REP_P5; ++rep) {
            pg8::Gemm g{MIX, (const bf16_t*)(ws + WS_WOUT) + (size_t)l * DM * DM, MP, DM, DM};
            pg8::StaticOrder S; S.init(MP, DM, G, (int)blockIdx.x);
            const bool lastl = (l == DEPTH - 1);
            EpiOut E{l == 0 ? a.in[0] : nullptr, l == 0 ? a.in[1] : nullptr, lastl ? out : nullptr, XB, XBn, lastl ? nullptr : (rep == 0 ? rowss + (l + 1) * MT : (float*)(ws + WS_DUMMY))};
            pg8::gemm_phase<EpiOut, pg8::StaticOrder, true, true>(lds, g, S, E, LT());
        }
#endif
        SEAM(pb + 4);
    }
#undef IN
#undef SEAM
}

extern "C" void kernel_launch(void* const* d_in, const int* in_sizes, int n_in, void* d_out, int out_size, void* d_ws, size_t ws_size, hipStream_t stream) {
    static int grid = 0;
    if (grid == 0) {
        int dev = 0, cus = 0, per_cu = 0;
        if (n_in != 11 || ws_size < WS_END) { fprintf(stderr, "kernel_launch: unexpected n_in %d / ws %zu\n", n_in, ws_size); grid = -1; return; }
        if (hipGetDevice(&dev) != hipSuccess || hipDeviceGetAttribute(&cus, hipDeviceAttributeMultiprocessorCount, dev) != hipSuccess) { grid = -1; return; }
        if (hipFuncSetAttribute((const void*)hymba_fwd, hipFuncAttributeMaxDynamicSharedMemorySize, LDS_BYTES) != hipSuccess) { fprintf(stderr, "kernel_launch: hipFuncSetAttribute failed\n"); grid = -1; return; }
        if (hipOccupancyMaxActiveBlocksPerMultiprocessor(&per_cu, (const void*)hymba_fwd, 512, LDS_BYTES) != hipSuccess || per_cu < 1) { fprintf(stderr, "kernel_launch: occupancy query says %d\n", per_cu); per_cu = 1; }
        (void)hipGetLastError();
        if (cus < 256) { fprintf(stderr, "kernel_launch: needs 256 CUs, got %d\n", cus); grid = -1; return; }
        grid = 256;
    }
    if (grid < 0) return;
    if (hipMemsetAsync(d_ws, 0, 16384, stream) != hipSuccess) { fprintf(stderr, "kernel_launch: memset failed\n"); return; }
    Args a{};
    for (int i = 0; i < 11; ++i) a.in[i] = (const float*)d_in[i];
    a.out = (float*)d_out; a.ws = (unsigned char*)d_ws;
    a.baseA = std::pow(500000.0, -1.0 / 8.0); a.baseB = std::pow(10000.0, -1.0 / 64.0);
    constexpr int NPH = 1 + 5 * DEPTH;
#if MK_MULTI
    for (int p = 0; p < NPH; ++p) { a.ph_lo = p; a.ph_hi = p + 1; hipLaunchKernelGGL(hymba_fwd, dim3(grid), dim3(512), LDS_BYTES, stream, a); }
#else
    a.ph_lo = 0; a.ph_hi = NPH;
    void* args[] = {&a};
    hipError_t e = hipLaunchCooperativeKernel((const void*)hymba_fwd, dim3(grid), dim3(512), args, LDS_BYTES, stream);
    if (e != hipSuccess) fprintf(stderr, "cooperative launch failed: %s (grid %d)\n", hipGetErrorString(e), grid);
#endif
}
```

```cpp
#include <hip/hip_runtime.h>
#include <hip/hip_cooperative_groups.h>
#include <cstdio>
#include <cstdint>
#include <cmath>
namespace cg = cooperative_groups;

#ifndef MK_MULTI
#define MK_MULTI 0
#endif

#ifndef REP_P0
#define REP_P0 1
#endif
#ifndef REP_P1
#define REP_P1 1
#endif
#ifndef REP_P2
#define REP_P2 1
#endif
#ifndef REP_P3
#define REP_P3 1
#endif
#ifndef REP_P4
#define REP_P4 1
#endif
#ifndef REP_P5
#define REP_P5 1
#endif
#define LAS __attribute__((address_space(3)))
typedef unsigned short bf16_t;
typedef short bf16x8 __attribute__((ext_vector_type(8)));
typedef float f32x4 __attribute__((ext_vector_type(4)));
typedef float f32x2 __attribute__((ext_vector_type(2)));
typedef unsigned u32x4 __attribute__((ext_vector_type(4)));
typedef unsigned u32x2 __attribute__((ext_vector_type(2)));

constexpr int DM = 1024, SEQ = 8192, NBATCH = 2, MP = NBATCH * SEQ, MS = 512, MT = MP + MS, NIN = 3328, DEPTH = 4;
constexpr int NPOS = 8196;
constexpr float LOG2E = 1.4426950408889634f;
constexpr size_t O_Y = 0, O_KP = 17301504, O_VP = 17432576, O_SP = 17563648, O_KS = 18087936, O_VS = 26476544, O_SS = 34865152;
constexpr size_t MiB = 1u << 20;
constexpr size_t WS_ROWSS = 1 * MiB, WS_TABB = 2 * MiB, WS_TABA = 7 * MiB, WS_WIN = 8 * MiB, WS_WOUT = 36 * MiB, WS_XB = 44 * MiB, WS_MIX = 80 * MiB,
                 WS_P = 116 * MiB, WS_UT = 224 * MiB, WS_SPT = 256 * MiB, WS_XB2 = 272 * MiB, WS_DUMMY = 308 * MiB, WS_END = 312 * MiB;
constexpr int LDS_BYTES = 147456;

__device__ __forceinline__ unsigned pk(float lo, float hi) { unsigned r; asm("v_cvt_pk_bf16_f32 %0, %1, %2" : "=v"(r) : "v"(lo), "v"(hi)); return r; }
__device__ __forceinline__ float bflo(unsigned u) { return __uint_as_float(u << 16); }
__device__ __forceinline__ float bfhi(unsigned u) { return __uint_as_float(u & 0xffff0000u); }
__device__ __forceinline__ float bf2f(bf16_t h) { return __uint_as_float((unsigned)h << 16); }
__device__ __forceinline__ float ex2(float x) { return __builtin_amdgcn_exp2f(x); }
__device__ __forceinline__ float shx(float v, int m, int lane) { return __builtin_bit_cast(float, __builtin_amdgcn_ds_bpermute(((lane ^ m) & 63) << 2, __builtin_bit_cast(int, v))); }
__device__ __forceinline__ int shxi(int v, int m, int lane) { return __builtin_amdgcn_ds_bpermute(((lane ^ m) & 63) << 2, v); }
__device__ __forceinline__ float l2gamma(int h) { const int hb = __builtin_amdgcn_readfirstlane(h); const unsigned b = hb == 0 ? 0xbd3b9ca6u : hb == 1 ? 0xbcba1f74u : hb == 2 ? 0xbc3963ddu : 0xbbb906ceu; return __builtin_bit_cast(float, b); }

namespace pg8 {
constexpr int BM = 256, BK = 64, HALF = 128, HTB = HALF * BK * 2, STAGE_BYTES = 8 * HTB, NXCD = 8, WGM = 8;
__host__ __device__ __forceinline__ int lds_byte(int r, int c) { const int st = (r >> 4) * 2 + (c >> 5), rr = r & 15, cc = c & 31, ob = rr * 64 + cc * 2; return st * 1024 + (ob ^ (((ob >> 9) & 1) << 5)); }
__host__ __device__ __forceinline__ void stage_rc(int b, int& R, int& C) { const int st = b / 1024, sb = b % 1024, swz = sb ^ (((sb >> 9) & 1) << 5); R = (st >> 1) * 16 + swz / 64; C = (st & 1) * 32 + (swz % 64) / 2; }
struct Unit { int pm, pn; };
struct Gemm { const bf16_t* A; const bf16_t* Bt; int M, N, K; };
struct StaticOrder {
    int nM, nN, nwg, G, c;
    __host__ __device__ void init(int M, int N, int G_, int c_) { nM = M / BM; nN = N / BM; nwg = nM * nN; G = G_; c = c_; }
    __host__ __device__ bool next(int i, Unit& u) const {
        const long L = (long)i * G + c; if (L >= nwg) return false;
        int wgid = (int)L; { const int q = nwg / NXCD, r = nwg % NXCD, xcd = wgid % NXCD, off = wgid / NXCD; wgid = (xcd < r ? xcd * (q + 1) : r * (q + 1) + (xcd - r) * q) + off; }
        const int nig = WGM * nN, gid = wgid / nig, fm = gid * WGM, gsz = (nM - fm) < WGM ? (nM - fm) : WGM;
        u.pm = fm + ((wgid % nig) % gsz); u.pn = (wgid % nig) / gsz; return true;
    }
    __device__ __forceinline__ void a_ready(const Unit&) const {}
    __device__ __forceinline__ void done(const Unit&) const {}
};

template <class Epi, class Sched, bool ALIGN_EPI = false, bool SP2 = false>
__device__ __forceinline__ void gemm_phase(LAS unsigned char* lds, const Gemm g, const Sched& S, const Epi& E, const int tid) {
    const int wid = __builtin_amdgcn_readfirstlane(tid >> 6), lane = tid & 63, wr = wid >> 2, wc = wid & 3, fr = lane & 15, fq = lane >> 4;
    const int K = g.K, nt = K / BK;
    unsigned voffA[2], voffB[2];
#pragma unroll
    for (int i = 0; i < 2; ++i) { int R, C; stage_rc(tid * 16 + i * 8192, R, C); voffA[i] = (unsigned)(R * K + C) * 2u; voffB[i] = voffA[i]; }
    const size_t kstep = (size_t)(BK * 2);
    const size_t hstep = (size_t)HALF * K * 2;
    const size_t tstep = 2 * hstep;
    const unsigned ldsw = (unsigned)wid * 1024u;
    const int aoff = lds_byte(wr * 64 + fr, fq * 8), boff = lds_byte(wc * 32 + fr, fq * 8);
#define PG8_SA(b, h) (((b) * 2 + (h)) * HTB)
#define PG8_SB(b, h) ((4 + (b) * 2 + (h)) * HTB)
#define PG8_STAGE(bufoff, gbase, voff) do { _Pragma("unroll") for (int _i = 0; _i < 2; ++_i) \
        __builtin_amdgcn_global_load_lds((const unsigned*)((const char*)(gbase) + (voff)[_i]), (LAS unsigned*)(lds + (bufoff) + ldsw + _i * 8192), 16, 0, 0); } while (0)
#define PG8_LDA(dst, b, h) do { _Pragma("unroll") for (int m = 0; m < 4; ++m) _Pragma("unroll") for (int k = 0; k < 2; ++k) dst[m][k] = *(const LAS bf16x8*)(lds + PG8_SA(b, h) + aoff + m * 2048 + k * 1024); } while (0)
#define PG8_LDB(dst, b, h) do { _Pragma("unroll") for (int n = 0; n < 2; ++n) _Pragma("unroll") for (int k = 0; k < 2; ++k) dst[n][k] = *(const LAS bf16x8*)(lds + PG8_SB(b, h) + boff + n * 2048 + k * 1024); } while (0)
#define PG8_MMA(ai, bj, At, Bt) do { __builtin_amdgcn_s_setprio(1); _Pragma("unroll") for (int m = 0; m < 4; ++m) _Pragma("unroll") for (int n = 0; n < 2; ++n) _Pragma("unroll") for (int k = 0; k < 2; ++k) \
        acc[ai][bj][m][n] = __builtin_amdgcn_mfma_f32_16x16x32_bf16(Bt[n][k], At[m][k], acc[ai][bj][m][n], 0, 0, 0); __builtin_amdgcn_s_setprio(0); } while (0)
#define PG8_WAIT_V(n) asm volatile("s_waitcnt vmcnt(" #n ")" ::: "memory")
#define PG8_WAIT_L(n) asm volatile("s_waitcnt lgkmcnt(" #n ")" ::: "memory")
#define PG8_BAR __builtin_amdgcn_s_barrier()
#define PG8_SCHED __builtin_amdgcn_sched_barrier(0)
    Unit cur, nxt; int ui = 0;
    if (!S.next(0, cur)) return;
    f32x4 acc[2][2][4][2];
#pragma unroll
    for (int a = 0; a < 2; ++a)
#pragma unroll
        for (int b = 0; b < 2; ++b)
#pragma unroll
            for (int m = 0; m < 4; ++m)
#pragma unroll
                for (int n = 0; n < 2; ++n) acc[a][b][m][n] = (f32x4){0.f, 0.f, 0.f, 0.f};
    bf16x8 At[4][2], B0[2][2], B1[2][2];
    const char* cA = (const char*)g.A + (size_t)cur.pm * tstep; const char* cB = (const char*)g.Bt + (size_t)cur.pn * tstep;
    S.a_ready(cur);
    if constexpr (SP2) {
        PG8_STAGE(PG8_SB(0, 0), cB, voffB); PG8_STAGE(PG8_SB(0, 1), cB + hstep, voffB); PG8_STAGE(PG8_SA(0, 0), cA, voffA); PG8_STAGE(PG8_SA(0, 1), cA + hstep, voffA);
        if (wr == 1) PG8_BAR;
        PG8_WAIT_V(2); PG8_BAR;
        PG8_STAGE(PG8_SB(1, 0), cB + kstep, voffB); PG8_STAGE(PG8_SA(1, 0), cA + kstep, voffA); PG8_STAGE(PG8_SB(1, 1), cB + hstep + kstep, voffB);
        PG8_WAIT_V(6); PG8_BAR;
    } else {
        PG8_STAGE(PG8_SB(0, 0), cB, voffB); PG8_STAGE(PG8_SA(0, 0), cA, voffA); PG8_STAGE(PG8_SB(0, 1), cB + hstep, voffB); PG8_STAGE(PG8_SA(0, 1), cA + hstep, voffA);
        if (wr == 1) PG8_BAR;
        PG8_WAIT_V(4); PG8_BAR;
        PG8_STAGE(PG8_SB(1, 0), cB + kstep, voffB); PG8_STAGE(PG8_SA(1, 0), cA + kstep, voffA); PG8_STAGE(PG8_SB(1, 1), cB + hstep + kstep, voffB);
        PG8_WAIT_V(6); PG8_BAR;
    }
    for (;;) {
        const bool has_next = S.next(ui + 1, nxt);
        const char* nA = has_next ? (const char*)g.A + (size_t)nxt.pm * tstep : cA; const char* nB = has_next ? (const char*)g.Bt + (size_t)nxt.pn * tstep : cB;
        for (int t = 0; t < nt; t += 2) {
            const bool last = (t == nt - 2);
            const char* a1 = cA + (size_t)(t + 1) * kstep;
            const char* a2 = last ? nA : cA + (size_t)(t + 2) * kstep; const char* b2 = last ? nB : cB + (size_t)(t + 2) * kstep;
            const char* a3 = a2 + kstep; const char* b3 = b2 + kstep;
            if (last && has_next) S.a_ready(nxt);
            if constexpr (SP2) {
            PG8_LDB(B0, 0, 0); PG8_LDB(B1, 0, 1); PG8_SCHED; PG8_LDA(At, 0, 0); PG8_STAGE(PG8_SA(1, 1), a1 + hstep, voffA);
            PG8_WAIT_V(8); PG8_WAIT_L(0); PG8_BAR; PG8_MMA(0, 0, At, B0); PG8_MMA(0, 1, At, B1); PG8_BAR; PG8_SCHED;
            PG8_LDA(At, 0, 1); PG8_STAGE(PG8_SB(0, 0), b2, voffB); PG8_STAGE(PG8_SB(0, 1), b2 + hstep, voffB); PG8_STAGE(PG8_SA(0, 0), a2, voffA);
            PG8_WAIT_V(8); PG8_WAIT_L(0); PG8_BAR; PG8_MMA(1, 0, At, B0); PG8_MMA(1, 1, At, B1); PG8_BAR; PG8_SCHED;
            PG8_LDB(B0, 1, 0); PG8_LDB(B1, 1, 1); PG8_SCHED; PG8_LDA(At, 1, 0); PG8_STAGE(PG8_SA(0, 1), a2 + hstep, voffA);
            PG8_WAIT_V(8); PG8_WAIT_L(0); PG8_BAR; PG8_MMA(0, 0, At, B0); PG8_MMA(0, 1, At, B1); PG8_BAR; PG8_SCHED;
            PG8_LDA(At, 1, 1); PG8_STAGE(PG8_SB(1, 0), b3, voffB); PG8_STAGE(PG8_SB(1, 1), b3 + hstep, voffB); PG8_STAGE(PG8_SA(1, 0), a3, voffA);
            PG8_WAIT_V(8); PG8_WAIT_L(0); PG8_BAR; PG8_MMA(1, 0, At, B0); PG8_MMA(1, 1, At, B1); PG8_BAR; PG8_SCHED;
            } else {
            PG8_LDB(B0, 0, 0); PG8_SCHED; PG8_LDA(At, 0, 0); PG8_STAGE(PG8_SA(1, 1), a1 + hstep, voffA);
            PG8_WAIT_L(8); PG8_BAR; PG8_WAIT_L(0); PG8_MMA(0, 0, At, B0); PG8_BAR; PG8_SCHED;
            PG8_LDB(B1, 0, 1); PG8_STAGE(PG8_SB(0, 0), b2, voffB);
            PG8_BAR; PG8_WAIT_L(0); PG8_MMA(0, 1, At, B1); PG8_BAR;
            PG8_LDA(At, 0, 1); PG8_STAGE(PG8_SA(0, 0), a2, voffA);
            PG8_BAR; PG8_WAIT_L(0); PG8_MMA(1, 0, At, B0); PG8_BAR; PG8_SCHED;
            PG8_STAGE(PG8_SB(0, 1), b2 + hstep, voffB);
            PG8_WAIT_V(6); PG8_BAR; PG8_MMA(1, 1, At, B1); PG8_BAR;
            PG8_LDB(B0, 1, 0); PG8_SCHED; PG8_LDA(At, 1, 0); PG8_STAGE(PG8_SA(0, 1), a2 + hstep, voffA);
            PG8_WAIT_L(8); PG8_BAR; PG8_WAIT_L(0); PG8_MMA(0, 0, At, B0); PG8_BAR; PG8_SCHED;
            PG8_LDB(B1, 1, 1); PG8_STAGE(PG8_SB(1, 0), b3, voffB);
            PG8_BAR; PG8_WAIT_L(0); PG8_MMA(0, 1, At, B1); PG8_BAR;
            PG8_LDA(At, 1, 1); PG8_STAGE(PG8_SA(1, 0), a3, voffA);
            PG8_BAR; PG8_WAIT_L(0); PG8_MMA(1, 0, At, B0); PG8_BAR; PG8_SCHED;
            PG8_STAGE(PG8_SB(1, 1), b3 + hstep, voffB);
            PG8_WAIT_V(6); PG8_BAR; PG8_MMA(1, 1, At, B1); PG8_BAR;
            }
        }
        if constexpr (ALIGN_EPI) { if (wr == 0) PG8_BAR; }
        E(acc, cur, wr, wc, fr, fq); S.done(cur);
        if (!has_next) break;
#pragma unroll
        for (int a = 0; a < 2; ++a)
#pragma unroll
            for (int b = 0; b < 2; ++b)
#pragma unroll
                for (int m = 0; m < 4; ++m)
#pragma unroll
                    for (int n = 0; n < 2; ++n) acc[a][b][m][n] = (f32x4){0.f, 0.f, 0.f, 0.f};
        cur = nxt; cA = nA; cB = nB; ++ui;
        if constexpr (ALIGN_EPI) { if (wr == 1) PG8_BAR; }
    }
    PG8_WAIT_V(0);
    if constexpr (!ALIGN_EPI) { if (wr == 0) PG8_BAR; }
    PG8_BAR;
#undef PG8_SA
#undef PG8_SB
#undef PG8_STAGE
#undef PG8_LDA
#undef PG8_LDB
#undef PG8_MMA
#undef PG8_WAIT_V
#undef PG8_WAIT_L
#undef PG8_BAR
#undef PG8_SCHED
}
}

__device__ __forceinline__ int colmap_in(int np) {
    const int pn = np >> 8, c = np & 255;
    const int bj = c >> 7, wc = (c >> 5) & 3, n = (c >> 4) & 1, fq = (c >> 2) & 3, j = c & 3;
    const int cnat = 128 * bj + 32 * wc + 8 * fq + 4 * n + j;
    const int d64 = 16 * fq + 8 * bj + 4 * n + j;
    const int d128 = 64 * bj + 32 * (wc & 1) + 8 * fq + 4 * n + j;
    if (pn <= 1) return 64 * (4 * pn + wc) + d64;
    if (pn == 2) return (wc < 2 ? 512 + 64 * wc : 640 + 64 * (wc - 2)) + d64;
    if (pn <= 4) return 768 + 256 * (pn - 3) + cnat;
    if (pn <= 6) return 1280 + 128 * (2 * (pn - 5) + (wc >> 1)) + d128;
    if (pn <= 8) return 1792 + 128 * (2 * (pn - 7) + (wc >> 1)) + d128;
    if (pn <= 10) return 2304 + 256 * (pn - 9) + cnat;
    return 2816 + 256 * (pn - 11) + cnat;
}
__device__ __forceinline__ int colmap_out(int np) {
    const int pn = np >> 8, c = np & 255;
    const int bj = c >> 7, wc = (c >> 5) & 3, n = (c >> 4) & 1, fq = (c >> 2) & 3, j = c & 3;
    return 256 * pn + 128 * bj + 32 * wc + 8 * fq + 4 * n + j;
}

__device__ __forceinline__ int cm_c64(int d, int wc) { return 128 * ((d >> 3) & 1) + 32 * wc + 16 * ((d >> 2) & 1) + 4 * (d >> 4) + (d & 3); }
__device__ __forceinline__ int cm_nat(int x) { return 128 * (x >> 7) + 32 * ((x >> 5) & 3) + 16 * ((x >> 2) & 1) + 4 * ((x >> 3) & 3) + (x & 3); }
__device__ __forceinline__ int cm_c128(int d, int hsel) { return 128 * (d >> 6) + 32 * (2 * hsel + ((d >> 5) & 1)) + 16 * ((d >> 2) & 1) + 4 * ((d >> 3) & 3) + (d & 3); }
__device__ __forceinline__ int colinv_in(int col) {
    if (col < 512) { const int head = col >> 6; return 256 * (head >> 2) + cm_c64(col & 63, head & 3); }
    if (col < 640) { const int o = col - 512; return 512 + cm_c64(o & 63, o >> 6); }
    if (col < 768) { const int o = col - 640; return 512 + cm_c64(o & 63, 2 + (o >> 6)); }
    if (col < 1280) { const int o = col - 768; return 256 * (3 + (o >> 8)) + cm_nat(o & 255); }
    if (col < 1792) { const int o = col - 1280, head = o >> 7; return 256 * (5 + (head >> 1)) + cm_c128(o & 127, head & 1); }
    if (col < 2304) { const int o = col - 1792, head = o >> 7; return 256 * (7 + (head >> 1)) + cm_c128(o & 127, head & 1); }
    if (col < 2816) { const int o = col - 2304; return 256 * (9 + (o >> 8)) + cm_nat(o & 255); }
    const int o = col - 2816; return 256 * (11 + (o >> 8)) + cm_nat(o & 255);
}
__device__ __forceinline__ int colinv_out(int col) { return 256 * (col >> 8) + cm_nat(col & 255); }
struct EpiIn {
    bf16_t* P; const float* rowss; const float* qg; const float* kg; const float* tabA; const float* tabB;
    float* kp; float* vp; float* ks; float* vs;
    __device__ __forceinline__ void operator()(const f32x4 (&acc)[2][2][4][2], const pg8::Unit& u, int wr, int wc, int fr, int fq) const {
        const int pn = u.pn;
        const int rowb = u.pm * 256 + wr * 64 + fr;
        float rr[2][4];
#pragma unroll
        for (int ai = 0; ai < 2; ++ai)
#pragma unroll
            for (int m = 0; m < 4; ++m) rr[ai][m] = rowss[rowb + ai * 128 + m * 16];
        if (pn <= 2) {
            const bool isv = (pn == 2 && wc >= 2), isk = (pn == 2 && wc < 2);
            const int head = (pn == 2) ? (wc & 1) : 4 * pn + wc;
            const int colbase = ((pn == 2) ? (isv ? 640 : 512) : 0) + 64 * head + 16 * fq;
            const float* gp = isk ? kg : qg;
#pragma unroll
            for (int am = 0; am < 4; ++am) {
                const int ai = am >> 1;
                f32x4 ca[4][2], sa[4][2];
                if (!isv) {
#pragma unroll
                    for (int m = 2 * (am & 1); m < 2 * (am & 1) + 2; ++m) {
                        const int row = rowb + ai * 128 + m * 16;
                        const int pos = (row < MP) ? (row & 8191) : (8192 + ((row - MP) & 3));
#pragma unroll
                        for (int n = 0; n < 2; ++n) { ca[m][n] = *(const f32x4*)(tabA + pos * 16 + 4 * n); sa[m][n] = *(const f32x4*)(tabA + pos * 16 + 8 + 4 * n); }
                    }
                }
#pragma unroll
                for (int m = 2 * (am & 1); m < 2 * (am & 1) + 2; ++m) {
                    const int row = rowb + ai * 128 + m * 16;
                    const float r = rsqrtf(rr[ai][m] * (1.0f / 1024.0f) + 1e-6f);
                    const int pos = (row < MP) ? (row & 8191) : (8192 + ((row - MP) & 3));
                    f32x4 v[2][2];
#pragma unroll
                    for (int bj = 0; bj < 2; ++bj)
#pragma unroll
                        for (int n = 0; n < 2; ++n) v[bj][n] = acc[ai][bj][m][n] * r;
                    if (!isv) {
                        float ss = 0.f;
#pragma unroll
                        for (int bj = 0; bj < 2; ++bj)
#pragma unroll
                            for (int n = 0; n < 2; ++n) { const f32x4 x = v[bj][n]; ss += (x[0] * x[0] + x[1] * x[1]) + (x[2] * x[2] + x[3] * x[3]); }
                        ss += shx(ss, 16, (fq * 16 + fr)); ss += shx(ss, 32, (fq * 16 + fr));
                        const float rn = rsqrtf(ss * (1.0f / 64.0f) + 1e-6f);
#pragma unroll
                        for (int bj = 0; bj < 2; ++bj)
#pragma unroll
                            for (int n = 0; n < 2; ++n) v[bj][n] = v[bj][n] * rn * *(const f32x4*)(gp + 16 * fq + 8 * bj + 4 * n);
                        if (fq == 0) {
#pragma unroll
                            for (int n = 0; n < 2; ++n) {
                                const f32x4 c = ca[m][n], s = sa[m][n];
                                const f32x4 x1 = v[0][n], x2 = v[1][n];
                                v[0][n] = x1 * c - x2 * s; v[1][n] = x2 * c + x1 * s;
                            }
                        }
                    }
                    if (pn == 2) {
                        float* dst = nullptr;
                        if (row < MP) { if (pos >= SEQ - 128) dst = (isv ? vp : kp) + ((((row >> 13) * 128 + (pos - (SEQ - 128))) * 2 + head) * 64 + 16 * fq); }
                        else { const int sr = row - MP; dst = (isv ? vs : ks) + ((((sr >> 2) * 128 + 124 + (sr & 3)) * 2 + head) * 64 + 16 * fq); }
                        if (dst) {
#pragma unroll
                            for (int bj = 0; bj < 2; ++bj)
#pragma unroll
                                for (int n = 0; n < 2; ++n) *(f32x4*)(dst + 8 * bj + 4 * n) = v[bj][n];
                        }
                    }
                    bf16_t* pp = P + (size_t)row * NIN + colbase;
                    if (pn < 2) {
#pragma unroll
                        for (int bj = 0; bj < 2; ++bj)
#pragma unroll
                            for (int n = 0; n < 2; ++n) v[bj][n] = v[bj][n] * (0.125f * LOG2E);
                    }
#pragma unroll
                    for (int bj = 0; bj < 2; ++bj) {
                        u32x4 w; w.x = pk(v[bj][0][0], v[bj][0][1]); w.y = pk(v[bj][0][2], v[bj][0][3]);
                        w.z = pk(v[bj][1][0], v[bj][1][1]); w.w = pk(v[bj][1][2], v[bj][1][3]);
                        *(u32x4*)(pp + 8 * bj) = w;
                    }
                }
            }
        } else if (pn <= 4 || pn >= 9) {
            const bool silu = (pn <= 4 || pn >= 11);
            const int colbase = (pn <= 4 ? 768 + 256 * (pn - 3) : (pn <= 10 ? 2304 + 256 * (pn - 9) : 2816 + 256 * (pn - 11))) + 32 * wc + 8 * fq;
#pragma unroll
            for (int ai = 0; ai < 2; ++ai)
#pragma unroll
                for (int m = 0; m < 4; ++m) {
                    const int row = rowb + ai * 128 + m * 16;
                    const float r = rsqrtf(rr[ai][m] * (1.0f / 1024.0f) + 1e-6f);
                    bf16_t* pp = P + (size_t)row * NIN + colbase;
#pragma unroll
                    for (int bj = 0; bj < 2; ++bj) {
                        f32x4 v0 = acc[ai][bj][m][0] * r, v1 = acc[ai][bj][m][1] * r;
                        if (silu) {
#pragma unroll
                            for (int e = 0; e < 4; ++e) { v0[e] = v0[e] * __builtin_amdgcn_rcpf(1.0f + ex2(-v0[e] * LOG2E)); v1[e] = v1[e] * __builtin_amdgcn_rcpf(1.0f + ex2(-v1[e] * LOG2E)); }
                        }
                        u32x4 w; w.x = pk(v0[0], v0[1]); w.y = pk(v0[2], v0[3]); w.z = pk(v1[0], v1[1]); w.w = pk(v1[2], v1[3]);
                        *(u32x4*)(pp + 128 * bj) = w;
                    }
                }
        } else {
            const bool isk = pn >= 7;
            const int head = 2 * ((pn - 5) & 1) + (wc >> 1), hh = wc & 1;
            const int colbase = (isk ? 1792 : 1280) + 128 * head + 32 * hh + 8 * fq;
            const float post = __builtin_bit_cast(float, __builtin_amdgcn_readfirstlane(isk ? 0x3db504f3 : 0x3f800000));
#pragma unroll
            for (int am = 0; am < 4; ++am) {
                const int ai = am >> 1;
                f32x4 cc[4][2], sn[4][2];
#pragma unroll
                for (int m = 2 * (am & 1); m < 2 * (am & 1) + 2; ++m) {
                    const int row = rowb + ai * 128 + m * 16;
                    const int pos = (row < MP) ? (row & 8191) : (8192 + ((row - MP) & 3));
                    const float* tb = tabB + pos * 128 + 32 * hh + 8 * fq;
#pragma unroll
                    for (int n = 0; n < 2; ++n) { cc[m][n] = *(const f32x4*)(tb + 4 * n); sn[m][n] = *(const f32x4*)(tb + 64 + 4 * n); }
                }
#pragma unroll
                for (int m = 2 * (am & 1); m < 2 * (am & 1) + 2; ++m) {
                    const int row = rowb + ai * 128 + m * 16;
                    const float r = rsqrtf(rr[ai][m] * (1.0f / 1024.0f) + 1e-6f) * post;
                    f32x4 y1[2], y2[2];
#pragma unroll
                    for (int n = 0; n < 2; ++n) {
                        const f32x4 c = cc[m][n], s = sn[m][n];
                        const f32x4 x1 = acc[ai][0][m][n] * r, x2 = acc[ai][1][m][n] * r;
                        y1[n] = x1 * c - x2 * s; y2[n] = x2 * c + x1 * s;
                    }
                    bf16_t* pp = P + (size_t)row * NIN + colbase;
                    u32x4 w; w.x = pk(y1[0][0], y1[0][1]); w.y = pk(y1[0][2], y1[0][3]); w.z = pk(y1[1][0], y1[1][1]); w.w = pk(y1[1][2], y1[1][3]);
                    *(u32x4*)pp = w;
                    w.x = pk(y2[0][0], y2[0][1]); w.y = pk(y2[0][2], y2[0][3]); w.z = pk(y2[1][0], y2[1][1]); w.w = pk(y2[1][2], y2[1][3]);
                    *(u32x4*)(pp + 64) = w;
                }
            }
        }
    }
};

struct EpiOut {
    const float* xin_p; const float* xin_s;
    float* xout;
    const bf16_t* XBi; bf16_t* XB; float* rowss_next;
    __device__ __forceinline__ void operator()(const f32x4 (&acc)[2][2][4][2], const pg8::Unit& u, int wr, int wc, int fr, int fq) const {
        const int rowb = u.pm * 256 + wr * 64 + fr;
        const int colb = u.pn * 256 + 32 * wc + 8 * fq;
        const bool f32in = (xin_p != nullptr), last = (xout != nullptr);
#pragma unroll
        for (int ai = 0; ai < 2; ++ai) {
            f32x4 pre[4][2][2];
            if (f32in) {
#pragma unroll
                for (int m = 0; m < 4; ++m) { const int row = rowb + ai * 128 + m * 16;
                    const float* xr = (row < MP) ? xin_p + (size_t)row * DM : xin_s + (size_t)(row - MP) * DM;
#pragma unroll
                    for (int bj = 0; bj < 2; ++bj) { pre[m][bj][0] = *(const f32x4*)(xr + colb + 128 * bj); pre[m][bj][1] = *(const f32x4*)(xr + colb + 128 * bj + 4); } }
            } else {
                u32x4 pb[4][2];
#pragma unroll
                for (int m = 0; m < 4; ++m) { const int row = rowb + ai * 128 + m * 16;
#pragma unroll
                    for (int bj = 0; bj < 2; ++bj) pb[m][bj] = *(const u32x4*)(XBi + (size_t)row * DM + colb + 128 * bj); }
#pragma unroll
                for (int m = 0; m < 4; ++m)
#pragma unroll
                    for (int bj = 0; bj < 2; ++bj) { const u32x4 w = pb[m][bj];
                        pre[m][bj][0] = (f32x4){bflo(w.x), bfhi(w.x), bflo(w.y), bfhi(w.y)}; pre[m][bj][1] = (f32x4){bflo(w.z), bfhi(w.z), bflo(w.w), bfhi(w.w)}; }
            }
#pragma unroll
            for (int m = 0; m < 4; ++m) {
                const int row = rowb + ai * 128 + m * 16;
                float ss = 0.f;
#pragma unroll
                for (int bj = 0; bj < 2; ++bj) {
                    const int col = colb + 128 * bj;
                    const f32x4 v0 = pre[m][bj][0] + acc[ai][bj][m][0], v1 = pre[m][bj][1] + acc[ai][bj][m][1];
                    if (last) { *(f32x4*)(xout + (size_t)row * DM + col) = v0; *(f32x4*)(xout + (size_t)row * DM + col + 4) = v1; }
                    else {
                        u32x4 w; w.x = pk(v0[0], v0[1]); w.y = pk(v0[2], v0[3]); w.z = pk(v1[0], v1[1]); w.w = pk(v1[2], v1[3]);
                        *(u32x4*)(XB + (size_t)row * DM + col) = w;
                        ss += (v0[0] * v0[0] + v0[1] * v0[1]) + (v0[2] * v0[2] + v0[3] * v0[3]) + (v1[0] * v1[0] + v1[1] * v1[1]) + (v1[2] * v1[2] + v1[3] * v1[3]);
                    }
                }
                if (!last) { ss += shx(ss, 16, (fq * 16 + fr)); ss += shx(ss, 32, (fq * 16 + fr)); if (fq == 0) atomicAdd(rowss_next + row, ss); }
            }
        }
    }
};
struct OneUnit {
    int pm, pn;
    __device__ __forceinline__ bool next(int i, pg8::Unit& u) const { if (i > 0) return false; u.pm = pm; u.pn = pn; return true; }
    __device__ __forceinline__ void a_ready(const pg8::Unit&) const {}
    __device__ __forceinline__ void done(const pg8::Unit&) const {}
};

__device__ __forceinline__ void p0_transpose_item(const float* W, int K, int N, const float* g, bf16_t* WT, bool is_in, LAS float* scr, int item, int lane) {
    const int nblk = N / 32, kb = item / nblk, nb = item % nblk, k0 = 64 * kb, s0 = 32 * nb;
    float tw[32];
#pragma unroll
    for (int i = 0; i < 32; ++i) tw[i] = W[(size_t)(k0 + 2 * i + (lane >> 5)) * N + s0 + (lane & 31)];
#pragma unroll
    for (int i = 0; i < 32; ++i) { const int kk = 2 * i + (lane >> 5); const float gvv = g ? g[k0 + kk] : 1.0f; scr[kk * 33 + (lane & 31)] = tw[i] * gvv; }
    asm volatile("s_waitcnt lgkmcnt(0)" ::: "memory");
    const int c = lane & 7;
#pragma unroll
    for (int j = 0; j < 4; ++j) { const int n = (lane >> 3) + 8 * j; const LAS float* s = scr + (8 * c) * 33 + n;
        const int drow = is_in ? colinv_in(s0 + n) : colinv_out(s0 + n);
        u32x4 o; o.x = pk(s[0 * 33], s[1 * 33]); o.y = pk(s[2 * 33], s[3 * 33]); o.z = pk(s[4 * 33], s[5 * 33]); o.w = pk(s[6 * 33], s[7 * 33]);
        *(u32x4*)(WT + (size_t)drow * K + k0 + 8 * c) = o; }
    asm volatile("s_waitcnt lgkmcnt(0)" ::: "memory");
}
__device__ __forceinline__ void sincos_d(double x, double& s, double& c) {
    const double kd = __builtin_rint(x * 0.63661977236758134308);
    const double r = (x - kd * 1.57079632673412561417e+00) - kd * 6.07710050650619224932e-11;
    const int k = ((int)kd) & 3;
    const double r2 = r * r;
    const double sp = r * (1.0 + r2 * (-1.0 / 6.0 + r2 * (1.0 / 120.0 + r2 * (-1.0 / 5040.0 + r2 * (1.0 / 362880.0 + r2 * (-1.0 / 39916800.0 + r2 * (1.0 / 6227020800.0)))))));
    const double cp = 1.0 + r2 * (-0.5 + r2 * (1.0 / 24.0 + r2 * (-1.0 / 720.0 + r2 * (1.0 / 40320.0 + r2 * (-1.0 / 3628800.0 + r2 * (1.0 / 479001600.0 + r2 * (-1.0 / 87178291200.0)))))));
    s = (k == 0) ? sp : (k == 1) ? cp : (k == 2) ? -sp : -cp;
    c = (k == 0) ? cp : (k == 1) ? -sp : (k == 2) ? -cp : sp;
}

struct Args { const float* in[11]; float* out; unsigned char* ws; double baseA, baseB; int ph_lo, ph_hi; };

__device__ __forceinline__ void p0_prologue(const Args& a, LAS unsigned char* lds, int tid, int G) {
    const int lane = tid & 63, wave = tid >> 6;
    LAS float* scr = (LAS float*)(lds + wave * 16384);
    const int gw = blockIdx.x * 8 + wave, NGW = G * 8;
    unsigned char* ws = a.ws;
    constexpr int I_IN = (DM / 64) * (NIN / 32), I_OUT = (DM / 64) * (DM / 32);
    for (int it = gw; it < DEPTH * (I_IN + I_OUT); it += NGW) {
        const int l = it / (I_IN + I_OUT); int r = it - l * (I_IN + I_OUT);
        if (r < I_IN) p0_transpose_item(a.in[5] + (size_t)l * DM * NIN, DM, NIN, a.in[7] + l * DM, (bf16_t*)(ws + WS_WIN) + (size_t)l * NIN * DM, true, scr, r, lane);
        else p0_transpose_item(a.in[6] + (size_t)l * DM * DM, DM, DM, nullptr, (bf16_t*)(ws + WS_WOUT) + (size_t)l * DM * DM, false, scr, r - I_IN, lane);
    }
    float* rowss = (float*)(ws + WS_ROWSS);
    bf16_t* XB = (bf16_t*)(ws + WS_XB);
    for (int m0 = gw; m0 < MT; m0 += 4 * NGW) {
        f32x4 v[4][4];
#pragma unroll
        for (int q = 0; q < 4; ++q) { const int m = m0 + q * NGW; if (m < MT) { const float* xr = (m < MP) ? a.in[0] + (size_t)m * DM : a.in[1] + (size_t)(m - MP) * DM;
#pragma unroll
            for (int j = 0; j < 4; ++j) v[q][j] = *(const f32x4*)(xr + 4 * lane + 256 * j); } }
#pragma unroll
        for (int q = 0; q < 4; ++q) { const int m = m0 + q * NGW; if (m < MT) {
            float s = 0.f;
#pragma unroll
            for (int j = 0; j < 4; ++j) { const f32x4 x = v[q][j]; s += (x[0] * x[0] + x[1] * x[1]) + (x[2] * x[2] + x[3] * x[3]);
                u32x2 w; w.x = pk(x[0], x[1]); w.y = pk(x[2], x[3]); *(u32x2*)(XB + (size_t)m * DM + 4 * lane + 256 * j) = w; }
#pragma unroll
            for (int o = 1; o < 64; o <<= 1) s += shx(s, o, lane);
            if (lane == 0) rowss[m] = s; } }
    }
    const int gt = blockIdx.x * 512 + tid, NGT = G * 512;
    for (int i = gt; i < 3 * MT; i += NGT) rowss[MT + i] = 0.f;
    float* tabB = (float*)(ws + WS_TABB); float* tabA = (float*)(ws + WS_TABA);
    for (int idx = gt; idx < NPOS * 72; idx += NGT) {
        const int pos = idx / 72, i = idx - pos * 72;
        const bool isB = i < 64; const int ii = isB ? i : i - 64; const double base = isB ? a.baseB : a.baseA;
        double p = 1.0; for (int k = 0; k < ii; ++k) p *= base;
        const float inv = (float)p; const float ang = (float)pos * inv;
        double s, c; sincos_d((double)ang, s, c);
        if (isB) { tabB[pos * 128 + ii] = (float)c; tabB[pos * 128 + 64 + ii] = (float)s; }
        else { tabA[pos * 16 + ii] = (float)c; tabA[pos * 16 + 8 + ii] = (float)s; }
    }
}


__device__ __forceinline__ void tr_write_sw(LAS bf16_t* img, int RS, int c8, int SM, int tok, u32x4 vv, int XL, int lane) {
    const bool odd = tok & 1;
    const unsigned s0 = odd ? vv.x : vv.z, s1 = odd ? vv.y : vv.w;
    const unsigned r0 = (unsigned)shxi((int)s0, XL, lane), r1 = (unsigned)shxi((int)s1, XL, lane);
    const unsigned a0 = odd ? r0 : vv.x, a1 = odd ? r1 : vv.y, b0 = odd ? vv.z : r0, b1 = odd ? vv.w : r1;
    LAS unsigned* p = (LAS unsigned*)(img + (8 * c8 + (odd ? 4 : 0)) * RS + ((((tok >> 3) ^ (c8 & SM)) << 3) + (tok & 6)));
    const int rs2 = RS >> 1;
    p[0] = (a0 & 0xffffu) | (b0 << 16); p[rs2] = (a0 >> 16) | (b0 & 0xffff0000u);
    p[2 * rs2] = (a1 & 0xffffu) | (b1 << 16); p[3 * rs2] = (a1 >> 16) | (b1 & 0xffff0000u);
}
__device__ __forceinline__ int sw_off(int d, int RS, int SM, int t0) { return d * RS + ((((t0 >> 3) ^ ((d >> 3) & SM)) << 3) + (t0 & 7)); }
struct AttnRegs { u32x4 kv[4], vv[4]; float sink; };
__device__ __forceinline__ void attn_load(AttnRegs& R, const bf16_t* P, int unit, int tid) {
    const int g = unit & 1, qb = (unit >> 1) & 63, n = unit >> 7;
    const int R0 = n * SEQ + qb * 128;
    const int lane = tid & 63, w = tid >> 6, fr = lane & 15, fq = lane >> 4;
#pragma unroll
    for (int i = 0; i < 4; ++i) {
        const int ch = tid + 512 * i, key = ch >> 3, c8 = ch & 7;
        R.kv[i] = (u32x4){0u, 0u, 0u, 0u};
        if (qb > 0 || key >= 128) R.kv[i] = *(const u32x4*)(P + (size_t)(R0 - 128 + key) * NIN + 512 + 64 * g + 8 * c8);
    }
#pragma unroll
    for (int i = 0; i < 4; ++i) { const int key = (tid >> 3) + 64 * i, c8 = tid & 7; R.vv[i] = (u32x4){0u, 0u, 0u, 0u};
        if (qb > 0 || key >= 128) R.vv[i] = *(const u32x4*)(P + (size_t)(R0 - 128 + key) * NIN + 640 + 64 * g + 8 * c8); }
}
__device__ __forceinline__ void attn_compute(LAS unsigned char* lds, const AttnRegs& R, const bf16_t* P, bf16_t* MIX, const float* sinks_l, int unit, int tid) {
    const int g = unit & 1, qb = (unit >> 1) & 63, n = unit >> 7;
    const int R0 = n * SEQ + qb * 128;
    LAS bf16_t* Ks = (LAS bf16_t*)lds;
    LAS bf16_t* Vt = (LAS bf16_t*)(lds + 256 * 144);
    const int lane = tid & 63, w = tid >> 6, fr = lane & 15, fq = lane >> 4;
    const int head = 4 * g + (w >> 1);
#pragma unroll
    for (int i = 0; i < 4; ++i) {
        const int ch = tid + 512 * i, key = ch >> 3, c8 = ch & 7;
        *(LAS u32x4*)(Ks + key * 72 + 8 * c8) = R.kv[i];
    }
#pragma unroll
    for (int i = 0; i < 4; ++i) tr_write_sw(Vt, 264, tid & 7, 7, (tid >> 3) + 64 * i, R.vv[i], 8, tid);
    __syncthreads();
    const float sink2 = sinks_l[head] * LOG2E;
#pragma unroll 1
    for (int qt = 0; qt < 4; ++qt) {
        const int qi = 64 * (w & 1) + 16 * qt + fr;
        const int row = R0 + qi;
        const bf16_t* qp = P + (size_t)row * NIN + 64 * head + 8 * fq;
        const bf16x8 bq0 = *(const bf16x8*)qp, bq1 = *(const bf16x8*)(qp + 32);
        u32x2 gts[4];
#pragma unroll
        for (int dt = 0; dt < 4; ++dt) gts[dt] = *(const u32x2*)(P + (size_t)row * NIN + 768 + 64 * head + 16 * dt + 4 * fq);
        f32x4 s[16];
#pragma unroll
        for (int kt = 0; kt < 16; ++kt) {
            const LAS bf16_t* kr = Ks + (16 * kt + fr) * 72 + 8 * fq;
            const bf16x8 a0 = *(const LAS bf16x8*)kr, a1 = *(const LAS bf16x8*)(kr + 32);
            f32x4 z = (f32x4){0.f, 0.f, 0.f, 0.f};
            z = __builtin_amdgcn_mfma_f32_16x16x32_bf16(a0, bq0, z, 0, 0, 0);
            s[kt] = __builtin_amdgcn_mfma_f32_16x16x32_bf16(a1, bq1, z, 0, 0, 0);
            if ((kt & 3) == 3) __builtin_amdgcn_sched_barrier(0);
        }
        float mx = -INFINITY;
#pragma unroll
        for (int kt = 0; kt < 16; ++kt)
#pragma unroll
            for (int r = 0; r < 4; ++r) {
                const int key = 16 * kt + 4 * fq + r;
                const bool valid = (kt < 8) ? (qb > 0 && key > qi) : (key - 128 <= qi);
                const float x = valid ? s[kt][r] : -INFINITY; s[kt][r] = x; mx = fmaxf(mx, x);
            }
        mx = fmaxf(mx, shx(mx, 16, lane)); mx = fmaxf(mx, shx(mx, 32, lane)); mx = fmaxf(mx, sink2);
        float sum = 0.f;
#pragma unroll
        for (int kt = 0; kt < 16; ++kt)
#pragma unroll
            for (int r = 0; r < 4; ++r) { const float p = ex2(s[kt][r] - mx); s[kt][r] = p; sum += p; }
        sum += shx(sum, 16, lane); sum += shx(sum, 32, lane); sum += ex2(sink2 - mx);
        f32x4 o[4];
#pragma unroll
        for (int dt = 0; dt < 4; ++dt) o[dt] = (f32x4){0.f, 0.f, 0.f, 0.f};
#pragma unroll
        for (int k2 = 0; k2 < 8; ++k2) {
            u32x4 pw; pw.x = pk(s[2 * k2][0], s[2 * k2][1]); pw.y = pk(s[2 * k2][2], s[2 * k2][3]); pw.z = pk(s[2 * k2 + 1][0], s[2 * k2 + 1][1]); pw.w = pk(s[2 * k2 + 1][2], s[2 * k2 + 1][3]);
            const bf16x8 pb = __builtin_bit_cast(bf16x8, pw);
#pragma unroll
            for (int dt = 0; dt < 4; ++dt) {
                const u32x2 lo = *(const LAS u32x2*)(Vt + sw_off(16 * dt + fr, 264, 7, 32 * k2 + 4 * fq)), hi = *(const LAS u32x2*)(Vt + sw_off(16 * dt + fr, 264, 7, 32 * k2 + 16 + 4 * fq));
                const u32x4 aw = (u32x4){lo.x, lo.y, hi.x, hi.y};
                o[dt] = __builtin_amdgcn_mfma_f32_16x16x32_bf16(__builtin_bit_cast(bf16x8, aw), pb, o[dt], 0, 0, 0);
            }
        }
        const float inv = 1.0f / sum;
#pragma unroll
        for (int dt = 0; dt < 4; ++dt) {
            const u32x2 gt = gts[dt];
            u32x2 wv; wv.x = pk(o[dt][0] * inv * bflo(gt.x), o[dt][1] * inv * bfhi(gt.x)); wv.y = pk(o[dt][2] * inv * bflo(gt.y), o[dt][3] * inv * bfhi(gt.y));
            *(u32x2*)(MIX + (size_t)row * DM + 64 * head + 16 * dt + 4 * fq) = wv;
        }
    }
    __syncthreads();
}

struct UcRegs { u32x4 kv[4], vv[4]; };
__device__ __forceinline__ void uc_load(UcRegs& R, const bf16_t* P, int unit, int tid) {
    const int h = unit & 3, c = (unit >> 2) & 63, n = unit >> 8;
    const int R0 = n * SEQ + c * 128;
#pragma unroll
    for (int i = 0; i < 4; ++i) { const int j = (tid >> 4) + 32 * i, c8 = tid & 15; const bf16_t* pr = P + (size_t)(R0 + j) * NIN + 128 * h + 8 * c8;
        R.kv[i] = *(const u32x4*)(pr + 1792); R.vv[i] = *(const u32x4*)(pr + 2304); }
}
__device__ __forceinline__ void uc_compute(LAS unsigned char* lds, const UcRegs& R, float* UT, int unit, int tid) {
    const int h = unit & 3;
    const float l2g = l2gamma(h);
    LAS bf16_t* Kt = (LAS bf16_t*)lds;
    LAS bf16_t* Vt = (LAS bf16_t*)(lds + 128 * 272);
    const int lane = tid & 63, w = tid >> 6, fr = lane & 15, fq = lane >> 4;
#pragma unroll
    for (int i = 0; i < 4; ++i) { const int j = (tid >> 4) + 32 * i, c8 = tid & 15; const u32x4 kv = R.kv[i];
        const float dec = ex2((float)(127 - j) * l2g);
        u32x4 kd; kd.x = pk(bflo(kv.x) * dec, bfhi(kv.x) * dec); kd.y = pk(bflo(kv.y) * dec, bfhi(kv.y) * dec);
        kd.z = pk(bflo(kv.z) * dec, bfhi(kv.z) * dec); kd.w = pk(bflo(kv.w) * dec, bfhi(kv.w) * dec);
        tr_write_sw(Kt, 136, c8, 15, j, kd, 16, tid); tr_write_sw(Vt, 136, c8, 15, j, R.vv[i], 16, tid); }
    __syncthreads();
    const int mt0 = 2 * (w & 3), nt0 = 4 * (w >> 2);
    f32x4 acc[2][4];
#pragma unroll
    for (int mi = 0; mi < 2; ++mi)
#pragma unroll
        for (int ni = 0; ni < 4; ++ni) acc[mi][ni] = (f32x4){0.f, 0.f, 0.f, 0.f};
#pragma unroll
    for (int ks = 0; ks < 4; ++ks) {
        bf16x8 af[2], bfr[4];
#pragma unroll
        for (int mi = 0; mi < 2; ++mi) af[mi] = *(const LAS bf16x8*)(Kt + sw_off(16 * (mt0 + mi) + fr, 136, 15, 32 * ks + 8 * fq));
#pragma unroll
        for (int ni = 0; ni < 4; ++ni) bfr[ni] = *(const LAS bf16x8*)(Vt + sw_off(16 * (nt0 + ni) + fr, 136, 15, 32 * ks + 8 * fq));
#pragma unroll
        for (int mi = 0; mi < 2; ++mi)
#pragma unroll
            for (int ni = 0; ni < 4; ++ni) acc[mi][ni] = __builtin_amdgcn_mfma_f32_16x16x32_bf16(af[mi], bfr[ni], acc[mi][ni], 0, 0, 0);
    }
    float* ub = UT + (size_t)unit * 16384;
#pragma unroll
    for (int mi = 0; mi < 2; ++mi)
#pragma unroll
        for (int ni = 0; ni < 4; ++ni) *(f32x4*)(ub + (16 * (nt0 + ni) + fr) * 128 + 16 * (mt0 + mi) + 4 * fq) = acc[mi][ni];
    __syncthreads();
}

__device__ __forceinline__ void sattn_unit(LAS unsigned char* lds, const bf16_t* P, bf16_t* MIX, const float* ck, const float* cv, float* kso, float* vso, const float* sinks_l, int unit, int tid) {
    const int n = unit >> 1, g = unit & 1;
    LAS float* Kc = (LAS float*)lds;
    LAS float* Vc = Kc + 132 * 68;
    LAS float* Qs = Vc + 132 * 68;
    LAS float* Sc = Qs + 1024;
    const float sink_pre = sinks_l[4 * g + ((tid >> 5) & 3)];
    bf16_t gate_pre[4];
    {
        const int lane_ = tid & 63, w_ = tid >> 6, d_ = 16 * (w_ & 3) + (lane_ & 15);
        const bf16_t* gp_ = P + (size_t)(MP + 4 * n + (lane_ >> 4)) * NIN + 768 + 64 * 4 * g + d_;
#pragma unroll
        for (int r = 0; r < 4; ++r) gate_pre[r] = gp_[64 * r];
    }
#pragma unroll
    for (int i = 0; i < 4; ++i) {
        const int ch = tid + 512 * i, wp = ch >> 4, c4 = ch & 15;
        const size_t src = (size_t)((n * 128 + wp) * 2 + g) * 64 + 4 * c4;
        const f32x4 kv = __builtin_nontemporal_load((const f32x4*)(ck + src)), vv = __builtin_nontemporal_load((const f32x4*)(cv + src));
        *(LAS f32x4*)(Kc + wp * 68 + 4 * c4) = kv; *(LAS f32x4*)(Vc + wp * 68 + 4 * c4) = vv;
        if (wp >= 4) { const size_t dst = (size_t)((n * 128 + wp - 4) * 2 + g) * 64 + 4 * c4; __builtin_nontemporal_store(kv, (f32x4*)(kso + dst)); __builtin_nontemporal_store(vv, (f32x4*)(vso + dst)); }
    }
    if (tid < 64) {
        const int t = tid >> 4, c4 = tid & 15;
        const size_t src = (size_t)((n * 128 + 124 + t) * 2 + g) * 64 + 4 * c4;
        *(LAS f32x4*)(Kc + (128 + t) * 68 + 4 * c4) = *(const f32x4*)(kso + src); *(LAS f32x4*)(Vc + (128 + t) * 68 + 4 * c4) = *(const f32x4*)(vso + src);
    }
    const int qi = tid >> 5, ln = tid & 31;
    const int head = 4 * g + (qi & 3), row = MP + 4 * n + (qi >> 2);
    { const unsigned u = *(const unsigned*)(P + (size_t)row * NIN + 64 * head + 2 * ln); Qs[qi * 64 + 2 * ln] = bflo(u); Qs[qi * 64 + 2 * ln + 1] = bfhi(u); }
    __syncthreads();
    const int lane = tid & 63, w = tid >> 6, fr = lane & 15, fq = lane >> 4;
#pragma unroll 1
    for (int kt = w; kt < 9; kt += 8) {
        f32x4 z = (f32x4){0.f, 0.f, 0.f, 0.f};
#pragma unroll
        for (int st = 0; st < 16; ++st) z = __builtin_amdgcn_mfma_f32_16x16x4f32(Qs[fr * 64 + 4 * st + fq], Kc[(16 * kt + fr) * 68 + 4 * st + fq], z, 0, 0, 0);
        const int k = 16 * kt + fr;
        if (k < 132) {
            const bool valid = (k >= fq + 1) && (k <= fq + 128);
#pragma unroll
            for (int r = 0; r < 4; ++r) Sc[(4 * fq + r) * 136 + k] = valid ? z[r] : -INFINITY;
        }
    }
    __syncthreads();
    const float sink2 = sink_pre * LOG2E;
    float mx = -INFINITY;
    for (int k = ln; k < 132; k += 32) mx = fmaxf(mx, Sc[qi * 136 + k]);
#pragma unroll
    for (int o = 1; o < 32; o <<= 1) mx = fmaxf(mx, shx(mx, o, tid));
    mx = fmaxf(mx, sink2);
    float sum = 0.f;
    for (int k = ln; k < 132; k += 32) { const float p = ex2(Sc[qi * 136 + k] - mx); Sc[qi * 136 + k] = p; sum += p; }
#pragma unroll
    for (int o = 1; o < 32; o <<= 1) sum += shx(sum, o, tid);
    if (ln == 0) Sc[qi * 136 + 132] = 1.0f / (sum + ex2(sink2 - mx));
    __syncthreads();
    if (w < 4) {
        f32x4 o = (f32x4){0.f, 0.f, 0.f, 0.f};
#pragma unroll 11
        for (int st = 0; st < 33; ++st) o = __builtin_amdgcn_mfma_f32_16x16x4f32(Sc[fr * 136 + 4 * st + fq], Vc[(4 * st + fq) * 68 + 16 * w + fr], o, 0, 0, 0);
        const int d = 16 * w + fr, orow = MP + 4 * n + fq;
#pragma unroll
        for (int r = 0; r < 4; ++r) {
            const int hd = 4 * g + r;
            const float gate = bf2f(gate_pre[r]);
            MIX[(size_t)orow * DM + 64 * hd + d] = (bf16_t)(pk(o[r] * Sc[(4 * fq + r) * 136 + 132] * gate, 0.f) & 0xffffu);
        }
    }
    __syncthreads();
}

struct SretRegs { f32x4 s4[8]; float gate; unsigned qkv; unsigned vv; };
__device__ __forceinline__ void sret_load(SretRegs& R, const bf16_t* P, const float* Sin, int unit, int tid) {
    const int n = unit >> 2, h = unit & 3;
    const int v4 = tid & 31, dg = tid >> 5;
    const float* Sb = Sin + (size_t)unit * 16384;
    const int t = tid >> 7, d = tid & 127;
    const bf16_t* pr = P + (size_t)(MP + 4 * n + t) * NIN + 128 * h + d;
    R.qkv = (unsigned)pr[1280] | ((unsigned)pr[1792] << 16); R.vv = (unsigned)pr[2304];
    R.gate = bf2f(pr[2816]);
#pragma unroll
    for (int i = 0; i < 8; ++i) R.s4[i] = __builtin_nontemporal_load((const f32x4*)(Sb + (8 * dg + i) * 128 + 4 * v4));
}
__device__ __forceinline__ void sret_compute(LAS unsigned char* lds, const SretRegs& R, bf16_t* MIX, float* Sout, int unit, int tid) {
    const int n = unit >> 2, h = unit & 3;
    const float l2g = l2gamma(h);
    LAS float* qs = (LAS float*)lds;
    LAS float* ks_ = qs + 512;
    LAS float* vs_ = qs + 1024;
    LAS float* qk = qs + 1536;
    LAS float* red = qs + 1552;
    LAS float* part = qs + 2048;
    const int v4 = tid & 31, dg = tid >> 5;
    float* So = Sout + (size_t)unit * 16384;
    qs[tid] = bflo(R.qkv); ks_[tid] = bfhi(R.qkv); vs_[tid] = bflo(R.vv);
    __syncthreads();
    f32x4 vj[4], cr[4];
#pragma unroll
    for (int j = 0; j < 4; ++j) { vj[j] = *(const LAS f32x4*)(vs_ + j * 128 + 4 * v4); cr[j] = (f32x4){0.f, 0.f, 0.f, 0.f}; }
    const float g1 = ex2(l2g), g2 = g1 * g1, g3 = g2 * g1, g4 = g2 * g2;
#pragma unroll
    for (int i = 0; i < 8; ++i) {
        const int d = 8 * dg + i;
#pragma unroll
        for (int t = 0; t < 4; ++t) cr[t] += R.s4[i] * qs[t * 128 + d];
        f32x4 sn = R.s4[i] * g4;
        sn += vj[0] * (g3 * ks_[0 * 128 + d]); sn += vj[1] * (g2 * ks_[1 * 128 + d]); sn += vj[2] * (g1 * ks_[2 * 128 + d]); sn += vj[3] * ks_[3 * 128 + d];
        __builtin_nontemporal_store(sn, (f32x4*)(So + d * 128 + 4 * v4));
    }
#pragma unroll
    for (int t = 0; t < 4; ++t) *(LAS f32x4*)(part + (dg * 4 + t) * 128 + 4 * v4) = cr[t];
    {
        const int t = dg >> 2, j = dg & 3; float p = 0.f;
#pragma unroll
        for (int d = v4; d < 128; d += 32) p += qs[t * 128 + d] * ks_[j * 128 + d];
#pragma unroll
        for (int o = 1; o < 32; o <<= 1) p += shx(p, o, tid);
        if (v4 == 0) qk[dg] = p;
    }
    __syncthreads();
    const int t = tid >> 7, v = tid & 127;
    float cross = 0.f;
#pragma unroll
    for (int d2 = 0; d2 < 16; ++d2) cross += part[(d2 * 4 + t) * 128 + v];
    float o = cross * ex2((float)(t + 1) * l2g);
#pragma unroll
    for (int j = 0; j < 4; ++j) if (j <= t) o += qk[t * 4 + j] * ex2((float)(t - j) * l2g) * vs_[j * 128 + v];
    float ss = o * o;
#pragma unroll
    for (int of = 1; of < 64; of <<= 1) ss += shx(ss, of, tid);
    if ((tid & 63) == 0) red[tid >> 6] = ss;
    __syncthreads();
    const float rn = rsqrtf((red[2 * t] + red[2 * t + 1]) * (1.0f / 128.0f) + 1e-6f);
    const int row = MP + 4 * n + t;
    MIX[(size_t)row * DM + 512 + 128 * h + v] = (bf16_t)(pk(o * rn * R.gate, 0.f) & 0xffffu);
    __syncthreads();
}

__device__ __forceinline__ void sample_outproj_slice(LAS unsigned char* lds, const bf16_t* MIX, const bf16_t* Wt, const float* xs_f32, const bf16_t* XBi, bf16_t* XBn, float* yout, float* rowss_next, int b, int tid) {
    const int lane = tid & 63, w = tid >> 6, fr = lane & 15, fq = lane >> 4;
    const int r0 = MP + 32 * (b >> 4), c0 = 64 * (b & 15), k0 = 128 * w;
    f32x4 res;
    {
        const int mt = w >> 1, nt = w & 1;
        const int col = c0 + 32 * (mt >> 1) + 8 * fq + 4 * (mt & 1), row = r0 + 16 * nt + fr;
        if (xs_f32) res = *(const f32x4*)(xs_f32 + (size_t)(row - MP) * DM + col);
        else { const u32x2 u = *(const u32x2*)(XBi + (size_t)row * DM + col); res = (f32x4){bflo(u.x), bfhi(u.x), bflo(u.y), bfhi(u.y)}; }
    }
    bf16x8 af[4][4], bfr[2][4];
#pragma unroll
    for (int mt = 0; mt < 4; ++mt)
#pragma unroll
        for (int ks = 0; ks < 4; ++ks) af[mt][ks] = *(const bf16x8*)(Wt + (size_t)(c0 + 16 * mt + fr) * DM + k0 + 32 * ks + 8 * fq);
#pragma unroll
    for (int nt = 0; nt < 2; ++nt)
#pragma unroll
        for (int ks = 0; ks < 4; ++ks) bfr[nt][ks] = *(const bf16x8*)(MIX + (size_t)(r0 + 16 * nt + fr) * DM + k0 + 32 * ks + 8 * fq);
    f32x4 acc[4][2];
#pragma unroll
    for (int mt = 0; mt < 4; ++mt)
#pragma unroll
        for (int nt = 0; nt < 2; ++nt) { f32x4 z = (f32x4){0.f, 0.f, 0.f, 0.f};
#pragma unroll
            for (int ks = 0; ks < 4; ++ks) z = __builtin_amdgcn_mfma_f32_16x16x32_bf16(af[mt][ks], bfr[nt][ks], z, 0, 0, 0);
            acc[mt][nt] = z; }
    LAS f32x4* red = (LAS f32x4*)lds;
#pragma unroll
    for (int mt = 0; mt < 4; ++mt)
#pragma unroll
        for (int nt = 0; nt < 2; ++nt) red[(w * 8 + mt * 2 + nt) * 64 + lane] = acc[mt][nt];
    __syncthreads();
    const int mt = w >> 1, nt = w & 1;
    f32x4 v = (f32x4){0.f, 0.f, 0.f, 0.f};
#pragma unroll
    for (int ww = 0; ww < 8; ++ww) v += red[(ww * 8 + w) * 64 + lane];
    const int col = c0 + 32 * (mt >> 1) + 8 * fq + 4 * (mt & 1);
    const int row = r0 + 16 * nt + fr;
    v += res;
    if (yout) *(f32x4*)(yout + (size_t)row * DM + col) = v;
    else {
        u32x2 o; o.x = pk(v[0], v[1]); o.y = pk(v[2], v[3]);
        *(u32x2*)(XBn + (size_t)row * DM + col) = o;
        float ss = (v[0] * v[0] + v[1] * v[1]) + (v[2] * v[2] + v[3] * v[3]);
        ss += shx(ss, 16, lane); ss += shx(ss, 32, lane);
        if (fq == 0) atomicAdd(rowss_next + row, ss);
    }
    __syncthreads();
}

__device__ __forceinline__ void scan_phase(const float* UT, bf16_t* SPT, float* sp_out_l, int tid, int G) {
    for (int gid = blockIdx.x * 512 + tid; gid < 2 * 4 * 16384; gid += G * 512) {
        const int n = gid >> 16, h = (gid >> 14) & 3, e = gid & 16383;
        const float gd = ex2(128.0f * l2gamma(h));
        const size_t base = ((size_t)(n * 64) * 4 + h) * 16384 + e;
        float S = 0.f;
        for (int c0 = 0; c0 < 64; c0 += 32) {
            float uu[32];
#pragma unroll
            for (int k = 0; k < 32; ++k) uu[k] = UT[base + (size_t)(c0 + k) * 65536];
#pragma unroll
            for (int k = 0; k < 32; ++k) { SPT[base + (size_t)(c0 + k) * 65536] = (bf16_t)(pk(S, 0.f) & 0xffffu); S = gd * S + uu[k]; }
        }
        const int dv = e >> 7, dk = e & 127;
        sp_out_l[(size_t)(n * 4 + h) * 16384 + dk * 128 + dv] = S;
    }
}

__device__ __forceinline__ void ret_unit(LAS unsigned char* lds, const bf16_t* P, const bf16_t* SPT, bf16_t* MIX, int unit, int tid) {
    const int h = unit & 3, c = (unit >> 2) & 63, n = unit >> 8;
    const int R0 = n * SEQ + c * 128;
    const float l2g = l2gamma(h);
    LAS bf16_t* Ks = (LAS bf16_t*)lds;
    LAS bf16_t* Vt = (LAS bf16_t*)(lds + 128 * 272);
    LAS bf16_t* Ss = (LAS bf16_t*)(lds + 256 * 272);
    const int lane = tid & 63, w = __builtin_amdgcn_readfirstlane(tid >> 6), fr = lane & 15, fq = lane >> 4;
    const int qi = 16 * w + fr, row = R0 + qi;
    bf16x8 bq[4];
#pragma unroll
    for (int ks = 0; ks < 4; ++ks) bq[ks] = *(const bf16x8*)(P + (size_t)row * NIN + 1280 + 128 * h + 32 * ks + 8 * fq);
    u32x2 gts[8];
#pragma unroll
    for (int dt = 0; dt < 8; ++dt) gts[dt] = *(const u32x2*)(P + (size_t)row * NIN + 2816 + 128 * h + 16 * dt + 4 * fq);
#pragma unroll
    for (int i = 0; i < 4; ++i) {
        const int ch = tid + 512 * i, j = ch >> 4, c8 = ch & 15;
        const u32x4 kv = *(const u32x4*)(P + (size_t)(R0 + j) * NIN + 1792 + 128 * h + 8 * c8);
        const u32x4 sv = *(const u32x4*)(SPT + (size_t)unit * 16384 + j * 128 + 8 * c8);
        *(LAS u32x4*)(Ks + j * 136 + 8 * c8) = kv;
        *(LAS u32x4*)(Ss + j * 136 + 8 * c8) = sv;
    }
    {
        u32x4 vv[4];
#pragma unroll
        for (int i = 0; i < 4; ++i) vv[i] = *(const u32x4*)(P + (size_t)(R0 + (tid >> 4) + 32 * i) * NIN + 2304 + 128 * h + 8 * (tid & 15));
#pragma unroll
        for (int i = 0; i < 4; ++i) tr_write_sw(Vt, 136, tid & 15, 15, (tid >> 4) + 32 * i, vv[i], 16, tid);
    }
    __syncthreads();
    f32x4 o[8];
#pragma unroll
    for (int dt = 0; dt < 8; ++dt) {
        f32x4 z = (f32x4){0.f, 0.f, 0.f, 0.f};
#pragma unroll
        for (int ks = 0; ks < 4; ++ks) z = __builtin_amdgcn_mfma_f32_16x16x32_bf16(*(const LAS bf16x8*)(Ss + (16 * dt + fr) * 136 + 32 * ks + 8 * fq), bq[ks], z, 0, 0, 0);
        o[dt] = z * ex2((float)(qi + 1) * l2g);
    }
    f32x4 sc[8];
#pragma unroll
    for (int jt = 0; jt < 8; ++jt) {
        f32x4 z = (f32x4){0.f, 0.f, 0.f, 0.f};
        if (jt <= w) {
#pragma unroll
            for (int ks = 0; ks < 4; ++ks) z = __builtin_amdgcn_mfma_f32_16x16x32_bf16(*(const LAS bf16x8*)(Ks + (16 * jt + fr) * 136 + 32 * ks + 8 * fq), bq[ks], z, 0, 0, 0);
#pragma unroll
            for (int r = 0; r < 4; ++r) { const int j = 16 * jt + 4 * fq + r; z[r] = (qi >= j) ? z[r] * ex2((float)(qi - j) * l2g) : 0.f; }
        }
        sc[jt] = z;
    }
#pragma unroll
    for (int k2 = 0; k2 < 4; ++k2) {
        if (2 * k2 <= w) {
            u32x4 pw; pw.x = pk(sc[2 * k2][0], sc[2 * k2][1]); pw.y = pk(sc[2 * k2][2], sc[2 * k2][3]); pw.z = pk(sc[2 * k2 + 1][0], sc[2 * k2 + 1][1]); pw.w = pk(sc[2 * k2 + 1][2], sc[2 * k2 + 1][3]);
            const bf16x8 pb = __builtin_bit_cast(bf16x8, pw);
#pragma unroll
            for (int dt = 0; dt < 8; ++dt) {
                const u32x2 lo = *(const LAS u32x2*)(Vt + sw_off(16 * dt + fr, 136, 15, 32 * k2 + 4 * fq)), hi = *(const LAS u32x2*)(Vt + sw_off(16 * dt + fr, 136, 15, 32 * k2 + 16 + 4 * fq));
                const u32x4 aw = (u32x4){lo.x, lo.y, hi.x, hi.y};
                o[dt] = __builtin_amdgcn_mfma_f32_16x16x32_bf16(__builtin_bit_cast(bf16x8, aw), pb, o[dt], 0, 0, 0);
            }
        }
    }
    float ss = 0.f;
#pragma unroll
    for (int dt = 0; dt < 8; ++dt) ss += (o[dt][0] * o[dt][0] + o[dt][1] * o[dt][1]) + (o[dt][2] * o[dt][2] + o[dt][3] * o[dt][3]);
    ss += shx(ss, 16, lane); ss += shx(ss, 32, lane);
    const float rn = rsqrtf(ss * (1.0f / 128.0f) + 1e-6f);
#pragma unroll
    for (int dt = 0; dt < 8; ++dt) {
        const u32x2 gt = gts[dt];
        u32x2 wv; wv.x = pk(o[dt][0] * rn * bflo(gt.x), o[dt][1] * rn * bfhi(gt.x)); wv.y = pk(o[dt][2] * rn * bflo(gt.y), o[dt][3] * rn * bfhi(gt.y));
        *(u32x2*)(MIX + (size_t)row * DM + 512 + 128 * h + 16 * dt + 4 * fq) = wv;
    }
    __syncthreads();
}


#define XB_TMO      128
#define XB_XCNT(j)  (256  + 64 * (j))
#define XB_XSUB(j)  (1280 + 64 * (j))
#define XB_XGEN(j)  (2304 + 64 * (j))
#define XB_TOP      3328
#define XB_TOPGEN   3392
#define XCD_BAR_WORDS 3456
#define XB_SPIN_CAP (1u << 22)
__device__ __forceinline__ unsigned xb_ld(unsigned* p)              { return __hip_atomic_load(p, __ATOMIC_RELAXED, __HIP_MEMORY_SCOPE_AGENT); }
__device__ __forceinline__ unsigned xb_add(unsigned* p, unsigned v) { return __hip_atomic_fetch_add(p, v, __ATOMIC_RELAXED, __HIP_MEMORY_SCOPE_AGENT); }
__device__ __forceinline__ unsigned xb_xcc_id() { return (unsigned)__builtin_amdgcn_s_getreg((3 << 11) | 20) & 0xFu; }
#define XB_SPIN(cond, bar) do { unsigned _sp = 0; while (cond) { __builtin_amdgcn_s_sleep(1); \
    if ((++_sp & 255u) == 0u) { if (xb_ld(&(bar)[XB_TMO])) break; if (_sp > XB_SPIN_CAP) { atomicAdd(&(bar)[XB_TMO], 1u); break; } } } } while (0)
struct XcdBarrier { unsigned* bar; unsigned x; volatile LAS unsigned* st; };
__device__ __forceinline__ XcdBarrier xcd_barrier_post(unsigned* bar, volatile LAS unsigned* st) {
    XcdBarrier b; b.bar = bar; b.x = xb_xcc_id(); b.st = st;
    if (threadIdx.x == 0) (void)xb_add(&bar[XB_XCNT(b.x)], 1u);
    return b;
}
__device__ __forceinline__ void xcd_barrier_complete(unsigned* bar, unsigned x, unsigned& nloc, unsigned& nx) {
    const unsigned G = gridDim.x * gridDim.y * gridDim.z;
    unsigned sum, cnt, mine, sp = 0u;
    for (;;) {
        sum = 0u; cnt = 0u; mine = 0u;
#pragma unroll
        for (unsigned j = 0; j < 16; ++j) { const unsigned c = xb_ld(&bar[XB_XCNT(j)]); sum += c; cnt += (c > 0u) ? 1u : 0u; mine = (j == x) ? c : mine; }
        if (sum == G) break;
        __builtin_amdgcn_s_sleep(1);
        if ((++sp & 255u) == 0u) { if (xb_ld(&bar[XB_TMO])) break; if (sp > XB_SPIN_CAP) { atomicAdd(&bar[XB_TMO], 1u); break; } }
    }
    nloc = mine > 0u ? mine : 1u; nx = cnt > 0u ? cnt : 1u;
}
__device__ __forceinline__ void xcd_barrier(const XcdBarrier& b0) {
    XcdBarrier b = b0;
    asm volatile("" : "+s"(b.x));
    asm volatile("s_waitcnt vmcnt(0)" ::: "memory");
    __syncthreads();
    if (threadIdx.x == 0) {
        unsigned* bar = b.bar;
        asm volatile("" : "+s"(bar));
        __builtin_amdgcn_s_waitcnt(0);
        unsigned nloc = b.st[0], nx = b.st[1];
        if (nloc == 0u) { xcd_barrier_complete(bar, b.x, nloc, nx); b.st[0] = nloc; b.st[1] = nx; }
        const unsigned old = xb_add(&bar[XB_XSUB(b.x)], 1u);
        const unsigned gen = old / nloc;
        if (old + 1u == (gen + 1u) * nloc) {
            __builtin_amdgcn_fence(__ATOMIC_RELEASE, "agent");
            asm volatile("s_waitcnt vmcnt(0)" ::: "memory");
            const unsigned og = xb_add(&bar[XB_TOP], 1u);
            const unsigned tg = og / nx;
            if (og + 1u == (tg + 1u) * nx) xb_add(&bar[XB_TOPGEN], 1u);
            else XB_SPIN(xb_ld(&bar[XB_TOPGEN]) == tg, bar);
            __builtin_amdgcn_fence(__ATOMIC_ACQUIRE, "agent");
            xb_add(&bar[XB_XGEN(b.x)], 1u);
            asm volatile("s_waitcnt vmcnt(0)" ::: "memory");
        } else {
            XB_SPIN(xb_ld(&bar[XB_XGEN(b.x)]) == gen, bar);
            __builtin_amdgcn_fence(__ATOMIC_ACQUIRE, "agent");
            asm volatile("s_waitcnt vmcnt(0)" ::: "memory");
        }
    }
    __syncthreads();
}
constexpr int MISC_OFF = 131072 + 320;
__device__ __forceinline__ int launder_tid() { int t = threadIdx.x; asm volatile("" : "+v"(t)); return t; }
__global__ void __launch_bounds__(512, 2) hymba_fwd(Args a) {
    extern __shared__ __attribute__((aligned(16))) unsigned char lds_raw[];
    LAS unsigned char* lds = (LAS unsigned char*)lds_raw;
    const int tid = threadIdx.x, G = gridDim.x;
    unsigned char* ws = a.ws;
    float* out = a.out;
    bf16_t* P = (bf16_t*)(ws + WS_P); bf16_t* MIX = (bf16_t*)(ws + WS_MIX);
    float* UT = (float*)(ws + WS_UT); bf16_t* SPT = (bf16_t*)(ws + WS_SPT);
    float* rowss = (float*)(ws + WS_ROWSS);
    const float* tabB = (const float*)(ws + WS_TABB); const float* tabA = (const float*)(ws + WS_TABA);
    const int lo = a.ph_lo, hi = a.ph_hi;
    volatile LAS unsigned* MISC = (volatile LAS unsigned*)(lds + MISC_OFF);
    if (tid < 32) MISC[tid] = 0u;
    __syncthreads();
    XcdBarrier bar = xcd_barrier_post((unsigned*)ws, MISC + 8);
    if (a.ph_lo < 0) cg::this_grid().sync();
#if MK_MULTI
#define IN(k) (lo <= (k) && (k) < hi)
#else
#define IN(k) true
#endif
#define LT() launder_tid()
#define SEAM(k) do { if (IN(k) && IN((k) + 1)) { xcd_barrier(bar); } } while (0)
#ifndef SKIP_P0
    if (IN(0)) for (int rep = 0; rep < REP_P0; ++rep) { p0_prologue(a, lds, tid, G); if (rep + 1 < REP_P0) xcd_barrier(bar); }
#endif
    SEAM(0);
    for (int l = 0; l < DEPTH; ++l) {
        const int pb = 1 + 5 * l;
        const float* sinks_l = a.in[10] + 8 * l;
        bf16_t* XB = (bf16_t*)(ws + ((l & 1) ? WS_XB2 : WS_XB)); bf16_t* XBn = (bf16_t*)(ws + ((l & 1) ? WS_XB : WS_XB2));
#ifndef SKIP_P1
        if (IN(pb)) for (int rep = 0; rep < REP_P1; ++rep) {
            const int b = (int)blockIdx.x;
            unsigned* cnt = (unsigned*)(ws + 14336) + 64 * l;
            pg8::Gemm g{XB, (const bf16_t*)(ws + WS_WIN) + (size_t)l * NIN * DM, MT, NIN, DM};
            EpiIn E{P, rowss + l * MT, a.in[8] + 64 * l, a.in[9] + 64 * l, tabA, tabB,
                    out + O_KP + (size_t)l * 32768, out + O_VP + (size_t)l * 32768, out + O_KS + (size_t)l * 2097152, out + O_VS + (size_t)l * 2097152};
            if (b >= 64 && b < 90) {
                OneUnit S1{64 + (b - 64) / 13, (b - 64) % 13};
                pg8::gemm_phase<EpiIn, OneUnit, true, true>(lds, g, S1, E, LT());
                asm volatile("s_waitcnt vmcnt(0)" ::: "memory");
                __syncthreads();
                if (threadIdx.x == 0) { __builtin_amdgcn_fence(__ATOMIC_RELEASE, "agent"); asm volatile("s_waitcnt vmcnt(0)" ::: "memory"); xb_add(cnt, 1u); }
            }
            pg8::StaticOrder S; S.init(MP, NIN, G, b);
            pg8::gemm_phase<EpiIn, pg8::StaticOrder, true, true>(lds, g, S, E, LT());
            if (b >= 90) {
                if (threadIdx.x == 0) {
                    XB_SPIN(xb_ld(cnt) < 26u * (unsigned)(rep + 1), (unsigned*)ws);
                    __builtin_amdgcn_fence(__ATOMIC_ACQUIRE, "agent"); asm volatile("s_waitcnt vmcnt(0)" ::: "memory");
                }
                __syncthreads();
                const float* ck = a.in[2] + (size_t)l * 2097152; const float* cv = a.in[3] + (size_t)l * 2097152;
                float* kso = out + O_KS + (size_t)l * 2097152; float* vso = out + O_VS + (size_t)l * 2097152;
                const float* sin_l = a.in[4] + (size_t)l * 8388608; float* sout_l = out + O_SS + (size_t)l * 8388608;
                {
                    const int stride = G - 90;
                    int u = b - 90;
                    if (u < 512) {
                        SretRegs cur; sret_load(cur, P, sin_l, u, LT());
#pragma unroll 1
                        for (; u < 512; u += stride) {
                            const int nx = u + stride;
                            SretRegs nxt = cur;
                            if (nx < 512) sret_load(nxt, P, sin_l, nx, LT());
                            sret_compute(lds, cur, MIX, sout_l, u, LT());
                            cur = nxt;
                        }
                    }
#pragma unroll 1
                    for (; u < 768; u += stride) sattn_unit(lds, P, MIX, ck, cv, kso, vso, sinks_l, u - 512, LT());
                }
            }
        }
#endif
        SEAM(pb);
#ifndef SKIP_P2
        if (IN(pb + 1)) for (int rep = 0; rep < REP_P2; ++rep) {
            const int b = (int)blockIdx.x;
            UcRegs u1, u2; AttnRegs ar;
            uc_load(u1, P, b, LT());
            uc_load(u2, P, b + 256, LT());
            uc_compute(lds, u1, UT, b, LT());
            attn_load(ar, P, b, LT());
            uc_compute(lds, u2, UT, b + 256, LT());
            attn_compute(lds, ar, P, MIX, sinks_l, b, LT());
        }
#endif
        SEAM(pb + 1);
#ifndef SKIP_SCAN
        if (IN(pb + 2)) for (int rep = 0; rep < REP_P3; ++rep) {
            const bool lastl = (l == DEPTH - 1);
            sample_outproj_slice(lds, MIX, (const bf16_t*)(ws + WS_WOUT) + (size_t)l * DM * DM, l == 0 ? a.in[1] : nullptr, XB, XBn, lastl ? out : nullptr,
                                 lastl ? nullptr : (rep == 0 ? rowss + (l + 1) * MT : (float*)(ws + WS_DUMMY)), (int)blockIdx.x, LT());
            scan_phase(UT, SPT, out + O_SP + (size_t)l * 131072, LT(), G);
        }
#endif
        SEAM(pb + 2);
#ifndef SKIP_RET
        if (IN(pb + 3)) for (int rep = 0; rep < REP_P4; ++rep) { for (int u = blockIdx.x; u < 512; u += G) ret_unit(lds, P, SPT, MIX, u, LT()); }
#endif
        SEAM(pb + 3);
#ifndef SKIP_P5
        if (IN(pb + 4)) for (int rep = 0; rep < REP_P5; ++rep) {
            pg8::Gemm g{MIX, (const bf16_t*)(ws + WS_WOUT) + (size_t)l * DM * DM, MP, DM, DM};
            pg8::StaticOrder S; S.init(MP, DM, G, (int)blockIdx.x);
            const bool lastl = (l == DEPTH - 1);
            EpiOut E{l == 0 ? a.in[0] : nullptr, l == 0 ? a.in[1] : nullptr, lastl ? out : nullptr, XB, XBn, lastl ? nullptr : (rep == 0 ? rowss + (l + 1) * MT : (float*)(ws + WS_DUMMY))};
            pg8::gemm_phase<EpiOut, pg8::StaticOrder, true, true>(lds, g, S, E, LT());
        }
#endif
        SEAM(pb + 4);
    }
#undef IN
#undef SEAM
}

extern "C" void kernel_launch(void* const* d_in, const int* in_sizes, int n_in, void* d_out, int out_size, void* d_ws, size_t ws_size, hipStream_t stream) {
    static int grid = 0;
    if (grid == 0) {
        int dev = 0, cus = 0, per_cu = 0;
        if (n_in != 11 || ws_size < WS_END) { fprintf(stderr, "kernel_launch: unexpected n_in %d / ws %zu\n", n_in, ws_size); grid = -1; return; }
        if (hipGetDevice(&dev) != hipSuccess || hipDeviceGetAttribute(&cus, hipDeviceAttributeMultiprocessorCount, dev) != hipSuccess) { grid = -1; return; }
        if (hipFuncSetAttribute((const void*)hymba_fwd, hipFuncAttributeMaxDynamicSharedMemorySize, LDS_BYTES) != hipSuccess) { fprintf(stderr, "kernel_launch: hipFuncSetAttribute failed\n"); grid = -1; return; }
        if (hipOccupancyMaxActiveBlocksPerMultiprocessor(&per_cu, (const void*)hymba_fwd, 512, LDS_BYTES) != hipSuccess || per_cu < 1) { fprintf(stderr, "kernel_launch: occupancy query says %d\n", per_cu); per_cu = 1; }
        (void)hipGetLastError();
        if (cus < 256) { fprintf(stderr, "kernel_launch: needs 256 CUs, got %d\n", cus); grid = -1; return; }
        grid = 256;
    }
    if (grid < 0) return;
    if (hipMemsetAsync(d_ws, 0, 16384, stream) != hipSuccess) { fprintf(stderr, "kernel_launch: memset failed\n"); return; }
    Args a{};
    for (int i = 0; i < 11; ++i) a.in[i] = (const float*)d_in[i];
    a.out = (float*)d_out; a.ws = (unsigned char*)d_ws;
    a.baseA = std::pow(500000.0, -1.0 / 8.0); a.baseB = std::pow(10000.0, -1.0 / 64.0);
    constexpr int NPH = 1 + 5 * DEPTH;
#if MK_MULTI
    for (int p = 0; p < NPH; ++p) { a.ph_lo = p; a.ph_hi = p + 1; hipLaunchKernelGGL(hymba_fwd, dim3(grid), dim3(512), LDS_BYTES, stream, a); }
#else
    a.ph_lo = 0; a.ph_hi = NPH;
    void* args[] = {&a};
    hipError_t e = hipLaunchCooperativeKernel((const void*)hymba_fwd, dim3(grid), dim3(512), args, LDS_BYTES, stream);
    if (e != hipSuccess) fprintf(stderr, "cooperative launch failed: %s (grid %d)\n", hipGetErrorString(e), grid);
#endif
}
```

```cpp
#include <hip/hip_runtime.h>
#include <hip/hip_cooperative_groups.h>
#include <cstdio>
#include <cstdint>
#include <cmath>
namespace cg = cooperative_groups;

#ifndef MK_MULTI
#define MK_MULTI 0
#endif

#ifndef REP_P0
#define REP_P0 1
#endif
#ifndef REP_P1
#define REP_P1 1
#endif
#ifndef REP_P2
#define REP_P2 1
#endif
#ifndef REP_P3
#define REP_P3 1
#endif
#ifndef REP_P4
#define REP_P4 1
#endif
#ifndef REP_P5
#define REP_P5 1
#endif
#define LAS __attribute__((address_space(3)))
typedef unsigned short bf16_t;
typedef short bf16x8 __attribute__((ext_vector_type(8)));
typedef float f32x4 __attribute__((ext_vector_type(4)));
typedef float f32x2 __attribute__((ext_vector_type(2)));
typedef unsigned u32x4 __attribute__((ext_vector_type(4)));
typedef unsigned u32x2 __attribute__((ext_vector_type(2)));

constexpr int DM = 1024, SEQ = 8192, NBATCH = 2, MP = NBATCH * SEQ, MS = 512, MT = MP + MS, NIN = 3328, DEPTH = 4;
constexpr int NPOS = 8196;
constexpr float LOG2E = 1.4426950408889634f;
constexpr size_t O_Y = 0, O_KP = 17301504, O_VP = 17432576, O_SP = 17563648, O_KS = 18087936, O_VS = 26476544, O_SS = 34865152;
constexpr size_t MiB = 1u << 20;
constexpr size_t WS_ROWSS = 1 * MiB, WS_TABB = 2 * MiB, WS_TABA = 7 * MiB, WS_WIN = 8 * MiB, WS_WOUT = 36 * MiB, WS_XB = 44 * MiB, WS_MIX = 80 * MiB,
                 WS_P = 116 * MiB, WS_UT = 224 * MiB, WS_SPT = 256 * MiB, WS_XB2 = 272 * MiB, WS_DUMMY = 308 * MiB, WS_END = 312 * MiB;
constexpr int LDS_BYTES = 147456;

__device__ __forceinline__ unsigned pk(float lo, float hi) { unsigned r; asm("v_cvt_pk_bf16_f32 %0, %1, %2" : "=v"(r) : "v"(lo), "v"(hi)); return r; }
__device__ __forceinline__ float bflo(unsigned u) { return __uint_as_float(u << 16); }
__device__ __forceinline__ float bfhi(unsigned u) { return __uint_as_float(u & 0xffff0000u); }
__device__ __forceinline__ float bf2f(bf16_t h) { return __uint_as_float((unsigned)h << 16); }
__device__ __forceinline__ float ex2(float x) { return __builtin_amdgcn_exp2f(x); }
__device__ __forceinline__ float shx(float v, int m, int lane) { return __builtin_bit_cast(float, __builtin_amdgcn_ds_bpermute(((lane ^ m) & 63) << 2, __builtin_bit_cast(int, v))); }
__device__ __forceinline__ int shxi(int v, int m, int lane) { return __builtin_amdgcn_ds_bpermute(((lane ^ m) & 63) << 2, v); }
__device__ __forceinline__ float l2gamma(int h) { const int hb = __builtin_amdgcn_readfirstlane(h); const unsigned b = hb == 0 ? 0xbd3b9ca6u : hb == 1 ? 0xbcba1f74u : hb == 2 ? 0xbc3963ddu : 0xbbb906ceu; return __builtin_bit_cast(float, b); }

namespace pg8 {
constexpr int BM = 256, BK = 64, HALF = 128, HTB = HALF * BK * 2, STAGE_BYTES = 8 * HTB, NXCD = 8, WGM = 8;
__host__ __device__ __forceinline__ int lds_byte(int r, int c) { const int st = (r >> 4) * 2 + (c >> 5), rr = r & 15, cc = c & 31, ob = rr * 64 + cc * 2; return st * 1024 + (ob ^ (((ob >> 9) & 1) << 5)); }
__host__ __device__ __forceinline__ void stage_rc(int b, int& R, int& C) { const int st = b / 1024, sb = b % 1024, swz = sb ^ (((sb >> 9) & 1) << 5); R = (st >> 1) * 16 + swz / 64; C = (st & 1) * 32 + (swz % 64) / 2; }
struct Unit { int pm, pn; };
struct Gemm { const bf16_t* A; const bf16_t* Bt; int M, N, K; };
struct StaticOrder {
    int nM, nN, nwg, G, c;
    __host__ __device__ void init(int M, int N, int G_, int c_) { nM = M / BM; nN = N / BM; nwg = nM * nN; G = G_; c = c_; }
    __host__ __device__ bool next(int i, Unit& u) const {
        const long L = (long)i * G + c; if (L >= nwg) return false;
        int wgid = (int)L; { const int q = nwg / NXCD, r = nwg % NXCD, xcd = wgid % NXCD, off = wgid / NXCD; wgid = (xcd < r ? xcd * (q + 1) : r * (q + 1) + (xcd - r) * q) + off; }
        const int nig = WGM * nN, gid = wgid / nig, fm = gid * WGM, gsz = (nM - fm) < WGM ? (nM - fm) : WGM;
        u.pm = fm + ((wgid % nig) % gsz); u.pn = (wgid % nig) / gsz; return true;
    }
    __device__ __forceinline__ void a_ready(const Unit&) const {}
    __device__ __forceinline__ void done(const Unit&) const {}
};

template <class Epi, class Sched, bool ALIGN_EPI = false, bool SP2 = false>
__device__ __forceinline__ void gemm_phase(LAS unsigned char* lds, const Gemm g, const Sched& S, const Epi& E, const int tid) {
    const int wid = __builtin_amdgcn_readfirstlane(tid >> 6), lane = tid & 63, wr = wid >> 2, wc = wid & 3, fr = lane & 15, fq = lane >> 4;
    const int K = g.K, nt = K / BK;
    unsigned voffA[2], voffB[2];
#pragma unroll
    for (int i = 0; i < 2; ++i) { int R, C; stage_rc(tid * 16 + i * 8192, R, C); voffA[i] = (unsigned)(R * K + C) * 2u; voffB[i] = voffA[i]; }
    const size_t kstep = (size_t)(BK * 2);
    const size_t hstep = (size_t)HALF * K * 2;
    const size_t tstep = 2 * hstep;
    const unsigned ldsw = (unsigned)wid * 1024u;
    const int aoff = lds_byte(wr * 64 + fr, fq * 8), boff = lds_byte(wc * 32 + fr, fq * 8);
#define PG8_SA(b, h) (((b) * 2 + (h)) * HTB)
#define PG8_SB(b, h) ((4 + (b) * 2 + (h)) * HTB)
#define PG8_STAGE(bufoff, gbase, voff) do { _Pragma("unroll") for (int _i = 0; _i < 2; ++_i) \
        __builtin_amdgcn_global_load_lds((const unsigned*)((const char*)(gbase) + (voff)[_i]), (LAS unsigned*)(lds + (bufoff) + ldsw + _i * 8192), 16, 0, 0); } while (0)
#define PG8_LDA(dst, b, h) do { _Pragma("unroll") for (int m = 0; m < 4; ++m) _Pragma("unroll") for (int k = 0; k < 2; ++k) dst[m][k] = *(const LAS bf16x8*)(lds + PG8_SA(b, h) + aoff + m * 2048 + k * 1024); } while (0)
#define PG8_LDB(dst, b, h) do { _Pragma("unroll") for (int n = 0; n < 2; ++n) _Pragma("unroll") for (int k = 0; k < 2; ++k) dst[n][k] = *(const LAS bf16x8*)(lds + PG8_SB(b, h) + boff + n * 2048 + k * 1024); } while (0)
#define PG8_MMA(ai, bj, At, Bt) do { __builtin_amdgcn_s_setprio(1); _Pragma("unroll") for (int m = 0; m < 4; ++m) _Pragma("unroll") for (int n = 0; n < 2; ++n) _Pragma("unroll") for (int k = 0; k < 2; ++k) \
        acc[ai][bj][m][n] = __builtin_amdgcn_mfma_f32_16x16x32_bf16(Bt[n][k], At[m][k], acc[ai][bj][m][n], 0, 0, 0); __builtin_amdgcn_s_setprio(0); } while (0)
#define PG8_WAIT_V(n) asm volatile("s_waitcnt vmcnt(" #n ")" ::: "memory")
#define PG8_WAIT_L(n) asm volatile("s_waitcnt lgkmcnt(" #n ")" ::: "memory")
#define PG8_BAR __builtin_amdgcn_s_barrier()
#define PG8_SCHED __builtin_amdgcn_sched_barrier(0)
    Unit cur, nxt; int ui = 0;
    if (!S.next(0, cur)) return;
    f32x4 acc[2][2][4][2];
#pragma unroll
    for (int a = 0; a < 2; ++a)
#pragma unroll
        for (int b = 0; b < 2; ++b)
#pragma unroll
            for (int m = 0; m < 4; ++m)
#pragma unroll
                for (int n = 0; n < 2; ++n) acc[a][b][m][n] = (f32x4){0.f, 0.f, 0.f, 0.f};
    bf16x8 At[4][2], B0[2][2], B1[2][2];
    const char* cA = (const char*)g.A + (size_t)cur.pm * tstep; const char* cB = (const char*)g.Bt + (size_t)cur.pn * tstep;
    S.a_ready(cur);
    if constexpr (SP2) {
        PG8_STAGE(PG8_SB(0, 0), cB, voffB); PG8_STAGE(PG8_SB(0, 1), cB + hstep, voffB); PG8_STAGE(PG8_SA(0, 0), cA, voffA); PG8_STAGE(PG8_SA(0, 1), cA + hstep, voffA);
        if (wr == 1) PG8_BAR;
        PG8_WAIT_V(2); PG8_BAR;
        PG8_STAGE(PG8_SB(1, 0), cB + kstep, voffB); PG8_STAGE(PG8_SA(1, 0), cA + kstep, voffA); PG8_STAGE(PG8_SB(1, 1), cB + hstep + kstep, voffB);
        PG8_WAIT_V(6); PG8_BAR;
    } else {
        PG8_STAGE(PG8_SB(0, 0), cB, voffB); PG8_STAGE(PG8_SA(0, 0), cA, voffA); PG8_STAGE(PG8_SB(0, 1), cB + hstep, voffB); PG8_STAGE(PG8_SA(0, 1), cA + hstep, voffA);
        if (wr == 1) PG8_BAR;
        PG8_WAIT_V(4); PG8_BAR;
        PG8_STAGE(PG8_SB(1, 0), cB + kstep, voffB); PG8_STAGE(PG8_SA(1, 0), cA + kstep, voffA); PG8_STAGE(PG8_SB(1, 1), cB + hstep + kstep, voffB);
        PG8_WAIT_V(6); PG8_BAR;
    }
    for (;;) {
        const bool has_next = S.next(ui + 1, nxt);
        const char* nA = has_next ? (const char*)g.A + (size_t)nxt.pm * tstep : cA; const char* nB = has_next ? (const char*)g.Bt + (size_t)nxt.pn * tstep : cB;
        for (int t = 0; t < nt; t += 2) {
            const bool last = (t == nt - 2);
            const char* a1 = cA + (size_t)(t + 1) * kstep;
            const char* a2 = last ? nA : cA + (size_t)(t + 2) * kstep; const char* b2 = last ? nB : cB + (size_t)(t + 2) * kstep;
            const char* a3 = a2 + kstep; const char* b3 = b2 + kstep;
            if (last && has_next) S.a_ready(nxt);
            if constexpr (SP2) {
            PG8_LDB(B0, 0, 0); PG8_LDB(B1, 0, 1); PG8_SCHED; PG8_LDA(At, 0, 0); PG8_STAGE(PG8_SA(1, 1), a1 + hstep, voffA);
            PG8_WAIT_V(8); PG8_WAIT_L(0); PG8_BAR; PG8_MMA(0, 0, At, B0); PG8_MMA(0, 1, At, B1); PG8_BAR; PG8_SCHED;
            PG8_LDA(At, 0, 1); PG8_STAGE(PG8_SB(0, 0), b2, voffB); PG8_STAGE(PG8_SB(0, 1), b2 + hstep, voffB); PG8_STAGE(PG8_SA(0, 0), a2, voffA);
            PG8_WAIT_V(8); PG8_WAIT_L(0); PG8_BAR; PG8_MMA(1, 0, At, B0); PG8_MMA(1, 1, At, B1); PG8_BAR; PG8_SCHED;
            PG8_LDB(B0, 1, 0); PG8_LDB(B1, 1, 1); PG8_SCHED; PG8_LDA(At, 1, 0); PG8_STAGE(PG8_SA(0, 1), a2 + hstep, voffA);
            PG8_WAIT_V(8); PG8_WAIT_L(0); PG8_BAR; PG8_MMA(0, 0, At, B0); PG8_MMA(0, 1, At, B1); PG8_BAR; PG8_SCHED;
            PG8_LDA(At, 1, 1); PG8_STAGE(PG8_SB(1, 0), b3, voffB); PG8_STAGE(PG8_SB(1, 1), b3 + hstep, voffB); PG8_STAGE(PG8_SA(1, 0), a3, voffA);
            PG8_WAIT_V(8); PG8_WAIT_L(0); PG8_BAR; PG8_MMA(1, 0, At, B0); PG8_MMA(1, 1, At, B1); PG8_BAR; PG8_SCHED;
            } else {
            PG8_LDB(B0, 0, 0); PG8_SCHED; PG8_LDA(At, 0, 0); PG8_STAGE(PG8_SA(1, 1), a1 + hstep, voffA);
            PG8_WAIT_L(8); PG8_BAR; PG8_WAIT_L(0); PG8_MMA(0, 0, At, B0); PG8_BAR; PG8_SCHED;
            PG8_LDB(B1, 0, 1); PG8_STAGE(PG8_SB(0, 0), b2, voffB);
            PG8_BAR; PG8_WAIT_L(0); PG8_MMA(0, 1, At, B1); PG8_BAR;
            PG8_LDA(At, 0, 1); PG8_STAGE(PG8_SA(0, 0), a2, voffA);
            PG8_BAR; PG8_WAIT_L(0); PG8_MMA(1, 0, At, B0); PG8_BAR; PG8_SCHED;
            PG8_STAGE(PG8_SB(0, 1), b2 + hstep, voffB);
            PG8_WAIT_V(6); PG8_BAR; PG8_MMA(1, 1, At, B1); PG8_BAR;
            PG8_LDB(B0, 1, 0); PG8_SCHED; PG8_LDA(At, 1, 0); PG8_STAGE(PG8_SA(0, 1), a2 + hstep, voffA);
            PG8_WAIT_L(8); PG8_BAR; PG8_WAIT_L(0); PG8_MMA(0, 0, At, B0); PG8_BAR; PG8_SCHED;
            PG8_LDB(B1, 1, 1); PG8_STAGE(PG8_SB(1, 0), b3, voffB);
            PG8_BAR; PG8_WAIT_L(0); PG8_MMA(0, 1, At, B1); PG8_BAR;
            PG8_LDA(At, 1, 1); PG8_STAGE(PG8_SA(1, 0), a3, voffA);
            PG8_BAR; PG8_WAIT_L(0); PG8_MMA(1, 0, At, B0); PG8_BAR; PG8_SCHED;
            PG8_STAGE(PG8_SB(1, 1), b3 + hstep, voffB);
            PG8_WAIT_V(6); PG8_BAR; PG8_MMA(1, 1, At, B1); PG8_BAR;
            }
        }
        if constexpr (ALIGN_EPI) { if (wr == 0) PG8_BAR; }
        E(acc, cur, wr, wc, fr, fq); S.done(cur);
        if (!has_next) break;
#pragma unroll
        for (int a = 0; a < 2; ++a)
#pragma unroll
            for (int b = 0; b < 2; ++b)
#pragma unroll
                for (int m = 0; m < 4; ++m)
#pragma unroll
                    for (int n = 0; n < 2; ++n) acc[a][b][m][n] = (f32x4){0.f, 0.f, 0.f, 0.f};
        cur = nxt; cA = nA; cB = nB; ++ui;
        if constexpr (ALIGN_EPI) { if (wr == 1) PG8_BAR; }
    }
    PG8_WAIT_V(0);
    if constexpr (!ALIGN_EPI) { if (wr == 0) PG8_BAR; }
    PG8_BAR;
#undef PG8_SA
#undef PG8_SB
#undef PG8_STAGE
#undef PG8_LDA
#undef PG8_LDB
#undef PG8_MMA
#undef PG8_WAIT_V
#undef PG8_WAIT_L
#undef PG8_BAR
#undef PG8_SCHED
}
}

__device__ __forceinline__ int colmap_in(int np) {
    const int pn = np >> 8, c = np & 255;
    const int bj = c >> 7, wc = (c >> 5) & 3, n = (c >> 4) & 1, fq = (c >> 2) & 3, j = c & 3;
    const int cnat = 128 * bj + 32 * wc + 8 * fq + 4 * n + j;
    const int d64 = 16 * fq + 8 * bj + 4 * n + j;
    const int d128 = 64 * bj + 32 * (wc & 1) + 8 * fq + 4 * n + j;
    if (pn <= 1) return 64 * (4 * pn + wc) + d64;
    if (pn == 2) return (wc < 2 ? 512 + 64 * wc : 640 + 64 * (wc - 2)) + d64;
    if (pn <= 4) return 768 + 256 * (pn - 3) + cnat;
    if (pn <= 6) return 1280 + 128 * (2 * (pn - 5) + (wc >> 1)) + d128;
    if (pn <= 8) return 1792 + 128 * (2 * (pn - 7) + (wc >> 1)) + d128;
    if (pn <= 10) return 2304 + 256 * (pn - 9) + cnat;
    return 2816 + 256 * (pn - 11) + cnat;
}
__device__ __forceinline__ int colmap_out(int np) {
    const int pn = np >> 8, c = np & 255;
    const int bj = c >> 7, wc = (c >> 5) & 3, n = (c >> 4) & 1, fq = (c >> 2) & 3, j = c & 3;
    return 256 * pn + 128 * bj + 32 * wc + 8 * fq + 4 * n + j;
}

__device__ __forceinline__ int cm_c64(int d, int wc) { return 128 * ((d >> 3) & 1) + 32 * wc + 16 * ((d >> 2) & 1) + 4 * (d >> 4) + (d & 3); }
__device__ __forceinline__ int cm_nat(int x) { return 128 * (x >> 7) + 32 * ((x >> 5) & 3) + 16 * ((x >> 2) & 1) + 4 * ((x >> 3) & 3) + (x & 3); }
__device__ __forceinline__ int cm_c128(int d, int hsel) { return 128 * (d >> 6) + 32 * (2 * hsel + ((d >> 5) & 1)) + 16 * ((d >> 2) & 1) + 4 * ((d >> 3) & 3) + (d & 3); }
__device__ __forceinline__ int colinv_in(int col) {
    if (col < 512) { const int head = col >> 6; return 256 * (head >> 2) + cm_c64(col & 63, head & 3); }
    if (col < 640) { const int o = col - 512; return 512 + cm_c64(o & 63, o >> 6); }
    if (col < 768) { const int o = col - 640; return 512 + cm_c64(o & 63, 2 + (o >> 6)); }
    if (col < 1280) { const int o = col - 768; return 256 * (3 + (o >> 8)) + cm_nat(o & 255); }
    if (col < 1792) { const int o = col - 1280, head = o >> 7; return 256 * (5 + (head >> 1)) + cm_c128(o & 127, head & 1); }
    if (col < 2304) { const int o = col - 1792, head = o >> 7; return 256 * (7 + (head >> 1)) + cm_c128(o & 127, head & 1); }
    if (col < 2816) { const int o = col - 2304; return 256 * (9 + (o >> 8)) + cm_nat(o & 255); }
    const int o = col - 2816; return 256 * (11 + (o >> 8)) + cm_nat(o & 255);
}
__device__ __forceinline__ int colinv_out(int col) { return 256 * (col >> 8) + cm_nat(col & 255); }
struct EpiIn {
    bf16_t* P; const float* rowss; const float* qg; const float* kg; const float* tabA; const float* tabB;
    float* kp; float* vp; float* ks; float* vs;
    __device__ __forceinline__ void operator()(const f32x4 (&acc)[2][2][4][2], const pg8::Unit& u, int wr, int wc, int fr, int fq) const {
        const int pn = u.pn;
        const int rowb = u.pm * 256 + wr * 64 + fr;
        float rr[2][4];
#pragma unroll
        for (int ai = 0; ai < 2; ++ai)
#pragma unroll
            for (int m = 0; m < 4; ++m) rr[ai][m] = rowss[rowb + ai * 128 + m * 16];
        if (pn <= 2) {
            const bool isv = (pn == 2 && wc >= 2), isk = (pn == 2 && wc < 2);
            const int head = (pn == 2) ? (wc & 1) : 4 * pn + wc;
            const int colbase = ((pn == 2) ? (isv ? 640 : 512) : 0) + 64 * head + 16 * fq;
            const float* gp = isk ? kg : qg;
#pragma unroll
            for (int am = 0; am < 4; ++am) {
                const int ai = am >> 1;
                f32x4 ca[4][2], sa[4][2];
                if (!isv) {
#pragma unroll
                    for (int m = 2 * (am & 1); m < 2 * (am & 1) + 2; ++m) {
                        const int row = rowb + ai * 128 + m * 16;
                        const int pos = (row < MP) ? (row & 8191) : (8192 + ((row - MP) & 3));
#pragma unroll
                        for (int n = 0; n < 2; ++n) { ca[m][n] = *(const f32x4*)(tabA + pos * 16 + 4 * n); sa[m][n] = *(const f32x4*)(tabA + pos * 16 + 8 + 4 * n); }
                    }
                }
#pragma unroll
                for (int m = 2 * (am & 1); m < 2 * (am & 1) + 2; ++m) {
                    const int row = rowb + ai * 128 + m * 16;
                    const float r = rsqrtf(rr[ai][m] * (1.0f / 1024.0f) + 1e-6f);
                    const int pos = (row < MP) ? (row & 8191) : (8192 + ((row - MP) & 3));
                    f32x4 v[2][2];
#pragma unroll
                    for (int bj = 0; bj < 2; ++bj)
#pragma unroll
                        for (int n = 0; n < 2; ++n) v[bj][n] = acc[ai][bj][m][n] * r;
                    if (!isv) {
                        float ss = 0.f;
#pragma unroll
                        for (int bj = 0; bj < 2; ++bj)
#pragma unroll
                            for (int n = 0; n < 2; ++n) { const f32x4 x = v[bj][n]; ss += (x[0] * x[0] + x[1] * x[1]) + (x[2] * x[2] + x[3] * x[3]); }
                        ss += shx(ss, 16, (fq * 16 + fr)); ss += shx(ss, 32, (fq * 16 + fr));
                        const float rn = rsqrtf(ss * (1.0f / 64.0f) + 1e-6f);
#pragma unroll
                        for (int bj = 0; bj < 2; ++bj)
#pragma unroll
                            for (int n = 0; n < 2; ++n) v[bj][n] = v[bj][n] * rn * *(const f32x4*)(gp + 16 * fq + 8 * bj + 4 * n);
                        if (fq == 0) {
#pragma unroll
                            for (int n = 0; n < 2; ++n) {
                                const f32x4 c = ca[m][n], s = sa[m][n];
                                const f32x4 x1 = v[0][n], x2 = v[1][n];
                                v[0][n] = x1 * c - x2 * s; v[1][n] = x2 * c + x1 * s;
                            }
                        }
                    }
                    if (pn == 2) {
                        float* dst = nullptr;
                        if (row < MP) { if (pos >= SEQ - 128) dst = (isv ? vp : kp) + ((((row >> 13) * 128 + (pos - (SEQ - 128))) * 2 + head) * 64 + 16 * fq); }
                        else { const int sr = row - MP; dst = (isv ? vs : ks) + ((((sr >> 2) * 128 + 124 + (sr & 3)) * 2 + head) * 64 + 16 * fq); }
                        if (dst) {
#pragma unroll
                            for (int bj = 0; bj < 2; ++bj)
#pragma unroll
                                for (int n = 0; n < 2; ++n) *(f32x4*)(dst + 8 * bj + 4 * n) = v[bj][n];
                        }
                    }
                    bf16_t* pp = P + (size_t)row * NIN + colbase;
                    if (pn < 2) {
#pragma unroll
                        for (int bj = 0; bj < 2; ++bj)
#pragma unroll
                            for (int n = 0; n < 2; ++n) v[bj][n] = v[bj][n] * (0.125f * LOG2E);
                    }
#pragma unroll
                    for (int bj = 0; bj < 2; ++bj) {
                        u32x4 w; w.x = pk(v[bj][0][0], v[bj][0][1]); w.y = pk(v[bj][0][2], v[bj][0][3]);
                        w.z = pk(v[bj][1][0], v[bj][1][1]); w.w = pk(v[bj][1][2], v[bj][1][3]);
                        *(u32x4*)(pp + 8 * bj) = w;
                    }
                }
            }
        } else if (pn <= 4 || pn >= 9) {
            const bool silu = (pn <= 4 || pn >= 11);
            const int colbase = (pn <= 4 ? 768 + 256 * (pn - 3) : (pn <= 10 ? 2304 + 256 * (pn - 9) : 2816 + 256 * (pn - 11))) + 32 * wc + 8 * fq;
#pragma unroll
            for (int ai = 0; ai < 2; ++ai)
#pragma unroll
                for (int m = 0; m < 4; ++m) {
                    const int row = rowb + ai * 128 + m * 16;
                    const float r = rsqrtf(rr[ai][m] * (1.0f / 1024.0f) + 1e-6f);
                    bf16_t* pp = P + (size_t)row * NIN + colbase;
#pragma unroll
                    for (int bj = 0; bj < 2; ++bj) {
                        f32x4 v0 = acc[ai][bj][m][0] * r, v1 = acc[ai][bj][m][1] * r;
                        if (silu) {
#pragma unroll
                            for (int e = 0; e < 4; ++e) { v0[e] = v0[e] * __builtin_amdgcn_rcpf(1.0f + ex2(-v0[e] * LOG2E)); v1[e] = v1[e] * __builtin_amdgcn_rcpf(1.0f + ex2(-v1[e] * LOG2E)); }
                        }
                        u32x4 w; w.x = pk(v0[0], v0[1]); w.y = pk(v0[2], v0[3]); w.z = pk(v1[0], v1[1]); w.w = pk(v1[2], v1[3]);
                        *(u32x4*)(pp + 128 * bj) = w;
                    }
                }
        } else {
            const bool isk = pn >= 7;
            const int head = 2 * ((pn - 5) & 1) + (wc >> 1), hh = wc & 1;
            const int colbase = (isk ? 1792 : 1280) + 128 * head + 32 * hh + 8 * fq;
            const float post = __builtin_bit_cast(float, __builtin_amdgcn_readfirstlane(isk ? 0x3db504f3 : 0x3f800000));
#pragma unroll
            for (int am = 0; am < 4; ++am) {
                const int ai = am >> 1;
                f32x4 cc[4][2], sn[4][2];
#pragma unroll
                for (int m = 2 * (am & 1); m < 2 * (am & 1) + 2; ++m) {
                    const int row = rowb + ai * 128 + m * 16;
                    const int pos = (row < MP) ? (row & 8191) : (8192 + ((row - MP) & 3));
                    const float* tb = tabB + pos * 128 + 32 * hh + 8 * fq;
#pragma unroll
                    for (int n = 0; n < 2; ++n) { cc[m][n] = *(const f32x4*)(tb + 4 * n); sn[m][n] = *(const f32x4*)(tb + 64 + 4 * n); }
                }
#pragma unroll
                for (int m = 2 * (am & 1); m < 2 * (am & 1) + 2; ++m) {
                    const int row = rowb + ai * 128 + m * 16;
                    const float r = rsqrtf(rr[ai][m] * (1.0f / 1024.0f) + 1e-6f) * post;
                    f32x4 y1[2], y2[2];
#pragma unroll
                    for (int n = 0; n < 2; ++n) {
                        const f32x4 c = cc[m][n], s = sn[m][n];
                        const f32x4 x1 = acc[ai][0][m][n] * r, x2 = acc[ai][1][m][n] * r;
                        y1[n] = x1 * c - x2 * s; y2[n] = x2 * c + x1 * s;
                    }
                    bf16_t* pp = P + (size_t)row * NIN + colbase;
                    u32x4 w; w.x = pk(y1[0][0], y1[0][1]); w.y = pk(y1[0][2], y1[0][3]); w.z = pk(y1[1][0], y1[1][1]); w.w = pk(y1[1][2], y1[1][3]);
                    *(u32x4*)pp = w;
                    w.x = pk(y2[0][0], y2[0][1]); w.y = pk(y2[0][2], y2[0][3]); w.z = pk(y2[1][0], y2[1][1]); w.w = pk(y2[1][2], y2[1][3]);
                    *(u32x4*)(pp + 64) = w;
                }
            }
        }
    }
};

struct EpiOut {
    const float* xin_p; const float* xin_s;
    float* xout;
    const bf16_t* XBi; bf16_t* XB; float* rowss_next;
    __device__ __forceinline__ void operator()(const f32x4 (&acc)[2][2][4][2], const pg8::Unit& u, int wr, int wc, int fr, int fq) const {
        const int rowb = u.pm * 256 + wr * 64 + fr;
        const int colb = u.pn * 256 + 32 * wc + 8 * fq;
        const bool f32in = (xin_p != nullptr), last = (xout != nullptr);
#pragma unroll
        for (int ai = 0; ai < 2; ++ai) {
            f32x4 pre[4][2][2];
            if (f32in) {
#pragma unroll
                for (int m = 0; m < 4; ++m) { const int row = rowb + ai * 128 + m * 16;
                    const float* xr = (row < MP) ? xin_p + (size_t)row * DM : xin_s + (size_t)(row - MP) * DM;
#pragma unroll
                    for (int bj = 0; bj < 2; ++bj) { pre[m][bj][0] = *(const f32x4*)(xr + colb + 128 * bj); pre[m][bj][1] = *(const f32x4*)(xr + colb + 128 * bj + 4); } }
            } else {
                u32x4 pb[4][2];
#pragma unroll
                for (int m = 0; m < 4; ++m) { const int row = rowb + ai * 128 + m * 16;
#pragma unroll
                    for (int bj = 0; bj < 2; ++bj) pb[m][bj] = __builtin_nontemporal_load((const u32x4*)(XBi + (size_t)row * DM + colb + 128 * bj)); }
#pragma unroll
                for (int m = 0; m < 4; ++m)
#pragma unroll
                    for (int bj = 0; bj < 2; ++bj) { const u32x4 w = pb[m][bj];
                        pre[m][bj][0] = (f32x4){bflo(w.x), bfhi(w.x), bflo(w.y), bfhi(w.y)}; pre[m][bj][1] = (f32x4){bflo(w.z), bfhi(w.z), bflo(w.w), bfhi(w.w)}; }
            }
#pragma unroll
            for (int m = 0; m < 4; ++m) {
                const int row = rowb + ai * 128 + m * 16;
                float ss = 0.f;
#pragma unroll
                for (int bj = 0; bj < 2; ++bj) {
                    const int col = colb + 128 * bj;
                    const f32x4 v0 = pre[m][bj][0] + acc[ai][bj][m][0], v1 = pre[m][bj][1] + acc[ai][bj][m][1];
                    if (last) { __builtin_nontemporal_store(v0, (f32x4*)(xout + (size_t)row * DM + col)); __builtin_nontemporal_store(v1, (f32x4*)(xout + (size_t)row * DM + col + 4)); }
                    else {
                        u32x4 w; w.x = pk(v0[0], v0[1]); w.y = pk(v0[2], v0[3]); w.z = pk(v1[0], v1[1]); w.w = pk(v1[2], v1[3]);
                        *(u32x4*)(XB + (size_t)row * DM + col) = w;
                        ss += (v0[0] * v0[0] + v0[1] * v0[1]) + (v0[2] * v0[2] + v0[3] * v0[3]) + (v1[0] * v1[0] + v1[1] * v1[1]) + (v1[2] * v1[2] + v1[3] * v1[3]);
                    }
                }
                if (!last) { ss += shx(ss, 16, (fq * 16 + fr)); ss += shx(ss, 32, (fq * 16 + fr)); if (fq == 0) atomicAdd(rowss_next + row, ss); }
            }
        }
    }
};
struct OneUnit {
    int pm, pn;
    __device__ __forceinline__ bool next(int i, pg8::Unit& u) const { if (i > 0) return false; u.pm = pm; u.pn = pn; return true; }
    __device__ __forceinline__ void a_ready(const pg8::Unit&) const {}
    __device__ __forceinline__ void done(const pg8::Unit&) const {}
};

__device__ __forceinline__ void p0_transpose_item(const float* W, int K, int N, const float* g, bf16_t* WT, bool is_in, LAS float* scr, int item, int lane) {
    const int nblk = N / 32, kb = item / nblk, nb = item % nblk, k0 = 64 * kb, s0 = 32 * nb;
    float tw[32];
#pragma unroll
    for (int i = 0; i < 32; ++i) tw[i] = __builtin_nontemporal_load(W + (size_t)(k0 + 2 * i + (lane >> 5)) * N + s0 + (lane & 31));
#pragma unroll
    for (int i = 0; i < 32; ++i) { const int kk = 2 * i + (lane >> 5); const float gvv = g ? g[k0 + kk] : 1.0f; scr[kk * 33 + (lane & 31)] = tw[i] * gvv; }
    asm volatile("s_waitcnt lgkmcnt(0)" ::: "memory");
    const int c = lane & 7;
#pragma unroll
    for (int j = 0; j < 4; ++j) { const int n = (lane >> 3) + 8 * j; const LAS float* s = scr + (8 * c) * 33 + n;
        const int drow = is_in ? colinv_in(s0 + n) : colinv_out(s0 + n);
        u32x4 o; o.x = pk(s[0 * 33], s[1 * 33]); o.y = pk(s[2 * 33], s[3 * 33]); o.z = pk(s[4 * 33], s[5 * 33]); o.w = pk(s[6 * 33], s[7 * 33]);
        *(u32x4*)(WT + (size_t)drow * K + k0 + 8 * c) = o; }
    asm volatile("s_waitcnt lgkmcnt(0)" ::: "memory");
}
__device__ __forceinline__ void sincos_d(double x, double& s, double& c) {
    const double kd = __builtin_rint(x * 0.63661977236758134308);
    const double r = (x - kd * 1.57079632673412561417e+00) - kd * 6.07710050650619224932e-11;
    const int k = ((int)kd) & 3;
    const double r2 = r * r;
    const double sp = r * (1.0 + r2 * (-1.0 / 6.0 + r2 * (1.0 / 120.0 + r2 * (-1.0 / 5040.0 + r2 * (1.0 / 362880.0 + r2 * (-1.0 / 39916800.0 + r2 * (1.0 / 6227020800.0)))))));
    const double cp = 1.0 + r2 * (-0.5 + r2 * (1.0 / 24.0 + r2 * (-1.0 / 720.0 + r2 * (1.0 / 40320.0 + r2 * (-1.0 / 3628800.0 + r2 * (1.0 / 479001600.0 + r2 * (-1.0 / 87178291200.0)))))));
    s = (k == 0) ? sp : (k == 1) ? cp : (k == 2) ? -sp : -cp;
    c = (k == 0) ? cp : (k == 1) ? -sp : (k == 2) ? -cp : sp;
}

struct Args { const float* in[11]; float* out; unsigned char* ws; double baseA, baseB; int ph_lo, ph_hi; };

__device__ __forceinline__ void p0_prologue(const Args& a, LAS unsigned char* lds, int tid, int G) {
    const int lane = tid & 63, wave = tid >> 6;
    LAS float* scr = (LAS float*)(lds + wave * 16384);
    const int gw = blockIdx.x * 8 + wave, NGW = G * 8;
    unsigned char* ws = a.ws;
    constexpr int I_IN = (DM / 64) * (NIN / 32), I_OUT = (DM / 64) * (DM / 32);
    for (int it = gw; it < DEPTH * (I_IN + I_OUT); it += NGW) {
        const int l = it / (I_IN + I_OUT); int r = it - l * (I_IN + I_OUT);
        if (r < I_IN) p0_transpose_item(a.in[5] + (size_t)l * DM * NIN, DM, NIN, a.in[7] + l * DM, (bf16_t*)(ws + WS_WIN) + (size_t)l * NIN * DM, true, scr, r, lane);
        else p0_transpose_item(a.in[6] + (size_t)l * DM * DM, DM, DM, nullptr, (bf16_t*)(ws + WS_WOUT) + (size_t)l * DM * DM, false, scr, r - I_IN, lane);
    }
    float* rowss = (float*)(ws + WS_ROWSS);
    bf16_t* XB = (bf16_t*)(ws + WS_XB);
    for (int m0 = gw; m0 < MT; m0 += 4 * NGW) {
        f32x4 v[4][4];
#pragma unroll
        for (int q = 0; q < 4; ++q) { const int m = m0 + q * NGW; if (m < MT) { const float* xr = (m < MP) ? a.in[0] + (size_t)m * DM : a.in[1] + (size_t)(m - MP) * DM;
#pragma unroll
            for (int j = 0; j < 4; ++j) v[q][j] = *(const f32x4*)(xr + 4 * lane + 256 * j); } }
#pragma unroll
        for (int q = 0; q < 4; ++q) { const int m = m0 + q * NGW; if (m < MT) {
            float s = 0.f;
#pragma unroll
            for (int j = 0; j < 4; ++j) { const f32x4 x = v[q][j]; s += (x[0] * x[0] + x[1] * x[1]) + (x[2] * x[2] + x[3] * x[3]);
                u32x2 w; w.x = pk(x[0], x[1]); w.y = pk(x[2], x[3]); *(u32x2*)(XB + (size_t)m * DM + 4 * lane + 256 * j) = w; }
#pragma unroll
            for (int o = 1; o < 64; o <<= 1) s += shx(s, o, lane);
            if (lane == 0) rowss[m] = s; } }
    }
    const int gt = blockIdx.x * 512 + tid, NGT = G * 512;
    for (int i = gt; i < 3 * MT; i += NGT) rowss[MT + i] = 0.f;
    float* tabB = (float*)(ws + WS_TABB); float* tabA = (float*)(ws + WS_TABA);
    for (int idx = gt; idx < NPOS * 72; idx += NGT) {
        const int pos = idx / 72, i = idx - pos * 72;
        const bool isB = i < 64; const int ii = isB ? i : i - 64; const double base = isB ? a.baseB : a.baseA;
        double p = 1.0; for (int k = 0; k < ii; ++k) p *= base;
        const float inv = (float)p; const float ang = (float)pos * inv;
        double s, c; sincos_d((double)ang, s, c);
        if (isB) { tabB[pos * 128 + ii] = (float)c; tabB[pos * 128 + 64 + ii] = (float)s; }
        else { tabA[pos * 16 + ii] = (float)c; tabA[pos * 16 + 8 + ii] = (float)s; }
    }
}


__device__ __forceinline__ void tr_write_sw(LAS bf16_t* img, int RS, int c8, int SM, int tok, u32x4 vv, int XL, int lane) {
    const bool odd = tok & 1;
    const unsigned s0 = odd ? vv.x : vv.z, s1 = odd ? vv.y : vv.w;
    const unsigned r0 = (unsigned)shxi((int)s0, XL, lane), r1 = (unsigned)shxi((int)s1, XL, lane);
    const unsigned a0 = odd ? r0 : vv.x, a1 = odd ? r1 : vv.y, b0 = odd ? vv.z : r0, b1 = odd ? vv.w : r1;
    LAS unsigned* p = (LAS unsigned*)(img + (8 * c8 + (odd ? 4 : 0)) * RS + ((((tok >> 3) ^ (c8 & SM)) << 3) + (tok & 6)));
    const int rs2 = RS >> 1;
    p[0] = (a0 & 0xffffu) | (b0 << 16); p[rs2] = (a0 >> 16) | (b0 & 0xffff0000u);
    p[2 * rs2] = (a1 & 0xffffu) | (b1 << 16); p[3 * rs2] = (a1 >> 16) | (b1 & 0xffff0000u);
}
__device__ __forceinline__ int sw_off(int d, int RS, int SM, int t0) { return d * RS + ((((t0 >> 3) ^ ((d >> 3) & SM)) << 3) + (t0 & 7)); }
struct AttnRegs { u32x4 kv[4], vv[4]; float sink; };
__device__ __forceinline__ void attn_load(AttnRegs& R, const bf16_t* P, int unit, int tid) {
    const int g = unit & 1, qb = (unit >> 1) & 63, n = unit >> 7;
    const int R0 = n * SEQ + qb * 128;
    const int lane = tid & 63, w = tid >> 6, fr = lane & 15, fq = lane >> 4;
#pragma unroll
    for (int i = 0; i < 4; ++i) {
        const int ch = tid + 512 * i, key = ch >> 3, c8 = ch & 7;
        R.kv[i] = (u32x4){0u, 0u, 0u, 0u};
        if (qb > 0 || key >= 128) R.kv[i] = *(const u32x4*)(P + (size_t)(R0 - 128 + key) * NIN + 512 + 64 * g + 8 * c8);
    }
#pragma unroll
    for (int i = 0; i < 4; ++i) { const int key = (tid >> 3) + 64 * i, c8 = tid & 7; R.vv[i] = (u32x4){0u, 0u, 0u, 0u};
        if (qb > 0 || key >= 128) R.vv[i] = *(const u32x4*)(P + (size_t)(R0 - 128 + key) * NIN + 640 + 64 * g + 8 * c8); }
}
__device__ __forceinline__ void attn_compute(LAS unsigned char* lds, const AttnRegs& R, const bf16_t* P, bf16_t* MIX, const float* sinks_l, int unit, int tid) {
    const int g = unit & 1, qb = (unit >> 1) & 63, n = unit >> 7;
    const int R0 = n * SEQ + qb * 128;
    LAS bf16_t* Ks = (LAS bf16_t*)lds;
    LAS bf16_t* Vt = (LAS bf16_t*)(lds + 256 * 144);
    const int lane = tid & 63, w = tid >> 6, fr = lane & 15, fq = lane >> 4;
    const int head = 4 * g + (w >> 1);
#pragma unroll
    for (int i = 0; i < 4; ++i) {
        const int ch = tid + 512 * i, key = ch >> 3, c8 = ch & 7;
        *(LAS u32x4*)(Ks + key * 72 + 8 * c8) = R.kv[i];
    }
#pragma unroll
    for (int i = 0; i < 4; ++i) tr_write_sw(Vt, 264, tid & 7, 7, (tid >> 3) + 64 * i, R.vv[i], 8, tid);
    __syncthreads();
    const float sink2 = sinks_l[head] * LOG2E;
#pragma unroll 1
    for (int qt = 0; qt < 4; ++qt) {
        const int qi = 64 * (w & 1) + 16 * qt + fr;
        const int row = R0 + qi;
        const bf16_t* qp = P + (size_t)row * NIN + 64 * head + 8 * fq;
        const bf16x8 bq0 = *(const bf16x8*)qp, bq1 = *(const bf16x8*)(qp + 32);
        u32x2 gts[4];
#pragma unroll
        for (int dt = 0; dt < 4; ++dt) gts[dt] = *(const u32x2*)(P + (size_t)row * NIN + 768 + 64 * head + 16 * dt + 4 * fq);
        f32x4 s[16];
#pragma unroll
        for (int kt = 0; kt < 16; ++kt) {
            const LAS bf16_t* kr = Ks + (16 * kt + fr) * 72 + 8 * fq;
            const bf16x8 a0 = *(const LAS bf16x8*)kr, a1 = *(const LAS bf16x8*)(kr + 32);
            f32x4 z = (f32x4){0.f, 0.f, 0.f, 0.f};
            z = __builtin_amdgcn_mfma_f32_16x16x32_bf16(a0, bq0, z, 0, 0, 0);
            s[kt] = __builtin_amdgcn_mfma_f32_16x16x32_bf16(a1, bq1, z, 0, 0, 0);
            if ((kt & 3) == 3) __builtin_amdgcn_sched_barrier(0);
        }
        float mx = -INFINITY;
#pragma unroll
        for (int kt = 0; kt < 16; ++kt)
#pragma unroll
            for (int r = 0; r < 4; ++r) {
                const int key = 16 * kt + 4 * fq + r;
                const bool valid = (kt < 8) ? (qb > 0 && key > qi) : (key - 128 <= qi);
                const float x = valid ? s[kt][r] : -INFINITY; s[kt][r] = x; mx = fmaxf(mx, x);
            }
        mx = fmaxf(mx, shx(mx, 16, lane)); mx = fmaxf(mx, shx(mx, 32, lane)); mx = fmaxf(mx, sink2);
        float sum = 0.f;
#pragma unroll
        for (int kt = 0; kt < 16; ++kt)
#pragma unroll
            for (int r = 0; r < 4; ++r) { const float p = ex2(s[kt][r] - mx); s[kt][r] = p; sum += p; }
        sum += shx(sum, 16, lane); sum += shx(sum, 32, lane); sum += ex2(sink2 - mx);
        f32x4 o[4];
#pragma unroll
        for (int dt = 0; dt < 4; ++dt) o[dt] = (f32x4){0.f, 0.f, 0.f, 0.f};
#pragma unroll
        for (int k2 = 0; k2 < 8; ++k2) {
            u32x4 pw; pw.x = pk(s[2 * k2][0], s[2 * k2][1]); pw.y = pk(s[2 * k2][2], s[2 * k2][3]); pw.z = pk(s[2 * k2 + 1][0], s[2 * k2 + 1][1]); pw.w = pk(s[2 * k2 + 1][2], s[2 * k2 + 1][3]);
            const bf16x8 pb = __builtin_bit_cast(bf16x8, pw);
#pragma unroll
            for (int dt = 0; dt < 4; ++dt) {
                const u32x2 lo = *(const LAS u32x2*)(Vt + sw_off(16 * dt + fr, 264, 7, 32 * k2 + 4 * fq)), hi = *(const LAS u32x2*)(Vt + sw_off(16 * dt + fr, 264, 7, 32 * k2 + 16 + 4 * fq));
                const u32x4 aw = (u32x4){lo.x, lo.y, hi.x, hi.y};
                o[dt] = __builtin_amdgcn_mfma_f32_16x16x32_bf16(__builtin_bit_cast(bf16x8, aw), pb, o[dt], 0, 0, 0);
            }
        }
        const float inv = 1.0f / sum;
#pragma unroll
        for (int dt = 0; dt < 4; ++dt) {
            const u32x2 gt = gts[dt];
            u32x2 wv; wv.x = pk(o[dt][0] * inv * bflo(gt.x), o[dt][1] * inv * bfhi(gt.x)); wv.y = pk(o[dt][2] * inv * bflo(gt.y), o[dt][3] * inv * bfhi(gt.y));
            *(u32x2*)(MIX + (size_t)row * DM + 64 * head + 16 * dt + 4 * fq) = wv;
        }
    }
    __syncthreads();
}

struct UcRegs { u32x4 kv[4], vv[4]; };
__device__ __forceinline__ void uc_load(UcRegs& R, const bf16_t* P, int unit, int tid) {
    const int h = unit & 3, c = (unit >> 2) & 63, n = unit >> 8;
    const int R0 = n * SEQ + c * 128;
#pragma unroll
    for (int i = 0; i < 4; ++i) { const int j = (tid >> 4) + 32 * i, c8 = tid & 15; const bf16_t* pr = P + (size_t)(R0 + j) * NIN + 128 * h + 8 * c8;
        R.kv[i] = *(const u32x4*)(pr + 1792); R.vv[i] = *(const u32x4*)(pr + 2304); }
}
__device__ __forceinline__ void uc_compute(LAS unsigned char* lds, const UcRegs& R, float* UT, int unit, int tid) {
    const int h = unit & 3;
    const float l2g = l2gamma(h);
    LAS bf16_t* Kt = (LAS bf16_t*)lds;
    LAS bf16_t* Vt = (LAS bf16_t*)(lds + 128 * 272);
    const int lane = tid & 63, w = tid >> 6, fr = lane & 15, fq = lane >> 4;
#pragma unroll
    for (int i = 0; i < 4; ++i) { const int j = (tid >> 4) + 32 * i, c8 = tid & 15; const u32x4 kv = R.kv[i];
        const float dec = ex2((float)(127 - j) * l2g);
        u32x4 kd; kd.x = pk(bflo(kv.x) * dec, bfhi(kv.x) * dec); kd.y = pk(bflo(kv.y) * dec, bfhi(kv.y) * dec);
        kd.z = pk(bflo(kv.z) * dec, bfhi(kv.z) * dec); kd.w = pk(bflo(kv.w) * dec, bfhi(kv.w) * dec);
        tr_write_sw(Kt, 136, c8, 15, j, kd, 16, tid); tr_write_sw(Vt, 136, c8, 15, j, R.vv[i], 16, tid); }
    __syncthreads();
    const int mt0 = 2 * (w & 3), nt0 = 4 * (w >> 2);
    f32x4 acc[2][4];
#pragma unroll
    for (int mi = 0; mi < 2; ++mi)
#pragma unroll
        for (int ni = 0; ni < 4; ++ni) acc[mi][ni] = (f32x4){0.f, 0.f, 0.f, 0.f};
#pragma unroll
    for (int ks = 0; ks < 4; ++ks) {
        bf16x8 af[2], bfr[4];
#pragma unroll
        for (int mi = 0; mi < 2; ++mi) af[mi] = *(const LAS bf16x8*)(Kt + sw_off(16 * (mt0 + mi) + fr, 136, 15, 32 * ks + 8 * fq));
#pragma unroll
        for (int ni = 0; ni < 4; ++ni) bfr[ni] = *(const LAS bf16x8*)(Vt + sw_off(16 * (nt0 + ni) + fr, 136, 15, 32 * ks + 8 * fq));
#pragma unroll
        for (int mi = 0; mi < 2; ++mi)
#pragma unroll
            for (int ni = 0; ni < 4; ++ni) acc[mi][ni] = __builtin_amdgcn_mfma_f32_16x16x32_bf16(af[mi], bfr[ni], acc[mi][ni], 0, 0, 0);
    }
    float* ub = UT + (size_t)unit * 16384;
#pragma unroll
    for (int mi = 0; mi < 2; ++mi)
#pragma unroll
        for (int ni = 0; ni < 4; ++ni) *(f32x4*)(ub + (16 * (nt0 + ni) + fr) * 128 + 16 * (mt0 + mi) + 4 * fq) = acc[mi][ni];
    __syncthreads();
}

__device__ __forceinline__ void sattn_unit(LAS unsigned char* lds, const bf16_t* P, bf16_t* MIX, const float* ck, const float* cv, float* kso, float* vso, const float* sinks_l, int unit, int tid) {
    const int n = unit >> 1, g = unit & 1;
    LAS float* Kc = (LAS float*)lds;
    LAS float* Vc = Kc + 132 * 68;
    LAS float* Qs = Vc + 132 * 68;
    LAS float* Sc = Qs + 1024;
    const float sink_pre = sinks_l[4 * g + ((tid >> 5) & 3)];
    bf16_t gate_pre[4];
    {
        const int lane_ = tid & 63, w_ = tid >> 6, d_ = 16 * (w_ & 3) + (lane_ & 15);
        const bf16_t* gp_ = P + (size_t)(MP + 4 * n + (lane_ >> 4)) * NIN + 768 + 64 * 4 * g + d_;
#pragma unroll
        for (int r = 0; r < 4; ++r) gate_pre[r] = gp_[64 * r];
    }
#pragma unroll
    for (int i = 0; i < 4; ++i) {
        const int ch = tid + 512 * i, wp = ch >> 4, c4 = ch & 15;
        const size_t src = (size_t)((n * 128 + wp) * 2 + g) * 64 + 4 * c4;
        const f32x4 kv = __builtin_nontemporal_load((const f32x4*)(ck + src)), vv = __builtin_nontemporal_load((const f32x4*)(cv + src));
        *(LAS f32x4*)(Kc + wp * 68 + 4 * c4) = kv; *(LAS f32x4*)(Vc + wp * 68 + 4 * c4) = vv;
        if (wp >= 4) { const size_t dst = (size_t)((n * 128 + wp - 4) * 2 + g) * 64 + 4 * c4; __builtin_nontemporal_store(kv, (f32x4*)(kso + dst)); __builtin_nontemporal_store(vv, (f32x4*)(vso + dst)); }
    }
    if (tid < 64) {
        const int t = tid >> 4, c4 = tid & 15;
        const size_t src = (size_t)((n * 128 + 124 + t) * 2 + g) * 64 + 4 * c4;
        *(LAS f32x4*)(Kc + (128 + t) * 68 + 4 * c4) = *(const f32x4*)(kso + src); *(LAS f32x4*)(Vc + (128 + t) * 68 + 4 * c4) = *(const f32x4*)(vso + src);
    }
    const int qi = tid >> 5, ln = tid & 31;
    const int head = 4 * g + (qi & 3), row = MP + 4 * n + (qi >> 2);
    { const unsigned u = *(const unsigned*)(P + (size_t)row * NIN + 64 * head + 2 * ln); Qs[qi * 64 + 2 * ln] = bflo(u); Qs[qi * 64 + 2 * ln + 1] = bfhi(u); }
    __syncthreads();
    const int lane = tid & 63, w = tid >> 6, fr = lane & 15, fq = lane >> 4;
#pragma unroll 1
    for (int kt = w; kt < 9; kt += 8) {
        f32x4 z = (f32x4){0.f, 0.f, 0.f, 0.f};
#pragma unroll
        for (int st = 0; st < 16; ++st) z = __builtin_amdgcn_mfma_f32_16x16x4f32(Qs[fr * 64 + 4 * st + fq], Kc[(16 * kt + fr) * 68 + 4 * st + fq], z, 0, 0, 0);
        const int k = 16 * kt + fr;
        if (k < 132) {
            const bool valid = (k >= fq + 1) && (k <= fq + 128);
#pragma unroll
            for (int r = 0; r < 4; ++r) Sc[(4 * fq + r) * 136 + k] = valid ? z[r] : -INFINITY;
        }
    }
    __syncthreads();
    const float sink2 = sink_pre * LOG2E;
    float mx = -INFINITY;
    for (int k = ln; k < 132; k += 32) mx = fmaxf(mx, Sc[qi * 136 + k]);
#pragma unroll
    for (int o = 1; o < 32; o <<= 1) mx = fmaxf(mx, shx(mx, o, tid));
    mx = fmaxf(mx, sink2);
    float sum = 0.f;
    for (int k = ln; k < 132; k += 32) { const float p = ex2(Sc[qi * 136 + k] - mx); Sc[qi * 136 + k] = p; sum += p; }
#pragma unroll
    for (int o = 1; o < 32; o <<= 1) sum += shx(sum, o, tid);
    if (ln == 0) Sc[qi * 136 + 132] = 1.0f / (sum + ex2(sink2 - mx));
    __syncthreads();
    if (w < 4) {
        f32x4 o = (f32x4){0.f, 0.f, 0.f, 0.f};
#pragma unroll 11
        for (int st = 0; st < 33; ++st) o = __builtin_amdgcn_mfma_f32_16x16x4f32(Sc[fr * 136 + 4 * st + fq], Vc[(4 * st + fq) * 68 + 16 * w + fr], o, 0, 0, 0);
        const int d = 16 * w + fr, orow = MP + 4 * n + fq;
#pragma unroll
        for (int r = 0; r < 4; ++r) {
            const int hd = 4 * g + r;
            const float gate = bf2f(gate_pre[r]);
            MIX[(size_t)orow * DM + 64 * hd + d] = (bf16_t)(pk(o[r] * Sc[(4 * fq + r) * 136 + 132] * gate, 0.f) & 0xffffu);
        }
    }
    __syncthreads();
}

struct SretRegs { f32x4 s4[8]; float gate; unsigned qkv; unsigned vv; };
__device__ __forceinline__ void sret_load(SretRegs& R, const bf16_t* P, const float* Sin, int unit, int tid) {
    const int n = unit >> 2, h = unit & 3;
    const int v4 = tid & 31, dg = tid >> 5;
    const float* Sb = Sin + (size_t)unit * 16384;
    const int t = tid >> 7, d = tid & 127;
    const bf16_t* pr = P + (size_t)(MP + 4 * n + t) * NIN + 128 * h + d;
    R.qkv = (unsigned)pr[1280] | ((unsigned)pr[1792] << 16); R.vv = (unsigned)pr[2304];
    R.gate = bf2f(pr[2816]);
#pragma unroll
    for (int i = 0; i < 8; ++i) R.s4[i] = __builtin_nontemporal_load((const f32x4*)(Sb + (8 * dg + i) * 128 + 4 * v4));
}
__device__ __forceinline__ void sret_compute(LAS unsigned char* lds, const SretRegs& R, bf16_t* MIX, float* Sout, int unit, int tid) {
    const int n = unit >> 2, h = unit & 3;
    const float l2g = l2gamma(h);
    LAS float* qs = (LAS float*)lds;
    LAS float* ks_ = qs + 512;
    LAS float* vs_ = qs + 1024;
    LAS float* qk = qs + 1536;
    LAS float* red = qs + 1552;
    LAS float* part = qs + 2048;
    const int v4 = tid & 31, dg = tid >> 5;
    float* So = Sout + (size_t)unit * 16384;
    qs[tid] = bflo(R.qkv); ks_[tid] = bfhi(R.qkv); vs_[tid] = bflo(R.vv);
    __syncthreads();
    f32x4 vj[4], cr[4];
#pragma unroll
    for (int j = 0; j < 4; ++j) { vj[j] = *(const LAS f32x4*)(vs_ + j * 128 + 4 * v4); cr[j] = (f32x4){0.f, 0.f, 0.f, 0.f}; }
    const float g1 = ex2(l2g), g2 = g1 * g1, g3 = g2 * g1, g4 = g2 * g2;
#pragma unroll
    for (int i = 0; i < 8; ++i) {
        const int d = 8 * dg + i;
#pragma unroll
        for (int t = 0; t < 4; ++t) cr[t] += R.s4[i] * qs[t * 128 + d];
        f32x4 sn = R.s4[i] * g4;
        sn += vj[0] * (g3 * ks_[0 * 128 + d]); sn += vj[1] * (g2 * ks_[1 * 128 + d]); sn += vj[2] * (g1 * ks_[2 * 128 + d]); sn += vj[3] * ks_[3 * 128 + d];
        __builtin_nontemporal_store(sn, (f32x4*)(So + d * 128 + 4 * v4));
    }
#pragma unroll
    for (int t = 0; t < 4; ++t) *(LAS f32x4*)(part + (dg * 4 + t) * 128 + 4 * v4) = cr[t];
    {
        const int t = dg >> 2, j = dg & 3; float p = 0.f;
#pragma unroll
        for (int d = v4; d < 128; d += 32) p += qs[t * 128 + d] * ks_[j * 128 + d];
#pragma unroll
        for (int o = 1; o < 32; o <<= 1) p += shx(p, o, tid);
        if (v4 == 0) qk[dg] = p;
    }
    __syncthreads();
    const int t = tid >> 7, v = tid & 127;
    float cross = 0.f;
#pragma unroll
    for (int d2 = 0; d2 < 16; ++d2) cross += part[(d2 * 4 + t) * 128 + v];
    float o = cross * ex2((float)(t + 1) * l2g);
#pragma unroll
    for (int j = 0; j < 4; ++j) if (j <= t) o += qk[t * 4 + j] * ex2((float)(t - j) * l2g) * vs_[j * 128 + v];
    float ss = o * o;
#pragma unroll
    for (int of = 1; of < 64; of <<= 1) ss += shx(ss, of, tid);
    if ((tid & 63) == 0) red[tid >> 6] = ss;
    __syncthreads();
    const float rn = rsqrtf((red[2 * t] + red[2 * t + 1]) * (1.0f / 128.0f) + 1e-6f);
    const int row = MP + 4 * n + t;
    MIX[(size_t)row * DM + 512 + 128 * h + v] = (bf16_t)(pk(o * rn * R.gate, 0.f) & 0xffffu);
    __syncthreads();
}

__device__ __forceinline__ void sample_outproj_slice(LAS unsigned char* lds, const bf16_t* MIX, const bf16_t* Wt, const float* xs_f32, const bf16_t* XBi, bf16_t* XBn, float* yout, float* rowss_next, int b, int tid) {
    const int lane = tid & 63, w = tid >> 6, fr = lane & 15, fq = lane >> 4;
    const int r0 = MP + 32 * (b >> 4), c0 = 64 * (b & 15), k0 = 128 * w;
    f32x4 res;
    {
        const int mt = w >> 1, nt = w & 1;
        const int col = c0 + 32 * (mt >> 1) + 8 * fq + 4 * (mt & 1), row = r0 + 16 * nt + fr;
        if (xs_f32) res = *(const f32x4*)(xs_f32 + (size_t)(row - MP) * DM + col);
        else { const u32x2 u = *(const u32x2*)(XBi + (size_t)row * DM + col); res = (f32x4){bflo(u.x), bfhi(u.x), bflo(u.y), bfhi(u.y)}; }
    }
    bf16x8 af[4][4], bfr[2][4];
#pragma unroll
    for (int mt = 0; mt < 4; ++mt)
#pragma unroll
        for (int ks = 0; ks < 4; ++ks) af[mt][ks] = *(const bf16x8*)(Wt + (size_t)(c0 + 16 * mt + fr) * DM + k0 + 32 * ks + 8 * fq);
#pragma unroll
    for (int nt = 0; nt < 2; ++nt)
#pragma unroll
        for (int ks = 0; ks < 4; ++ks) bfr[nt][ks] = *(const bf16x8*)(MIX + (size_t)(r0 + 16 * nt + fr) * DM + k0 + 32 * ks + 8 * fq);
    f32x4 acc[4][2];
#pragma unroll
    for (int mt = 0; mt < 4; ++mt)
#pragma unroll
        for (int nt = 0; nt < 2; ++nt) { f32x4 z = (f32x4){0.f, 0.f, 0.f, 0.f};
#pragma unroll
            for (int ks = 0; ks < 4; ++ks) z = __builtin_amdgcn_mfma_f32_16x16x32_bf16(af[mt][ks], bfr[nt][ks], z, 0, 0, 0);
            acc[mt][nt] = z; }
    LAS f32x4* red = (LAS f32x4*)lds;
#pragma unroll
    for (int mt = 0; mt < 4; ++mt)
#pragma unroll
        for (int nt = 0; nt < 2; ++nt) red[(w * 8 + mt * 2 + nt) * 64 + lane] = acc[mt][nt];
    __syncthreads();
    const int mt = w >> 1, nt = w & 1;
    f32x4 v = (f32x4){0.f, 0.f, 0.f, 0.f};
#pragma unroll
    for (int ww = 0; ww < 8; ++ww) v += red[(ww * 8 + w) * 64 + lane];
    const int col = c0 + 32 * (mt >> 1) + 8 * fq + 4 * (mt & 1);
    const int row = r0 + 16 * nt + fr;
    v += res;
    if (yout) *(f32x4*)(yout + (size_t)row * DM + col) = v;
    else {
        u32x2 o; o.x = pk(v[0], v[1]); o.y = pk(v[2], v[3]);
        *(u32x2*)(XBn + (size_t)row * DM + col) = o;
        float ss = (v[0] * v[0] + v[1] * v[1]) + (v[2] * v[2] + v[3] * v[3]);
        ss += shx(ss, 16, lane); ss += shx(ss, 32, lane);
        if (fq == 0) atomicAdd(rowss_next + row, ss);
    }
    __syncthreads();
}

__device__ __forceinline__ void scan_phase(const float* UT, bf16_t* SPT, float* sp_out_l, int tid, int G) {
    for (int gid = blockIdx.x * 512 + tid; gid < 2 * 4 * 16384; gid += G * 512) {
        const int n = gid >> 16, h = (gid >> 14) & 3, e = gid & 16383;
        const float gd = ex2(128.0f * l2gamma(h));
        const size_t base = ((size_t)(n * 64) * 4 + h) * 16384 + e;
        float S = 0.f;
        for (int c0 = 0; c0 < 64; c0 += 32) {
            float uu[32];
#pragma unroll
            for (int k = 0; k < 32; ++k) uu[k] = __builtin_nontemporal_load(UT + base + (size_t)(c0 + k) * 65536);
#pragma unroll
            for (int k = 0; k < 32; ++k) { SPT[base + (size_t)(c0 + k) * 65536] = (bf16_t)(pk(S, 0.f) & 0xffffu); S = gd * S + uu[k]; }
        }
        const int dv = e >> 7, dk = e & 127;
        sp_out_l[(size_t)(n * 4 + h) * 16384 + dk * 128 + dv] = S;
    }
}

__device__ __forceinline__ void ret_unit(LAS unsigned char* lds, const bf16_t* P, const bf16_t* SPT, bf16_t* MIX, int unit, int tid) {
    const int h = unit & 3, c = (unit >> 2) & 63, n = unit >> 8;
    const int R0 = n * SEQ + c * 128;
    const float l2g = l2gamma(h);
    LAS bf16_t* Ks = (LAS bf16_t*)lds;
    LAS bf16_t* Vt = (LAS bf16_t*)(lds + 128 * 272);
    LAS bf16_t* Ss = (LAS bf16_t*)(lds + 256 * 272);
    const int lane = tid & 63, w = __builtin_amdgcn_readfirstlane(tid >> 6), fr = lane & 15, fq = lane >> 4;
    const int qi = 16 * w + fr, row = R0 + qi;
    bf16x8 bq[4];
#pragma unroll
    for (int ks = 0; ks < 4; ++ks) bq[ks] = *(const bf16x8*)(P + (size_t)row * NIN + 1280 + 128 * h + 32 * ks + 8 * fq);
    u32x2 gts[8];
#pragma unroll
    for (int dt = 0; dt < 8; ++dt) gts[dt] = *(const u32x2*)(P + (size_t)row * NIN + 2816 + 128 * h + 16 * dt + 4 * fq);
#pragma unroll
    for (int i = 0; i < 4; ++i) {
        const int ch = tid + 512 * i, j = ch >> 4, c8 = ch & 15;
        const u32x4 kv = *(const u32x4*)(P + (size_t)(R0 + j) * NIN + 1792 + 128 * h + 8 * c8);
        const u32x4 sv = __builtin_nontemporal_load((const u32x4*)(SPT + (size_t)unit * 16384 + j * 128 + 8 * c8));
        *(LAS u32x4*)(Ks + j * 136 + 8 * c8) = kv;
        *(LAS u32x4*)(Ss + j * 136 + 8 * c8) = sv;
    }
    {
        u32x4 vv[4];
#pragma unroll
        for (int i = 0; i < 4; ++i) vv[i] = *(const u32x4*)(P + (size_t)(R0 + (tid >> 4) + 32 * i) * NIN + 2304 + 128 * h + 8 * (tid & 15));
#pragma unroll
        for (int i = 0; i < 4; ++i) tr_write_sw(Vt, 136, tid & 15, 15, (tid >> 4) + 32 * i, vv[i], 16, tid);
    }
    __syncthreads();
    f32x4 o[8];
#pragma unroll
    for (int dt = 0; dt < 8; ++dt) {
        f32x4 z = (f32x4){0.f, 0.f, 0.f, 0.f};
#pragma unroll
        for (int ks = 0; ks < 4; ++ks) z = __builtin_amdgcn_mfma_f32_16x16x32_bf16(*(const LAS bf16x8*)(Ss + (16 * dt + fr) * 136 + 32 * ks + 8 * fq), bq[ks], z, 0, 0, 0);
        o[dt] = z * ex2((float)(qi + 1) * l2g);
    }
    f32x4 sc[8];
#pragma unroll
    for (int jt = 0; jt < 8; ++jt) {
        f32x4 z = (f32x4){0.f, 0.f, 0.f, 0.f};
        if (jt <= w) {
#pragma unroll
            for (int ks = 0; ks < 4; ++ks) z = __builtin_amdgcn_mfma_f32_16x16x32_bf16(*(const LAS bf16x8*)(Ks + (16 * jt + fr) * 136 + 32 * ks + 8 * fq), bq[ks], z, 0, 0, 0);
#pragma unroll
            for (int r = 0; r < 4; ++r) { const int j = 16 * jt + 4 * fq + r; z[r] = (qi >= j) ? z[r] * ex2((float)(qi - j) * l2g) : 0.f; }
        }
        sc[jt] = z;
    }
#pragma unroll
    for (int k2 = 0; k2 < 4; ++k2) {
        if (2 * k2 <= w) {
            u32x4 pw; pw.x = pk(sc[2 * k2][0], sc[2 * k2][1]); pw.y = pk(sc[2 * k2][2], sc[2 * k2][3]); pw.z = pk(sc[2 * k2 + 1][0], sc[2 * k2 + 1][1]); pw.w = pk(sc[2 * k2 + 1][2], sc[2 * k2 + 1][3]);
            const bf16x8 pb = __builtin_bit_cast(bf16x8, pw);
#pragma unroll
            for (int dt = 0; dt < 8; ++dt) {
                const u32x2 lo = *(const LAS u32x2*)(Vt + sw_off(16 * dt + fr, 136, 15, 32 * k2 + 4 * fq)), hi = *(const LAS u32x2*)(Vt + sw_off(16 * dt + fr, 136, 15, 32 * k2 + 16 + 4 * fq));
                const u32x4 aw = (u32x4){lo.x, lo.y, hi.x, hi.y};
                o[dt] = __builtin_amdgcn_mfma_f32_16x16x32_bf16(__builtin_bit_cast(bf16x8, aw), pb, o[dt], 0, 0, 0);
            }
        }
    }
    float ss = 0.f;
#pragma unroll
    for (int dt = 0; dt < 8; ++dt) ss += (o[dt][0] * o[dt][0] + o[dt][1] * o[dt][1]) + (o[dt][2] * o[dt][2] + o[dt][3] * o[dt][3]);
    ss += shx(ss, 16, lane); ss += shx(ss, 32, lane);
    const float rn = rsqrtf(ss * (1.0f / 128.0f) + 1e-6f);
#pragma unroll
    for (int dt = 0; dt < 8; ++dt) {
        const u32x2 gt = gts[dt];
        u32x2 wv; wv.x = pk(o[dt][0] * rn * bflo(gt.x), o[dt][1] * rn * bfhi(gt.x)); wv.y = pk(o[dt][2] * rn * bflo(gt.y), o[dt][3] * rn * bfhi(gt.y));
        *(u32x2*)(MIX + (size_t)row * DM + 512 + 128 * h + 16 * dt + 4 * fq) = wv;
    }
    __syncthreads();
}


#define XB_TMO      128
#define XB_XCNT(j)  (256  + 64 * (j))
#define XB_XSUB(j)  (1280 + 64 * (j))
#define XB_XGEN(j)  (2304 + 64 * (j))
#define XB_TOP      3328
#define XB_TOPGEN   3392
#define XCD_BAR_WORDS 3456
#define XB_SPIN_CAP (1u << 22)
__device__ __forceinline__ unsigned xb_ld(unsigned* p)              { return __hip_atomic_load(p, __ATOMIC_RELAXED, __HIP_MEMORY_SCOPE_AGENT); }
__device__ __forceinline__ unsigned xb_add(unsigned* p, unsigned v) { return __hip_atomic_fetch_add(p, v, __ATOMIC_RELAXED, __HIP_MEMORY_SCOPE_AGENT); }
__device__ __forceinline__ unsigned xb_xcc_id() { return (unsigned)__builtin_amdgcn_s_getreg((3 << 11) | 20) & 0xFu; }
#define XB_SPIN(cond, bar) do { unsigned _sp = 0; while (cond) { __builtin_amdgcn_s_sleep(1); \
    if ((++_sp & 255u) == 0u) { if (xb_ld(&(bar)[XB_TMO])) break; if (_sp > XB_SPIN_CAP) { atomicAdd(&(bar)[XB_TMO], 1u); break; } } } } while (0)
struct XcdBarrier { unsigned* bar; unsigned x; volatile LAS unsigned* st; };
__device__ __forceinline__ XcdBarrier xcd_barrier_post(unsigned* bar, volatile LAS unsigned* st) {
    XcdBarrier b; b.bar = bar; b.x = xb_xcc_id(); b.st = st;
    if (threadIdx.x == 0) (void)xb_add(&bar[XB_XCNT(b.x)], 1u);
    return b;
}
__device__ __forceinline__ void xcd_barrier_complete(unsigned* bar, unsigned x, unsigned& nloc, unsigned& nx) {
    const unsigned G = gridDim.x * gridDim.y * gridDim.z;
    unsigned sum, cnt, mine, sp = 0u;
    for (;;) {
        sum = 0u; cnt = 0u; mine = 0u;
#pragma unroll
        for (unsigned j = 0; j < 16; ++j) { const unsigned c = xb_ld(&bar[XB_XCNT(j)]); sum += c; cnt += (c > 0u) ? 1u : 0u; mine = (j == x) ? c : mine; }
        if (sum == G) break;
        __builtin_amdgcn_s_sleep(1);
        if ((++sp & 255u) == 0u) { if (xb_ld(&bar[XB_TMO])) break; if (sp > XB_SPIN_CAP) { atomicAdd(&bar[XB_TMO], 1u); break; } }
    }
    nloc = mine > 0u ? mine : 1u; nx = cnt > 0u ? cnt : 1u;
}
__device__ __forceinline__ void xcd_barrier(const XcdBarrier& b0) {
    XcdBarrier b = b0;
    asm volatile("" : "+s"(b.x));
    asm volatile("s_waitcnt vmcnt(0)" ::: "memory");
    __syncthreads();
    if (threadIdx.x == 0) {
        unsigned* bar = b.bar;
        asm volatile("" : "+s"(bar));
        __builtin_amdgcn_s_waitcnt(0);
        unsigned nloc = b.st[0], nx = b.st[1];
        if (nloc == 0u) { xcd_barrier_complete(bar, b.x, nloc, nx); b.st[0] = nloc; b.st[1] = nx; }
        const unsigned old = xb_add(&bar[XB_XSUB(b.x)], 1u);
        const unsigned gen = old / nloc;
        if (old + 1u == (gen + 1u) * nloc) {
            __builtin_amdgcn_fence(__ATOMIC_RELEASE, "agent");
            asm volatile("s_waitcnt vmcnt(0)" ::: "memory");
            const unsigned og = xb_add(&bar[XB_TOP], 1u);
            const unsigned tg = og / nx;
            if (og + 1u == (tg + 1u) * nx) xb_add(&bar[XB_TOPGEN], 1u);
            else XB_SPIN(xb_ld(&bar[XB_TOPGEN]) == tg, bar);
            __builtin_amdgcn_fence(__ATOMIC_ACQUIRE, "agent");
            xb_add(&bar[XB_XGEN(b.x)], 1u);
            asm volatile("s_waitcnt vmcnt(0)" ::: "memory");
        } else {
            XB_SPIN(xb_ld(&bar[XB_XGEN(b.x)]) == gen, bar);
            __builtin_amdgcn_fence(__ATOMIC_ACQUIRE, "agent");
            asm volatile("s_waitcnt vmcnt(0)" ::: "memory");
        }
    }
    __syncthreads();
}
constexpr int MISC_OFF = 131072 + 320;
__device__ __forceinline__ int launder_tid() { int t = threadIdx.x; asm volatile("" : "+v"(t)); return t; }
__global__ void __launch_bounds__(512, 2) hymba_fwd(Args a) {
    extern __shared__ __attribute__((aligned(16))) unsigned char lds_raw[];
    LAS unsigned char* lds = (LAS unsigned char*)lds_raw;
    const int tid = threadIdx.x, G = gridDim.x;
    unsigned char* ws = a.ws;
    float* out = a.out;
    bf16_t* P = (bf16_t*)(ws + WS_P); bf16_t* MIX = (bf16_t*)(ws + WS_MIX);
    float* UT = (float*)(ws + WS_UT); bf16_t* SPT = (bf16_t*)(ws + WS_SPT);
    float* rowss = (float*)(ws + WS_ROWSS);
    const float* tabB = (const float*)(ws + WS_TABB); const float* tabA = (const float*)(ws + WS_TABA);
    const int lo = a.ph_lo, hi = a.ph_hi;
    volatile LAS unsigned* MISC = (volatile LAS unsigned*)(lds + MISC_OFF);
    if (tid < 32) MISC[tid] = 0u;
    __syncthreads();
    XcdBarrier bar = xcd_barrier_post((unsigned*)ws, MISC + 8);
    if (a.ph_lo < 0) cg::this_grid().sync();
#if MK_MULTI
#define IN(k) (lo <= (k) && (k) < hi)
#else
#define IN(k) true
#endif
#define LT() launder_tid()
#define SEAM(k) do { if (IN(k) && IN((k) + 1)) { xcd_barrier(bar); } } while (0)
#ifndef SKIP_P0
    if (IN(0)) for (int rep = 0; rep < REP_P0; ++rep) { p0_prologue(a, lds, tid, G); if (rep + 1 < REP_P0) xcd_barrier(bar); }
#endif
    SEAM(0);
    for (int l = 0; l < DEPTH; ++l) {
        const int pb = 1 + 5 * l;
        const float* sinks_l = a.in[10] + 8 * l;
        bf16_t* XB = (bf16_t*)(ws + ((l & 1) ? WS_XB2 : WS_XB)); bf16_t* XBn = (bf16_t*)(ws + ((l & 1) ? WS_XB : WS_XB2));
#ifndef SKIP_P1
        if (IN(pb)) for (int rep = 0; rep < REP_P1; ++rep) {
            const int b = (int)blockIdx.x;
            unsigned* cnt = (unsigned*)(ws + 14336) + 64 * l;
            pg8::Gemm g{XB, (const bf16_t*)(ws + WS_WIN) + (size_t)l * NIN * DM, MT, NIN, DM};
            EpiIn E{P, rowss + l * MT, a.in[8] + 64 * l, a.in[9] + 64 * l, tabA, tabB,
                    out + O_KP + (size_t)l * 32768, out + O_VP + (size_t)l * 32768, out + O_KS + (size_t)l * 2097152, out + O_VS + (size_t)l * 2097152};
            if (b >= 64 && b < 90) {
                OneUnit S1{64 + (b - 64) / 13, (b - 64) % 13};
                pg8::gemm_phase<EpiIn, OneUnit, true, true>(lds, g, S1, E, LT());
                asm volatile("s_waitcnt vmcnt(0)" ::: "memory");
                __syncthreads();
                if (threadIdx.x == 0) { __builtin_amdgcn_fence(__ATOMIC_RELEASE, "agent"); asm volatile("s_waitcnt vmcnt(0)" ::: "memory"); xb_add(cnt, 1u); }
            }
            pg8::StaticOrder S; S.init(MP, NIN, G, b);
            pg8::gemm_phase<EpiIn, pg8::StaticOrder, true, true>(lds, g, S, E, LT());
            if (b >= 90) {
                if (threadIdx.x == 0) {
                    XB_SPIN(xb_ld(cnt) < 26u * (unsigned)(rep + 1), (unsigned*)ws);
                    __builtin_amdgcn_fence(__ATOMIC_ACQUIRE, "agent"); asm volatile("s_waitcnt vmcnt(0)" ::: "memory");
                }
                __syncthreads();
                const float* ck = a.in[2] + (size_t)l * 2097152; const float* cv = a.in[3] + (size_t)l * 2097152;
                float* kso = out + O_KS + (size_t)l * 2097152; float* vso = out + O_VS + (size_t)l * 2097152;
                const float* sin_l = a.in[4] + (size_t)l * 8388608; float* sout_l = out + O_SS + (size_t)l * 8388608;
                {
                    const int stride = G - 90;
                    int u = b - 90;
                    if (u < 512) {
                        SretRegs cur; sret_load(cur, P, sin_l, u, LT());
#pragma unroll 1
                        for (; u < 512; u += stride) {
                            const int nx = u + stride;
                            SretRegs nxt = cur;
                            if (nx < 512) sret_load(nxt, P, sin_l, nx, LT());
                            sret_compute(lds, cur, MIX, sout_l, u, LT());
                            cur = nxt;
                        }
                    }
#pragma unroll 1
                    for (; u < 768; u += stride) sattn_unit(lds, P, MIX, ck, cv, kso, vso, sinks_l, u - 512, LT());
                }
            }
        }
#endif
        SEAM(pb);
#ifndef SKIP_P2
        if (IN(pb + 1)) for (int rep = 0; rep < REP_P2; ++rep) {
            const int b = (int)blockIdx.x;
            UcRegs u1, u2; AttnRegs ar;
            uc_load(u1, P, b, LT());
            uc_load(u2, P, b + 256, LT());
            uc_compute(lds, u1, UT, b, LT());
            attn_load(ar, P, b, LT());
            uc_compute(lds, u2, UT, b + 256, LT());
            attn_compute(lds, ar, P, MIX, sinks_l, b, LT());
        }
#endif
        SEAM(pb + 1);
#ifndef SKIP_SCAN
        if (IN(pb + 2)) for (int rep = 0; rep < REP_P3; ++rep) {
            const bool lastl = (l == DEPTH - 1);
            sample_outproj_slice(lds, MIX, (const bf16_t*)(ws + WS_WOUT) + (size_t)l * DM * DM, l == 0 ? a.in[1] : nullptr, XB, XBn, lastl ? out : nullptr,
                                 lastl ? nullptr : (rep == 0 ? rowss + (l + 1) * MT : (float*)(ws + WS_DUMMY)), (int)blockIdx.x, LT());
            scan_phase(UT, SPT, out + O_SP + (size_t)l * 131072, LT(), G);
        }
#endif
        SEAM(pb + 2);
#ifndef SKIP_RET
        if (IN(pb + 3)) for (int rep = 0; rep < REP_P4; ++rep) { for (int u = blockIdx.x; u < 512; u += G) ret_unit(lds, P, SPT, MIX, u, LT()); }
#endif
        SEAM(pb + 3);
#ifndef SKIP_P5
        if (IN(pb + 4)) for (int rep = 0; rep < REP_P5; ++rep) {
            pg8::Gemm g{MIX, (const bf16_t*)(ws + WS_WOUT) + (size_t)l * DM * DM, MP, DM, DM};
            pg8::StaticOrder S; S.init(MP, DM, G, (int)blockIdx.x);
            const bool lastl = (l == DEPTH - 1);
            EpiOut E{l == 0 ? a.in[0] : nullptr, l == 0 ? a.in[1] : nullptr, lastl ? out : nullptr, XB, XBn, lastl ? nullptr : (rep == 0 ? rowss + (l + 1) * MT : (float*)(ws + WS_DUMMY))};
            pg8::gemm_phase<EpiOut, pg8::StaticOrder, true, true>(lds, g, S, E, LT());
        }
#endif
        SEAM(pb + 4);
    }
#undef IN
#undef SEAM
}

extern "C" void kernel_launch(void* const* d_in, const int* in_sizes, int n_in, void* d_out, int out_size, void* d_ws, size_t ws_size, hipStream_t stream) {
    static int grid = 0;
    if (grid == 0) {
        int dev = 0, cus = 0, per_cu = 0;
        if (n_in != 11 || ws_size < WS_END) { fprintf(stderr, "kernel_launch: unexpected n_in %d / ws %zu\n", n_in, ws_size); grid = -1; return; }
        if (hipGetDevice(&dev) != hipSuccess || hipDeviceGetAttribute(&cus, hipDeviceAttributeMultiprocessorCount, dev) != hipSuccess) { grid = -1; return; }
        if (hipFuncSetAttribute((const void*)hymba_fwd, hipFuncAttributeMaxDynamicSharedMemorySize, LDS_BYTES) != hipSuccess) { fprintf(stderr, "kernel_launch: hipFuncSetAttribute failed\n"); grid = -1; return; }
        if (hipOccupancyMaxActiveBlocksPerMultiprocessor(&per_cu, (const void*)hymba_fwd, 512, LDS_BYTES) != hipSuccess || per_cu < 1) { fprintf(stderr, "kernel_launch: occupancy query says %d\n", per_cu); per_cu = 1; }
        (void)hipGetLastError();
        if (cus < 256) { fprintf(stderr, "kernel_launch: needs 256 CUs, got %d\n", cus); grid = -1; return; }
        grid = 256;
    }
    if (grid < 0) return;
    if (hipMemsetAsync(d_ws, 0, 16384, stream) != hipSuccess) { fprintf(stderr, "kernel_launch: memset failed\n"); return; }
    Args a{};
    for (int i = 0; i < 11; ++i) a.in[i] = (const float*)d_in[i];
    a.out = (float*)d_out; a.ws = (unsigned char*)d_ws;
    a.baseA = std::pow(500000.0, -1.0 / 8.0); a.baseB = std::pow(10000.0, -1.0 / 64.0);
    constexpr int NPH = 1 + 5 * DEPTH;
#if MK_MULTI
    for (int p = 0; p < NPH; ++p) { a.ph_lo = p; a.ph_hi = p + 1; hipLaunchKernelGGL(hymba_fwd, dim3(grid), dim3(512), LDS_BYTES, stream, a); }
#else
    a.ph_lo = 0; a.ph_hi = NPH;
    void* args[] = {&a};
    hipError_t e = hipLaunchCooperativeKernel((const void*)hymba_fwd, dim3(grid), dim3(512), args, LDS_BYTES, stream);
    if (e != hipSuccess) fprintf(stderr, "cooperative launch failed: %s (grid %d)\n", hipGetErrorString(e), grid);
#endif
}
```

```cpp
#include <hip/hip_runtime.h>
#include <hip/hip_cooperative_groups.h>
#include <cstdio>
#include <cstdint>
#include <cmath>
namespace cg = cooperative_groups;

#ifndef MK_MULTI
#define MK_MULTI 0
#endif

#ifndef REP_P0
#define REP_P0 1
#endif
#ifndef REP_P1
#define REP_P1 1
#endif
#ifndef REP_P2
#define REP_P2 1
#endif
#ifndef REP_P3
#define REP_P3 1
#endif
#ifndef REP_P4
#define REP_P4 1
#endif
#ifndef REP_P5
#define REP_P5 1
#endif
#define LAS __attribute__((address_space(3)))
typedef unsigned short bf16_t;
typedef short bf16x8 __attribute__((ext_vector_type(8)));
typedef float f32x4 __attribute__((ext_vector_type(4)));
typedef float f32x2 __attribute__((ext_vector_type(2)));
typedef unsigned u32x4 __attribute__((ext_vector_type(4)));
typedef unsigned u32x2 __attribute__((ext_vector_type(2)));

constexpr int DM = 1024, SEQ = 8192, NBATCH = 2, MP = NBATCH * SEQ, MS = 512, MT = MP + MS, NIN = 3328, DEPTH = 4;
constexpr int NPOS = 8196;
constexpr float LOG2E = 1.4426950408889634f;
constexpr size_t O_Y = 0, O_KP = 17301504, O_VP = 17432576, O_SP = 17563648, O_KS = 18087936, O_VS = 26476544, O_SS = 34865152;
constexpr size_t MiB = 1u << 20;
constexpr size_t WS_ROWSS = 1 * MiB, WS_TABB = 2 * MiB, WS_TABA = 7 * MiB, WS_WIN = 8 * MiB, WS_WOUT = 36 * MiB, WS_XB = 44 * MiB, WS_MIX = 80 * MiB,
                 WS_P = 116 * MiB, WS_UT = 224 * MiB, WS_SPT = 256 * MiB, WS_XB2 = 272 * MiB, WS_DUMMY = 308 * MiB, WS_END = 312 * MiB;
constexpr int LDS_BYTES = 147456;

__device__ __forceinline__ unsigned pk(float lo, float hi) { unsigned r; asm("v_cvt_pk_bf16_f32 %0, %1, %2" : "=v"(r) : "v"(lo), "v"(hi)); return r; }
__device__ __forceinline__ float bflo(unsigned u) { return __uint_as_float(u << 16); }
__device__ __forceinline__ float bfhi(unsigned u) { return __uint_as_float(u & 0xffff0000u); }
__device__ __forceinline__ float bf2f(bf16_t h) { return __uint_as_float((unsigned)h << 16); }
__device__ __forceinline__ float ex2(float x) { return __builtin_amdgcn_exp2f(x); }
__device__ __forceinline__ float shx(float v, int m, int lane) { return __builtin_bit_cast(float, __builtin_amdgcn_ds_bpermute(((lane ^ m) & 63) << 2, __builtin_bit_cast(int, v))); }
__device__ __forceinline__ int shxi(int v, int m, int lane) { return __builtin_amdgcn_ds_bpermute(((lane ^ m) & 63) << 2, v); }
__device__ __forceinline__ float l2gamma(int h) { const int hb = __builtin_amdgcn_readfirstlane(h); const unsigned b = hb == 0 ? 0xbd3b9ca6u : hb == 1 ? 0xbcba1f74u : hb == 2 ? 0xbc3963ddu : 0xbbb906ceu; return __builtin_bit_cast(float, b); }

namespace pg8 {
constexpr int BM = 256, BK = 64, HALF = 128, HTB = HALF * BK * 2, STAGE_BYTES = 8 * HTB, NXCD = 8, WGM = 8;
__host__ __device__ __forceinline__ int lds_byte(int r, int c) { const int st = (r >> 4) * 2 + (c >> 5), rr = r & 15, cc = c & 31, ob = rr * 64 + cc * 2; return st * 1024 + (ob ^ (((ob >> 9) & 1) << 5)); }
__host__ __device__ __forceinline__ void stage_rc(int b, int& R, int& C) { const int st = b / 1024, sb = b % 1024, swz = sb ^ (((sb >> 9) & 1) << 5); R = (st >> 1) * 16 + swz / 64; C = (st & 1) * 32 + (swz % 64) / 2; }
struct Unit { int pm, pn; };
struct Gemm { const bf16_t* A; const bf16_t* Bt; int M, N, K; };
struct StaticOrder {
    int nM, nN, nwg, G, c;
    __host__ __device__ void init(int M, int N, int G_, int c_) { nM = M / BM; nN = N / BM; nwg = nM * nN; G = G_; c = c_; }
    __host__ __device__ bool next(int i, Unit& u) const {
        const long L = (long)i * G + c; if (L >= nwg) return false;
        int wgid = (int)L; { const int q = nwg / NXCD, r = nwg % NXCD, xcd = wgid % NXCD, off = wgid / NXCD; wgid = (xcd < r ? xcd * (q + 1) : r * (q + 1) + (xcd - r) * q) + off; }
        const int nig = WGM * nN, gid = wgid / nig, fm = gid * WGM, gsz = (nM - fm) < WGM ? (nM - fm) : WGM;
        u.pm = fm + ((wgid % nig) % gsz); u.pn = (wgid % nig) / gsz; return true;
    }
    __device__ __forceinline__ void a_ready(const Unit&) const {}
    __device__ __forceinline__ void done(const Unit&) const {}
};

template <class Epi, class Sched, bool ALIGN_EPI = false, bool SP2 = false>
__device__ __forceinline__ void gemm_phase(LAS unsigned char* lds, const Gemm g, const Sched& S, const Epi& E, const int tid) {
    const int wid = __builtin_amdgcn_readfirstlane(tid >> 6), lane = tid & 63, wr = wid >> 2, wc = wid & 3, fr = lane & 15, fq = lane >> 4;
    const int K = g.K, nt = K / BK;
    unsigned voffA[2], voffB[2];
#pragma unroll
    for (int i = 0; i < 2; ++i) { int R, C; stage_rc(tid * 16 + i * 8192, R, C); voffA[i] = (unsigned)(R * K + C) * 2u; voffB[i] = voffA[i]; }
    const size_t kstep = (size_t)(BK * 2);
    const size_t hstep = (size_t)HALF * K * 2;
    const size_t tstep = 2 * hstep;
    const unsigned ldsw = (unsigned)wid * 1024u;
    const int aoff = lds_byte(wr * 64 + fr, fq * 8), boff = lds_byte(wc * 32 + fr, fq * 8);
#define PG8_SA(b, h) (((b) * 2 + (h)) * HTB)
#define PG8_SB(b, h) ((4 + (b) * 2 + (h)) * HTB)
#define PG8_STAGE(bufoff, gbase, voff) do { _Pragma("unroll") for (int _i = 0; _i < 2; ++_i) \
        __builtin_amdgcn_global_load_lds((const unsigned*)((const char*)(gbase) + (voff)[_i]), (LAS unsigned*)(lds + (bufoff) + ldsw + _i * 8192), 16, 0, 0); } while (0)
#define PG8_LDA(dst, b, h) do { _Pragma("unroll") for (int m = 0; m < 4; ++m) _Pragma("unroll") for (int k = 0; k < 2; ++k) dst[m][k] = *(const LAS bf16x8*)(lds + PG8_SA(b, h) + aoff + m * 2048 + k * 1024); } while (0)
#define PG8_LDB(dst, b, h) do { _Pragma("unroll") for (int n = 0; n < 2; ++n) _Pragma("unroll") for (int k = 0; k < 2; ++k) dst[n][k] = *(const LAS bf16x8*)(lds + PG8_SB(b, h) + boff + n * 2048 + k * 1024); } while (0)
#define PG8_MMA(ai, bj, At, Bt) do { __builtin_amdgcn_s_setprio(1); _Pragma("unroll") for (int m = 0; m < 4; ++m) _Pragma("unroll") for (int n = 0; n < 2; ++n) _Pragma("unroll") for (int k = 0; k < 2; ++k) \
        acc[ai][bj][m][n] = __builtin_amdgcn_mfma_f32_16x16x32_bf16(Bt[n][k], At[m][k], acc[ai][bj][m][n], 0, 0, 0); __builtin_amdgcn_s_setprio(0); } while (0)
#define PG8_WAIT_V(n) asm volatile("s_waitcnt vmcnt(" #n ")" ::: "memory")
#define PG8_WAIT_L(n) asm volatile("s_waitcnt lgkmcnt(" #n ")" ::: "memory")
#define PG8_BAR __builtin_amdgcn_s_barrier()
#define PG8_SCHED __builtin_amdgcn_sched_barrier(0)
    Unit cur, nxt; int ui = 0;
    if (!S.next(0, cur)) return;
    f32x4 acc[2][2][4][2];
#pragma unroll
    for (int a = 0; a < 2; ++a)
#pragma unroll
        for (int b = 0; b < 2; ++b)
#pragma unroll
            for (int m = 0; m < 4; ++m)
#pragma unroll
                for (int n = 0; n < 2; ++n) acc[a][b][m][n] = (f32x4){0.f, 0.f, 0.f, 0.f};
    bf16x8 At[4][2], B0[2][2], B1[2][2];
    const char* cA = (const char*)g.A + (size_t)cur.pm * tstep; const char* cB = (const char*)g.Bt + (size_t)cur.pn * tstep;
    S.a_ready(cur);
    if constexpr (SP2) {
        PG8_STAGE(PG8_SB(0, 0), cB, voffB); PG8_STAGE(PG8_SB(0, 1), cB + hstep, voffB); PG8_STAGE(PG8_SA(0, 0), cA, voffA); PG8_STAGE(PG8_SA(0, 1), cA + hstep, voffA);
        if (wr == 1) PG8_BAR;
        PG8_WAIT_V(2); PG8_BAR;
        PG8_STAGE(PG8_SB(1, 0), cB + kstep, voffB); PG8_STAGE(PG8_SA(1, 0), cA + kstep, voffA); PG8_STAGE(PG8_SB(1, 1), cB + hstep + kstep, voffB);
        PG8_WAIT_V(6); PG8_BAR;
    } else {
        PG8_STAGE(PG8_SB(0, 0), cB, voffB); PG8_STAGE(PG8_SA(0, 0), cA, voffA); PG8_STAGE(PG8_SB(0, 1), cB + hstep, voffB); PG8_STAGE(PG8_SA(0, 1), cA + hstep, voffA);
        if (wr == 1) PG8_BAR;
        PG8_WAIT_V(4); PG8_BAR;
        PG8_STAGE(PG8_SB(1, 0), cB + kstep, voffB); PG8_STAGE(PG8_SA(1, 0), cA + kstep, voffA); PG8_STAGE(PG8_SB(1, 1), cB + hstep + kstep, voffB);
        PG8_WAIT_V(6); PG8_BAR;
    }
    for (;;) {
        const bool has_next = S.next(ui + 1, nxt);
        const char* nA = has_next ? (const char*)g.A + (size_t)nxt.pm * tstep : cA; const char* nB = has_next ? (const char*)g.Bt + (size_t)nxt.pn * tstep : cB;
        for (int t = 0; t < nt; t += 2) {
            const bool last = (t == nt - 2);
            const char* a1 = cA + (size_t)(t + 1) * kstep;
            const char* a2 = last ? nA : cA + (size_t)(t + 2) * kstep; const char* b2 = last ? nB : cB + (size_t)(t + 2) * kstep;
            const char* a3 = a2 + kstep; const char* b3 = b2 + kstep;
            if (last && has_next) S.a_ready(nxt);
            if constexpr (SP2) {
            PG8_LDB(B0, 0, 0); PG8_LDB(B1, 0, 1); PG8_SCHED; PG8_LDA(At, 0, 0); PG8_STAGE(PG8_SA(1, 1), a1 + hstep, voffA);
            PG8_WAIT_V(8); PG8_WAIT_L(0); PG8_BAR; PG8_MMA(0, 0, At, B0); PG8_MMA(0, 1, At, B1); PG8_BAR; PG8_SCHED;
            PG8_LDA(At, 0, 1); PG8_STAGE(PG8_SB(0, 0), b2, voffB); PG8_STAGE(PG8_SB(0, 1), b2 + hstep, voffB); PG8_STAGE(PG8_SA(0, 0), a2, voffA);
            PG8_WAIT_V(8); PG8_WAIT_L(0); PG8_BAR; PG8_MMA(1, 0, At, B0); PG8_MMA(1, 1, At, B1); PG8_BAR; PG8_SCHED;
            PG8_LDB(B0, 1, 0); PG8_LDB(B1, 1, 1); PG8_SCHED; PG8_LDA(At, 1, 0); PG8_STAGE(PG8_SA(0, 1), a2 + hstep, voffA);
            PG8_WAIT_V(8); PG8_WAIT_L(0); PG8_BAR; PG8_MMA(0, 0, At, B0); PG8_MMA(0, 1, At, B1); PG8_BAR; PG8_SCHED;
            PG8_LDA(At, 1, 1); PG8_STAGE(PG8_SB(1, 0), b3, voffB); PG8_STAGE(PG8_SB(1, 1), b3 + hstep, voffB); PG8_STAGE(PG8_SA(1, 0), a3, voffA);
            PG8_WAIT_V(8); PG8_WAIT_L(0); PG8_BAR; PG8_MMA(1, 0, At, B0); PG8_MMA(1, 1, At, B1); PG8_BAR; PG8_SCHED;
            } else {
            PG8_LDB(B0, 0, 0); PG8_SCHED; PG8_LDA(At, 0, 0); PG8_STAGE(PG8_SA(1, 1), a1 + hstep, voffA);
            PG8_WAIT_L(8); PG8_BAR; PG8_WAIT_L(0); PG8_MMA(0, 0, At, B0); PG8_BAR; PG8_SCHED;
            PG8_LDB(B1, 0, 1); PG8_STAGE(PG8_SB(0, 0), b2, voffB);
            PG8_BAR; PG8_WAIT_L(0); PG8_MMA(0, 1, At, B1); PG8_BAR;
            PG8_LDA(At, 0, 1); PG8_STAGE(PG8_SA(0, 0), a2, voffA);
            PG8_BAR; PG8_WAIT_L(0); PG8_MMA(1, 0, At, B0); PG8_BAR; PG8_SCHED;
            PG8_STAGE(PG8_SB(0, 1), b2 + hstep, voffB);
            PG8_WAIT_V(6); PG8_BAR; PG8_MMA(1, 1, At, B1); PG8_BAR;
            PG8_LDB(B0, 1, 0); PG8_SCHED; PG8_LDA(At, 1, 0); PG8_STAGE(PG8_SA(0, 1), a2 + hstep, voffA);
            PG8_WAIT_L(8); PG8_BAR; PG8_WAIT_L(0); PG8_MMA(0, 0, At, B0); PG8_BAR; PG8_SCHED;
            PG8_LDB(B1, 1, 1); PG8_STAGE(PG8_SB(1, 0), b3, voffB);
            PG8_BAR; PG8_WAIT_L(0); PG8_MMA(0, 1, At, B1); PG8_BAR;
            PG8_LDA(At, 1, 1); PG8_STAGE(PG8_SA(1, 0), a3, voffA);
            PG8_BAR; PG8_WAIT_L(0); PG8_MMA(1, 0, At, B0); PG8_BAR; PG8_SCHED;
            PG8_STAGE(PG8_SB(1, 1), b3 + hstep, voffB);
            PG8_WAIT_V(6); PG8_BAR; PG8_MMA(1, 1, At, B1); PG8_BAR;
            }
        }
        if constexpr (ALIGN_EPI) { if (wr == 0) PG8_BAR; }
        E(acc, cur, wr, wc, fr, fq); S.done(cur);
        if (!has_next) break;
#pragma unroll
        for (int a = 0; a < 2; ++a)
#pragma unroll
            for (int b = 0; b < 2; ++b)
#pragma unroll
                for (int m = 0; m < 4; ++m)
#pragma unroll
                    for (int n = 0; n < 2; ++n) acc[a][b][m][n] = (f32x4){0.f, 0.f, 0.f, 0.f};
        cur = nxt; cA = nA; cB = nB; ++ui;
        if constexpr (ALIGN_EPI) { if (wr == 1) PG8_BAR; }
    }
    PG8_WAIT_V(0);
    if constexpr (!ALIGN_EPI) { if (wr == 0) PG8_BAR; }
    PG8_BAR;
#undef PG8_SA
#undef PG8_SB
#undef PG8_STAGE
#undef PG8_LDA
#undef PG8_LDB
#undef PG8_MMA
#undef PG8_WAIT_V
#undef PG8_WAIT_L
#undef PG8_BAR
#undef PG8_SCHED
}
}

__device__ __forceinline__ int colmap_in(int np) {
    const int pn = np >> 8, c = np & 255;
    const int bj = c >> 7, wc = (c >> 5) & 3, n = (c >> 4) & 1, fq = (c >> 2) & 3, j = c & 3;
    const int cnat = 128 * bj + 32 * wc + 8 * fq + 4 * n + j;
    const int d64 = 16 * fq + 8 * bj + 4 * n + j;
    const int d128 = 64 * bj + 32 * (wc & 1) + 8 * fq + 4 * n + j;
    if (pn <= 1) return 64 * (4 * pn + wc) + d64;
    if (pn == 2) return (wc < 2 ? 512 + 64 * wc : 640 + 64 * (wc - 2)) + d64;
    if (pn <= 4) return 768 + 256 * (pn - 3) + cnat;
    if (pn <= 6) return 1280 + 128 * (2 * (pn - 5) + (wc >> 1)) + d128;
    if (pn <= 8) return 1792 + 128 * (2 * (pn - 7) + (wc >> 1)) + d128;
    if (pn <= 10) return 2304 + 256 * (pn - 9) + cnat;
    return 2816 + 256 * (pn - 11) + cnat;
}
__device__ __forceinline__ int colmap_out(int np) {
    const int pn = np >> 8, c = np & 255;
    const int bj = c >> 7, wc = (c >> 5) & 3, n = (c >> 4) & 1, fq = (c >> 2) & 3, j = c & 3;
    return 256 * pn + 128 * bj + 32 * wc + 8 * fq + 4 * n + j;
}

__device__ __forceinline__ int cm_c64(int d, int wc) { return 128 * ((d >> 3) & 1) + 32 * wc + 16 * ((d >> 2) & 1) + 4 * (d >> 4) + (d & 3); }
__device__ __forceinline__ int cm_nat(int x) { return 128 * (x >> 7) + 32 * ((x >> 5) & 3) + 16 * ((x >> 2) & 1) + 4 * ((x >> 3) & 3) + (x & 3); }
__device__ __forceinline__ int cm_c128(int d, int hsel) { return 128 * (d >> 6) + 32 * (2 * hsel + ((d >> 5) & 1)) + 16 * ((d >> 2) & 1) + 4 * ((d >> 3) & 3) + (d & 3); }
__device__ __forceinline__ int colinv_in(int col) {
    if (col < 512) { const int head = col >> 6; return 256 * (head >> 2) + cm_c64(col & 63, head & 3); }
    if (col < 640) { const int o = col - 512; return 512 + cm_c64(o & 63, o >> 6); }
    if (col < 768) { const int o = col - 640; return 512 + cm_c64(o & 63, 2 + (o >> 6)); }
    if (col < 1280) { const int o = col - 768; return 256 * (3 + (o >> 8)) + cm_nat(o & 255); }
    if (col < 1792) { const int o = col - 1280, head = o >> 7; return 256 * (5 + (head >> 1)) + cm_c128(o & 127, head & 1); }
    if (col < 2304) { const int o = col - 1792, head = o >> 7; return 256 * (7 + (head >> 1)) + cm_c128(o & 127, head & 1); }
    if (col < 2816) { const int o = col - 2304; return 256 * (9 + (o >> 8)) + cm_nat(o & 255); }
    const int o = col - 2816; return 256 * (11 + (o >> 8)) + cm_nat(o & 255);
}
__device__ __forceinline__ int colinv_out(int col) { return 256 * (col >> 8) + cm_nat(col & 255); }
struct EpiIn {
    bf16_t* P; const float* rowss; const float* qg; const float* kg; const float* tabA; const float* tabB;
    float* kp; float* vp; float* ks; float* vs;
    __device__ __forceinline__ void operator()(const f32x4 (&acc)[2][2][4][2], const pg8::Unit& u, int wr, int wc, int fr, int fq) const {
        const int pn = u.pn;
        const int rowb = u.pm * 256 + wr * 64 + fr;
        float rr[2][4];
#pragma unroll
        for (int ai = 0; ai < 2; ++ai)
#pragma unroll
            for (int m = 0; m < 4; ++m) rr[ai][m] = rowss[rowb + ai * 128 + m * 16];
        if (pn <= 2) {
            const bool isv = (pn == 2 && wc >= 2), isk = (pn == 2 && wc < 2);
            const int head = (pn == 2) ? (wc & 1) : 4 * pn + wc;
            const int colbase = ((pn == 2) ? (isv ? 640 : 512) : 0) + 64 * head + 16 * fq;
            const float* gp = isk ? kg : qg;
#pragma unroll
            for (int am = 0; am < 4; ++am) {
                const int ai = am >> 1;
                f32x4 ca[4][2], sa[4][2];
                if (!isv) {
#pragma unroll
                    for (int m = 2 * (am & 1); m < 2 * (am & 1) + 2; ++m) {
                        const int row = rowb + ai * 128 + m * 16;
                        const int pos = (row < MP) ? (row & 8191) : (8192 + ((row - MP) & 3));
#pragma unroll
                        for (int n = 0; n < 2; ++n) { ca[m][n] = *(const f32x4*)(tabA + pos * 16 + 4 * n); sa[m][n] = *(const f32x4*)(tabA + pos * 16 + 8 + 4 * n); }
                    }
                }
#pragma unroll
                for (int m = 2 * (am & 1); m < 2 * (am & 1) + 2; ++m) {
                    const int row = rowb + ai * 128 + m * 16;
                    const float r = rsqrtf(rr[ai][m] * (1.0f / 1024.0f) + 1e-6f);
                    const int pos = (row < MP) ? (row & 8191) : (8192 + ((row - MP) & 3));
                    f32x4 v[2][2];
#pragma unroll
                    for (int bj = 0; bj < 2; ++bj)
#pragma unroll
                        for (int n = 0; n < 2; ++n) v[bj][n] = acc[ai][bj][m][n] * r;
                    if (!isv) {
                        float ss = 0.f;
#pragma unroll
                        for (int bj = 0; bj < 2; ++bj)
#pragma unroll
                            for (int n = 0; n < 2; ++n) { const f32x4 x = v[bj][n]; ss += (x[0] * x[0] + x[1] * x[1]) + (x[2] * x[2] + x[3] * x[3]); }
                        ss += shx(ss, 16, (fq * 16 + fr)); ss += shx(ss, 32, (fq * 16 + fr));
                        const float rn = rsqrtf(ss * (1.0f / 64.0f) + 1e-6f);
#pragma unroll
                        for (int bj = 0; bj < 2; ++bj)
#pragma unroll
                            for (int n = 0; n < 2; ++n) v[bj][n] = v[bj][n] * rn * *(const f32x4*)(gp + 16 * fq + 8 * bj + 4 * n);
                        if (fq == 0) {
#pragma unroll
                            for (int n = 0; n < 2; ++n) {
                                const f32x4 c = ca[m][n], s = sa[m][n];
                                const f32x4 x1 = v[0][n], x2 = v[1][n];
                                v[0][n] = x1 * c - x2 * s; v[1][n] = x2 * c + x1 * s;
                            }
                        }
                    }
                    if (pn == 2) {
                        float* dst = nullptr;
                        if (row < MP) { if (pos >= SEQ - 128) dst = (isv ? vp : kp) + ((((row >> 13) * 128 + (pos - (SEQ - 128))) * 2 + head) * 64 + 16 * fq); }
                        else { const int sr = row - MP; dst = (isv ? vs : ks) + ((((sr >> 2) * 128 + 124 + (sr & 3)) * 2 + head) * 64 + 16 * fq); }
                        if (dst) {
#pragma unroll
                            for (int bj = 0; bj < 2; ++bj)
#pragma unroll
                                for (int n = 0; n < 2; ++n) *(f32x4*)(dst + 8 * bj + 4 * n) = v[bj][n];
                        }
                    }
                    bf16_t* pp = P + (size_t)row * NIN + colbase;
                    if (pn < 2) {
#pragma unroll
                        for (int bj = 0; bj < 2; ++bj)
#pragma unroll
                            for (int n = 0; n < 2; ++n) v[bj][n] = v[bj][n] * (0.125f * LOG2E);
                    }
#pragma unroll
                    for (int bj = 0; bj < 2; ++bj) {
                        u32x4 w; w.x = pk(v[bj][0][0], v[bj][0][1]); w.y = pk(v[bj][0][2], v[bj][0][3]);
                        w.z = pk(v[bj][1][0], v[bj][1][1]); w.w = pk(v[bj][1][2], v[bj][1][3]);
                        *(u32x4*)(pp + 8 * bj) = w;
                    }
                }
            }
        } else if (pn <= 4 || pn >= 9) {
            const bool silu = (pn <= 4 || pn >= 11);
            const int colbase = (pn <= 4 ? 768 + 256 * (pn - 3) : (pn <= 10 ? 2304 + 256 * (pn - 9) : 2816 + 256 * (pn - 11))) + 32 * wc + 8 * fq;
#pragma unroll
            for (int ai = 0; ai < 2; ++ai)
#pragma unroll
                for (int m = 0; m < 4; ++m) {
                    const int row = rowb + ai * 128 + m * 16;
                    const float r = rsqrtf(rr[ai][m] * (1.0f / 1024.0f) + 1e-6f);
                    bf16_t* pp = P + (size_t)row * NIN + colbase;
#pragma unroll
                    for (int bj = 0; bj < 2; ++bj) {
                        f32x4 v0 = acc[ai][bj][m][0] * r, v1 = acc[ai][bj][m][1] * r;
                        if (silu) {
#pragma unroll
                            for (int e = 0; e < 4; ++e) { v0[e] = v0[e] * __builtin_amdgcn_rcpf(1.0f + ex2(-v0[e] * LOG2E)); v1[e] = v1[e] * __builtin_amdgcn_rcpf(1.0f + ex2(-v1[e] * LOG2E)); }
                        }
                        u32x4 w; w.x = pk(v0[0], v0[1]); w.y = pk(v0[2], v0[3]); w.z = pk(v1[0], v1[1]); w.w = pk(v1[2], v1[3]);
                        *(u32x4*)(pp + 128 * bj) = w;
                    }
                }
        } else {
            const bool isk = pn >= 7;
            const int head = 2 * ((pn - 5) & 1) + (wc >> 1), hh = wc & 1;
            const int colbase = (isk ? 1792 : 1280) + 128 * head + 32 * hh + 8 * fq;
            const float post = __builtin_bit_cast(float, __builtin_amdgcn_readfirstlane(isk ? 0x3db504f3 : 0x3f800000));
#pragma unroll
            for (int am = 0; am < 4; ++am) {
                const int ai = am >> 1;
                f32x4 cc[4][2], sn[4][2];
#pragma unroll
                for (int m = 2 * (am & 1); m < 2 * (am & 1) + 2; ++m) {
                    const int row = rowb + ai * 128 + m * 16;
                    const int pos = (row < MP) ? (row & 8191) : (8192 + ((row - MP) & 3));
                    const float* tb = tabB + pos * 128 + 32 * hh + 8 * fq;
#pragma unroll
                    for (int n = 0; n < 2; ++n) { cc[m][n] = *(const f32x4*)(tb + 4 * n); sn[m][n] = *(const f32x4*)(tb + 64 + 4 * n); }
                }
#pragma unroll
                for (int m = 2 * (am & 1); m < 2 * (am & 1) + 2; ++m) {
                    const int row = rowb + ai * 128 + m * 16;
                    const float r = rsqrtf(rr[ai][m] * (1.0f / 1024.0f) + 1e-6f) * post;
                    f32x4 y1[2], y2[2];
#pragma unroll
                    for (int n = 0; n < 2; ++n) {
                        const f32x4 c = cc[m][n], s = sn[m][n];
                        const f32x4 x1 = acc[ai][0][m][n] * r, x2 = acc[ai][1][m][n] * r;
                        y1[n] = x1 * c - x2 * s; y2[n] = x2 * c + x1 * s;
                    }
                    bf16_t* pp = P + (size_t)row * NIN + colbase;
                    u32x4 w; w.x = pk(y1[0][0], y1[0][1]); w.y = pk(y1[0][2], y1[0][3]); w.z = pk(y1[1][0], y1[1][1]); w.w = pk(y1[1][2], y1[1][3]);
                    *(u32x4*)pp = w;
                    w.x = pk(y2[0][0], y2[0][1]); w.y = pk(y2[0][2], y2[0][3]); w.z = pk(y2[1][0], y2[1][1]); w.w = pk(y2[1][2], y2[1][3]);
                    *(u32x4*)(pp + 64) = w;
                }
            }
        }
    }
};

struct EpiOut {
    const float* xin_p; const float* xin_s;
    float* xout;
    const bf16_t* XBi; bf16_t* XB; float* rowss_next;
    __device__ __forceinline__ void operator()(const f32x4 (&acc)[2][2][4][2], const pg8::Unit& u, int wr, int wc, int fr, int fq) const {
        const int rowb = u.pm * 256 + wr * 64 + fr;
        const int colb = u.pn * 256 + 32 * wc + 8 * fq;
        const bool f32in = (xin_p != nullptr), last = (xout != nullptr);
#pragma unroll
        for (int ai = 0; ai < 2; ++ai) {
            f32x4 pre[4][2][2];
            if (f32in) {
#pragma unroll
                for (int m = 0; m < 4; ++m) { const int row = rowb + ai * 128 + m * 16;
                    const float* xr = (row < MP) ? xin_p + (size_t)row * DM : xin_s + (size_t)(row - MP) * DM;
#pragma unroll
                    for (int bj = 0; bj < 2; ++bj) { pre[m][bj][0] = *(const f32x4*)(xr + colb + 128 * bj); pre[m][bj][1] = *(const f32x4*)(xr + colb + 128 * bj + 4); } }
            } else {
                u32x4 pb[4][2];
#pragma unroll
                for (int m = 0; m < 4; ++m) { const int row = rowb + ai * 128 + m * 16;
#pragma unroll
                    for (int bj = 0; bj < 2; ++bj) pb[m][bj] = __builtin_nontemporal_load((const u32x4*)(XBi + (size_t)row * DM + colb + 128 * bj)); }
#pragma unroll
                for (int m = 0; m < 4; ++m)
#pragma unroll
                    for (int bj = 0; bj < 2; ++bj) { const u32x4 w = pb[m][bj];
                        pre[m][bj][0] = (f32x4){bflo(w.x), bfhi(w.x), bflo(w.y), bfhi(w.y)}; pre[m][bj][1] = (f32x4){bflo(w.z), bfhi(w.z), bflo(w.w), bfhi(w.w)}; }
            }
#pragma unroll
            for (int m = 0; m < 4; ++m) {
                const int row = rowb + ai * 128 + m * 16;
                float ss = 0.f;
#pragma unroll
                for (int bj = 0; bj < 2; ++bj) {
                    const int col = colb + 128 * bj;
                    const f32x4 v0 = pre[m][bj][0] + acc[ai][bj][m][0], v1 = pre[m][bj][1] + acc[ai][bj][m][1];
                    if (last) { __builtin_nontemporal_store(v0, (f32x4*)(xout + (size_t)row * DM + col)); __builtin_nontemporal_store(v1, (f32x4*)(xout + (size_t)row * DM + col + 4)); }
                    else {
                        u32x4 w; w.x = pk(v0[0], v0[1]); w.y = pk(v0[2], v0[3]); w.z = pk(v1[0], v1[1]); w.w = pk(v1[2], v1[3]);
                        *(u32x4*)(XB + (size_t)row * DM + col) = w;
                        ss += (v0[0] * v0[0] + v0[1] * v0[1]) + (v0[2] * v0[2] + v0[3] * v0[3]) + (v1[0] * v1[0] + v1[1] * v1[1]) + (v1[2] * v1[2] + v1[3] * v1[3]);
                    }
                }
                if (!last) { ss += shx(ss, 16, (fq * 16 + fr)); ss += shx(ss, 32, (fq * 16 + fr)); if (fq == 0) atomicAdd(rowss_next + row, ss); }
            }
        }
    }
};
struct OneUnit {
    int pm, pn;
    __device__ __forceinline__ bool next(int i, pg8::Unit& u) const { if (i > 0) return false; u.pm = pm; u.pn = pn; return true; }
    __device__ __forceinline__ void a_ready(const pg8::Unit&) const {}
    __device__ __forceinline__ void done(const pg8::Unit&) const {}
};

struct SampleFirstOrder {
    pg8::StaticOrder S; int spm, spn; unsigned* cnt;
    __device__ __forceinline__ bool next(int i, pg8::Unit& u) const {
        if (spm >= 0) { if (i == 0) { u.pm = spm; u.pn = spn; return true; } return S.next(i - 1, u); }
        return S.next(i, u);
    }
    __device__ __forceinline__ void a_ready(const pg8::Unit&) const {}
    __device__ __forceinline__ void done(const pg8::Unit& u) const {
        if (u.pm >= 64) {
            asm volatile("s_waitcnt vmcnt(0)" ::: "memory");
            __builtin_amdgcn_s_barrier();
            if (threadIdx.x == 0) { __builtin_amdgcn_fence(__ATOMIC_RELEASE, "agent"); asm volatile("s_waitcnt vmcnt(0)" ::: "memory"); __hip_atomic_fetch_add(cnt, 1u, __ATOMIC_RELAXED, __HIP_MEMORY_SCOPE_AGENT); }
        }
    }
};
__device__ __forceinline__ void p0_transpose_item(const float* W, int K, int N, const float* g, bf16_t* WT, bool is_in, LAS float* scr, int item, int lane) {
    const int nblk = N / 32, kb = item / nblk, nb = item % nblk, k0 = 64 * kb, s0 = 32 * nb;
    float tw[32];
#pragma unroll
    for (int i = 0; i < 32; ++i) tw[i] = __builtin_nontemporal_load(W + (size_t)(k0 + 2 * i + (lane >> 5)) * N + s0 + (lane & 31));
#pragma unroll
    for (int i = 0; i < 32; ++i) { const int kk = 2 * i + (lane >> 5); const float gvv = g ? g[k0 + kk] : 1.0f; scr[kk * 33 + (lane & 31)] = tw[i] * gvv; }
    asm volatile("s_waitcnt lgkmcnt(0)" ::: "memory");
    const int c = lane & 7;
#pragma unroll
    for (int j = 0; j < 4; ++j) { const int n = (lane >> 3) + 8 * j; const LAS float* s = scr + (8 * c) * 33 + n;
        const int drow = is_in ? colinv_in(s0 + n) : colinv_out(s0 + n);
        u32x4 o; o.x = pk(s[0 * 33], s[1 * 33]); o.y = pk(s[2 * 33], s[3 * 33]); o.z = pk(s[4 * 33], s[5 * 33]); o.w = pk(s[6 * 33], s[7 * 33]);
        *(u32x4*)(WT + (size_t)drow * K + k0 + 8 * c) = o; }
    asm volatile("s_waitcnt lgkmcnt(0)" ::: "memory");
}
__device__ __forceinline__ void sincos_d(double x, double& s, double& c) {
    const double kd = __builtin_rint(x * 0.63661977236758134308);
    const double r = (x - kd * 1.57079632673412561417e+00) - kd * 6.07710050650619224932e-11;
    const int k = ((int)kd) & 3;
    const double r2 = r * r;
    const double sp = r * (1.0 + r2 * (-1.0 / 6.0 + r2 * (1.0 / 120.0 + r2 * (-1.0 / 5040.0 + r2 * (1.0 / 362880.0 + r2 * (-1.0 / 39916800.0 + r2 * (1.0 / 6227020800.0)))))));
    const double cp = 1.0 + r2 * (-0.5 + r2 * (1.0 / 24.0 + r2 * (-1.0 / 720.0 + r2 * (1.0 / 40320.0 + r2 * (-1.0 / 3628800.0 + r2 * (1.0 / 479001600.0 + r2 * (-1.0 / 87178291200.0)))))));
    s = (k == 0) ? sp : (k == 1) ? cp : (k == 2) ? -sp : -cp;
    c = (k == 0) ? cp : (k == 1) ? -sp : (k == 2) ? -cp : sp;
}

struct Args { const float* in[11]; float* out; unsigned char* ws; double baseA, baseB; int ph_lo, ph_hi; };

__device__ __forceinline__ void p0_prologue(const Args& a, LAS unsigned char* lds, int tid, int G) {
    const int lane = tid & 63, wave = tid >> 6;
    LAS float* scr = (LAS float*)(lds + wave * 16384);
    const int gw = blockIdx.x * 8 + wave, NGW = G * 8;
    unsigned char* ws = a.ws;
    constexpr int I_IN = (DM / 64) * (NIN / 32), I_OUT = (DM / 64) * (DM / 32);
    for (int it = gw; it < DEPTH * (I_IN + I_OUT); it += NGW) {
        const int l = it / (I_IN + I_OUT); int r = it - l * (I_IN + I_OUT);
        if (r < I_IN) p0_transpose_item(a.in[5] + (size_t)l * DM * NIN, DM, NIN, a.in[7] + l * DM, (bf16_t*)(ws + WS_WIN) + (size_t)l * NIN * DM, true, scr, r, lane);
        else p0_transpose_item(a.in[6] + (size_t)l * DM * DM, DM, DM, nullptr, (bf16_t*)(ws + WS_WOUT) + (size_t)l * DM * DM, false, scr, r - I_IN, lane);
    }
    float* rowss = (float*)(ws + WS_ROWSS);
    bf16_t* XB = (bf16_t*)(ws + WS_XB);
    for (int m0 = gw; m0 < MT; m0 += 4 * NGW) {
        f32x4 v[4][4];
#pragma unroll
        for (int q = 0; q < 4; ++q) { const int m = m0 + q * NGW; if (m < MT) { const float* xr = (m < MP) ? a.in[0] + (size_t)m * DM : a.in[1] + (size_t)(m - MP) * DM;
#pragma unroll
            for (int j = 0; j < 4; ++j) v[q][j] = *(const f32x4*)(xr + 4 * lane + 256 * j); } }
#pragma unroll
        for (int q = 0; q < 4; ++q) { const int m = m0 + q * NGW; if (m < MT) {
            float s = 0.f;
#pragma unroll
            for (int j = 0; j < 4; ++j) { const f32x4 x = v[q][j]; s += (x[0] * x[0] + x[1] * x[1]) + (x[2] * x[2] + x[3] * x[3]);
                u32x2 w; w.x = pk(x[0], x[1]); w.y = pk(x[2], x[3]); *(u32x2*)(XB + (size_t)m * DM + 4 * lane + 256 * j) = w; }
#pragma unroll
            for (int o = 1; o < 64; o <<= 1) s += shx(s, o, lane);
            if (lane == 0) rowss[m] = s; } }
    }
    const int gt = blockIdx.x * 512 + tid, NGT = G * 512;
    for (int i = gt; i < 3 * MT; i += NGT) rowss[MT + i] = 0.f;
    float* tabB = (float*)(ws + WS_TABB); float* tabA = (float*)(ws + WS_TABA);
    for (int idx = gt; idx < NPOS * 72; idx += NGT) {
        const int pos = idx / 72, i = idx - pos * 72;
        const bool isB = i < 64; const int ii = isB ? i : i - 64; const double base = isB ? a.baseB : a.baseA;
        double p = 1.0; for (int k = 0; k < ii; ++k) p *= base;
        const float inv = (float)p; const float ang = (float)pos * inv;
        double s, c; sincos_d((double)ang, s, c);
        if (isB) { tabB[pos * 128 + ii] = (float)c; tabB[pos * 128 + 64 + ii] = (float)s; }
        else { tabA[pos * 16 + ii] = (float)c; tabA[pos * 16 + 8 + ii] = (float)s; }
    }
}


__device__ __forceinline__ void tr_write_sw(LAS bf16_t* img, int RS, int c8, int SM, int tok, u32x4 vv, int XL, int lane) {
    const bool odd = tok & 1;
    const unsigned s0 = odd ? vv.x : vv.z, s1 = odd ? vv.y : vv.w;
    const unsigned r0 = (unsigned)shxi((int)s0, XL, lane), r1 = (unsigned)shxi((int)s1, XL, lane);
    const unsigned a0 = odd ? r0 : vv.x, a1 = odd ? r1 : vv.y, b0 = odd ? vv.z : r0, b1 = odd ? vv.w : r1;
    LAS unsigned* p = (LAS unsigned*)(img + (8 * c8 + (odd ? 4 : 0)) * RS + ((((tok >> 3) ^ (c8 & SM)) << 3) + (tok & 6)));
    const int rs2 = RS >> 1;
    p[0] = (a0 & 0xffffu) | (b0 << 16); p[rs2] = (a0 >> 16) | (b0 & 0xffff0000u);
    p[2 * rs2] = (a1 & 0xffffu) | (b1 << 16); p[3 * rs2] = (a1 >> 16) | (b1 & 0xffff0000u);
}
__device__ __forceinline__ int sw_off(int d, int RS, int SM, int t0) { return d * RS + ((((t0 >> 3) ^ ((d >> 3) & SM)) << 3) + (t0 & 7)); }
struct AttnRegs { u32x4 kv[4], vv[4]; float sink; };
__device__ __forceinline__ void attn_load(AttnRegs& R, const bf16_t* P, int unit, int tid) {
    const int g = unit & 1, qb = (unit >> 1) & 63, n = unit >> 7;
    const int R0 = n * SEQ + qb * 128;
    const int lane = tid & 63, w = tid >> 6, fr = lane & 15, fq = lane >> 4;
#pragma unroll
    for (int i = 0; i < 4; ++i) {
        const int ch = tid + 512 * i, key = ch >> 3, c8 = ch & 7;
        R.kv[i] = (u32x4){0u, 0u, 0u, 0u};
        if (qb > 0 || key >= 128) R.kv[i] = *(const u32x4*)(P + (size_t)(R0 - 128 + key) * NIN + 512 + 64 * g + 8 * c8);
    }
#pragma unroll
    for (int i = 0; i < 4; ++i) { const int key = (tid >> 3) + 64 * i, c8 = tid & 7; R.vv[i] = (u32x4){0u, 0u, 0u, 0u};
        if (qb > 0 || key >= 128) R.vv[i] = *(const u32x4*)(P + (size_t)(R0 - 128 + key) * NIN + 640 + 64 * g + 8 * c8); }
}
__device__ __forceinline__ void attn_compute(LAS unsigned char* lds, const AttnRegs& R, const bf16_t* P, bf16_t* MIX, const float* sinks_l, int unit, int tid) {
    const int g = unit & 1, qb = (unit >> 1) & 63, n = unit >> 7;
    const int R0 = n * SEQ + qb * 128;
    LAS bf16_t* Ks = (LAS bf16_t*)lds;
    LAS bf16_t* Vt = (LAS bf16_t*)(lds + 256 * 144);
    const int lane = tid & 63, w = tid >> 6, fr = lane & 15, fq = lane >> 4;
    const int head = 4 * g + (w >> 1);
#pragma unroll
    for (int i = 0; i < 4; ++i) {
        const int ch = tid + 512 * i, key = ch >> 3, c8 = ch & 7;
        *(LAS u32x4*)(Ks + key * 72 + 8 * c8) = R.kv[i];
    }
#pragma unroll
    for (int i = 0; i < 4; ++i) tr_write_sw(Vt, 264, tid & 7, 7, (tid >> 3) + 64 * i, R.vv[i], 8, tid);
    __syncthreads();
    const float sink2 = sinks_l[head] * LOG2E;
#pragma unroll 1
    for (int qt = 0; qt < 4; ++qt) {
        const int qi = 64 * (w & 1) + 16 * qt + fr;
        const int row = R0 + qi;
        const bf16_t* qp = P + (size_t)row * NIN + 64 * head + 8 * fq;
        const bf16x8 bq0 = *(const bf16x8*)qp, bq1 = *(const bf16x8*)(qp + 32);
        u32x2 gts[4];
#pragma unroll
        for (int dt = 0; dt < 4; ++dt) gts[dt] = *(const u32x2*)(P + (size_t)row * NIN + 768 + 64 * head + 16 * dt + 4 * fq);
        f32x4 s[16];
#pragma unroll
        for (int kt = 0; kt < 16; ++kt) {
            const LAS bf16_t* kr = Ks + (16 * kt + fr) * 72 + 8 * fq;
            const bf16x8 a0 = *(const LAS bf16x8*)kr, a1 = *(const LAS bf16x8*)(kr + 32);
            f32x4 z = (f32x4){0.f, 0.f, 0.f, 0.f};
            z = __builtin_amdgcn_mfma_f32_16x16x32_bf16(a0, bq0, z, 0, 0, 0);
            s[kt] = __builtin_amdgcn_mfma_f32_16x16x32_bf16(a1, bq1, z, 0, 0, 0);
            if ((kt & 3) == 3) __builtin_amdgcn_sched_barrier(0);
        }
        float mx = -INFINITY;
#pragma unroll
        for (int kt = 0; kt < 16; ++kt)
#pragma unroll
            for (int r = 0; r < 4; ++r) {
                const int key = 16 * kt + 4 * fq + r;
                const bool valid = (kt < 8) ? (qb > 0 && key > qi) : (key - 128 <= qi);
                const float x = valid ? s[kt][r] : -INFINITY; s[kt][r] = x; mx = fmaxf(mx, x);
            }
        mx = fmaxf(mx, shx(mx, 16, lane)); mx = fmaxf(mx, shx(mx, 32, lane)); mx = fmaxf(mx, sink2);
        float sum = 0.f;
#pragma unroll
        for (int kt = 0; kt < 16; ++kt)
#pragma unroll
            for (int r = 0; r < 4; ++r) { const float p = ex2(s[kt][r] - mx); s[kt][r] = p; sum += p; }
        sum += shx(sum, 16, lane); sum += shx(sum, 32, lane); sum += ex2(sink2 - mx);
        f32x4 o[4];
#pragma unroll
        for (int dt = 0; dt < 4; ++dt) o[dt] = (f32x4){0.f, 0.f, 0.f, 0.f};
#pragma unroll
        for (int k2 = 0; k2 < 8; ++k2) {
            u32x4 pw; pw.x = pk(s[2 * k2][0], s[2 * k2][1]); pw.y = pk(s[2 * k2][2], s[2 * k2][3]); pw.z = pk(s[2 * k2 + 1][0], s[2 * k2 + 1][1]); pw.w = pk(s[2 * k2 + 1][2], s[2 * k2 + 1][3]);
            const bf16x8 pb = __builtin_bit_cast(bf16x8, pw);
#pragma unroll
            for (int dt = 0; dt < 4; ++dt) {
                const u32x2 lo = *(const LAS u32x2*)(Vt + sw_off(16 * dt + fr, 264, 7, 32 * k2 + 4 * fq)), hi = *(const LAS u32x2*)(Vt + sw_off(16 * dt + fr, 264, 7, 32 * k2 + 16 + 4 * fq));
                const u32x4 aw = (u32x4){lo.x, lo.y, hi.x, hi.y};
                o[dt] = __builtin_amdgcn_mfma_f32_16x16x32_bf16(__builtin_bit_cast(bf16x8, aw), pb, o[dt], 0, 0, 0);
            }
        }
        const float inv = 1.0f / sum;
#pragma unroll
        for (int dt = 0; dt < 4; ++dt) {
            const u32x2 gt = gts[dt];
            u32x2 wv; wv.x = pk(o[dt][0] * inv * bflo(gt.x), o[dt][1] * inv * bfhi(gt.x)); wv.y = pk(o[dt][2] * inv * bflo(gt.y), o[dt][3] * inv * bfhi(gt.y));
            *(u32x2*)(MIX + (size_t)row * DM + 64 * head + 16 * dt + 4 * fq) = wv;
        }
    }
    __syncthreads();
}

struct UcRegs { u32x4 kv[4], vv[4]; };
__device__ __forceinline__ void uc_load(UcRegs& R, const bf16_t* P, int unit, int tid) {
    const int h = unit & 3, c = (unit >> 2) & 63, n = unit >> 8;
    const int R0 = n * SEQ + c * 128;
#pragma unroll
    for (int i = 0; i < 4; ++i) { const int j = (tid >> 4) + 32 * i, c8 = tid & 15; const bf16_t* pr = P + (size_t)(R0 + j) * NIN + 128 * h + 8 * c8;
        R.kv[i] = *(const u32x4*)(pr + 1792); R.vv[i] = *(const u32x4*)(pr + 2304); }
}
__device__ __forceinline__ void uc_compute(LAS unsigned char* lds, const UcRegs& R, float* UT, int unit, int tid) {
    const int h = unit & 3;
    const float l2g = l2gamma(h);
    LAS bf16_t* Kt = (LAS bf16_t*)lds;
    LAS bf16_t* Vt = (LAS bf16_t*)(lds + 128 * 272);
    const int lane = tid & 63, w = tid >> 6, fr = lane & 15, fq = lane >> 4;
#pragma unroll
    for (int i = 0; i < 4; ++i) { const int j = (tid >> 4) + 32 * i, c8 = tid & 15; const u32x4 kv = R.kv[i];
        const float dec = ex2((float)(127 - j) * l2g);
        u32x4 kd; kd.x = pk(bflo(kv.x) * dec, bfhi(kv.x) * dec); kd.y = pk(bflo(kv.y) * dec, bfhi(kv.y) * dec);
        kd.z = pk(bflo(kv.z) * dec, bfhi(kv.z) * dec); kd.w = pk(bflo(kv.w) * dec, bfhi(kv.w) * dec);
        tr_write_sw(Kt, 136, c8, 15, j, kd, 16, tid); tr_write_sw(Vt, 136, c8, 15, j, R.vv[i], 16, tid); }
    __syncthreads();
    const int mt0 = 2 * (w & 3), nt0 = 4 * (w >> 2);
    f32x4 acc[2][4];
#pragma unroll
    for (int mi = 0; mi < 2; ++mi)
#pragma unroll
        for (int ni = 0; ni < 4; ++ni) acc[mi][ni] = (f32x4){0.f, 0.f, 0.f, 0.f};
#pragma unroll
    for (int ks = 0; ks < 4; ++ks) {
        bf16x8 af[2], bfr[4];
#pragma unroll
        for (int mi = 0; mi < 2; ++mi) af[mi] = *(const LAS bf16x8*)(Kt + sw_off(16 * (mt0 + mi) + fr, 136, 15, 32 * ks + 8 * fq));
#pragma unroll
        for (int ni = 0; ni < 4; ++ni) bfr[ni] = *(const LAS bf16x8*)(Vt + sw_off(16 * (nt0 + ni) + fr, 136, 15, 32 * ks + 8 * fq));
#pragma unroll
        for (int mi = 0; mi < 2; ++mi)
#pragma unroll
            for (int ni = 0; ni < 4; ++ni) acc[mi][ni] = __builtin_amdgcn_mfma_f32_16x16x32_bf16(af[mi], bfr[ni], acc[mi][ni], 0, 0, 0);
    }
    float* ub = UT + (size_t)unit * 16384;
#pragma unroll
    for (int mi = 0; mi < 2; ++mi)
#pragma unroll
        for (int ni = 0; ni < 4; ++ni) *(f32x4*)(ub + (16 * (nt0 + ni) + fr) * 128 + 16 * (mt0 + mi) + 4 * fq) = acc[mi][ni];
    __syncthreads();
}

__device__ __forceinline__ void sattn_unit(LAS unsigned char* lds, const bf16_t* P, bf16_t* MIX, const float* ck, const float* cv, float* kso, float* vso, const float* sinks_l, int unit, int tid) {
    const int n = unit >> 1, g = unit & 1;
    LAS float* Kc = (LAS float*)lds;
    LAS float* Vc = Kc + 132 * 68;
    LAS float* Qs = Vc + 132 * 68;
    LAS float* Sc = Qs + 1024;
    const float sink_pre = sinks_l[4 * g + ((tid >> 5) & 3)];
    bf16_t gate_pre[4];
    {
        const int lane_ = tid & 63, w_ = tid >> 6, d_ = 16 * (w_ & 3) + (lane_ & 15);
        const bf16_t* gp_ = P + (size_t)(MP + 4 * n + (lane_ >> 4)) * NIN + 768 + 64 * 4 * g + d_;
#pragma unroll
        for (int r = 0; r < 4; ++r) gate_pre[r] = gp_[64 * r];
    }
#pragma unroll
    for (int i = 0; i < 4; ++i) {
        const int ch = tid + 512 * i, wp = ch >> 4, c4 = ch & 15;
        const size_t src = (size_t)((n * 128 + wp) * 2 + g) * 64 + 4 * c4;
        const f32x4 kv = __builtin_nontemporal_load((const f32x4*)(ck + src)), vv = __builtin_nontemporal_load((const f32x4*)(cv + src));
        *(LAS f32x4*)(Kc + wp * 68 + 4 * c4) = kv; *(LAS f32x4*)(Vc + wp * 68 + 4 * c4) = vv;
        if (wp >= 4) { const size_t dst = (size_t)((n * 128 + wp - 4) * 2 + g) * 64 + 4 * c4; __builtin_nontemporal_store(kv, (f32x4*)(kso + dst)); __builtin_nontemporal_store(vv, (f32x4*)(vso + dst)); }
    }
    if (tid < 64) {
        const int t = tid >> 4, c4 = tid & 15;
        const size_t src = (size_t)((n * 128 + 124 + t) * 2 + g) * 64 + 4 * c4;
        *(LAS f32x4*)(Kc + (128 + t) * 68 + 4 * c4) = *(const f32x4*)(kso + src); *(LAS f32x4*)(Vc + (128 + t) * 68 + 4 * c4) = *(const f32x4*)(vso + src);
    }
    const int qi = tid >> 5, ln = tid & 31;
    const int head = 4 * g + (qi & 3), row = MP + 4 * n + (qi >> 2);
    { const unsigned u = *(const unsigned*)(P + (size_t)row * NIN + 64 * head + 2 * ln); Qs[qi * 64 + 2 * ln] = bflo(u); Qs[qi * 64 + 2 * ln + 1] = bfhi(u); }
    __syncthreads();
    const int lane = tid & 63, w = tid >> 6, fr = lane & 15, fq = lane >> 4;
#pragma unroll 1
    for (int kt = w; kt < 9; kt += 8) {
        f32x4 z = (f32x4){0.f, 0.f, 0.f, 0.f};
#pragma unroll
        for (int st = 0; st < 16; ++st) z = __builtin_amdgcn_mfma_f32_16x16x4f32(Qs[fr * 64 + 4 * st + fq], Kc[(16 * kt + fr) * 68 + 4 * st + fq], z, 0, 0, 0);
        const int k = 16 * kt + fr;
        if (k < 132) {
            const bool valid = (k >= fq + 1) && (k <= fq + 128);
#pragma unroll
            for (int r = 0; r < 4; ++r) Sc[(4 * fq + r) * 136 + k] = valid ? z[r] : -INFINITY;
        }
    }
    __syncthreads();
    const float sink2 = sink_pre * LOG2E;
    float mx = -INFINITY;
    for (int k = ln; k < 132; k += 32) mx = fmaxf(mx, Sc[qi * 136 + k]);
#pragma unroll
    for (int o = 1; o < 32; o <<= 1) mx = fmaxf(mx, shx(mx, o, tid));
    mx = fmaxf(mx, sink2);
    float sum = 0.f;
    for (int k = ln; k < 132; k += 32) { const float p = ex2(Sc[qi * 136 + k] - mx); Sc[qi * 136 + k] = p; sum += p; }
#pragma unroll
    for (int o = 1; o < 32; o <<= 1) sum += shx(sum, o, tid);
    if (ln == 0) Sc[qi * 136 + 132] = 1.0f / (sum + ex2(sink2 - mx));
    __syncthreads();
    if (w < 4) {
        f32x4 o = (f32x4){0.f, 0.f, 0.f, 0.f};
#pragma unroll 11
        for (int st = 0; st < 33; ++st) o = __builtin_amdgcn_mfma_f32_16x16x4f32(Sc[fr * 136 + 4 * st + fq], Vc[(4 * st + fq) * 68 + 16 * w + fr], o, 0, 0, 0);
        const int d = 16 * w + fr, orow = MP + 4 * n + fq;
#pragma unroll
        for (int r = 0; r < 4; ++r) {
            const int hd = 4 * g + r;
            const float gate = bf2f(gate_pre[r]);
            MIX[(size_t)orow * DM + 64 * hd + d] = (bf16_t)(pk(o[r] * Sc[(4 * fq + r) * 136 + 132] * gate, 0.f) & 0xffffu);
        }
    }
    __syncthreads();
}

struct SretRegs { f32x4 s4[8]; float gate; unsigned qkv; unsigned vv; };
__device__ __forceinline__ void sret_load(SretRegs& R, const bf16_t* P, const float* Sin, int unit, int tid) {
    const int n = unit >> 2, h = unit & 3;
    const int v4 = tid & 31, dg = tid >> 5;
    const float* Sb = Sin + (size_t)unit * 16384;
    const int t = tid >> 7, d = tid & 127;
    const bf16_t* pr = P + (size_t)(MP + 4 * n + t) * NIN + 128 * h + d;
    R.qkv = (unsigned)pr[1280] | ((unsigned)pr[1792] << 16); R.vv = (unsigned)pr[2304];
    R.gate = bf2f(pr[2816]);
#pragma unroll
    for (int i = 0; i < 8; ++i) R.s4[i] = __builtin_nontemporal_load((const f32x4*)(Sb + (8 * dg + i) * 128 + 4 * v4));
}
__device__ __forceinline__ void sret_compute(LAS unsigned char* lds, const SretRegs& R, bf16_t* MIX, float* Sout, int unit, int tid) {
    const int n = unit >> 2, h = unit & 3;
    const float l2g = l2gamma(h);
    LAS float* qs = (LAS float*)lds;
    LAS float* ks_ = qs + 512;
    LAS float* vs_ = qs + 1024;
    LAS float* qk = qs + 1536;
    LAS float* red = qs + 1552;
    LAS float* part = qs + 2048;
    const int v4 = tid & 31, dg = tid >> 5;
    float* So = Sout + (size_t)unit * 16384;
    qs[tid] = bflo(R.qkv); ks_[tid] = bfhi(R.qkv); vs_[tid] = bflo(R.vv);
    __syncthreads();
    f32x4 vj[4], cr[4];
#pragma unroll
    for (int j = 0; j < 4; ++j) { vj[j] = *(const LAS f32x4*)(vs_ + j * 128 + 4 * v4); cr[j] = (f32x4){0.f, 0.f, 0.f, 0.f}; }
    const float g1 = ex2(l2g), g2 = g1 * g1, g3 = g2 * g1, g4 = g2 * g2;
#pragma unroll
    for (int i = 0; i < 8; ++i) {
        const int d = 8 * dg + i;
#pragma unroll
        for (int t = 0; t < 4; ++t) cr[t] += R.s4[i] * qs[t * 128 + d];
        f32x4 sn = R.s4[i] * g4;
        sn += vj[0] * (g3 * ks_[0 * 128 + d]); sn += vj[1] * (g2 * ks_[1 * 128 + d]); sn += vj[2] * (g1 * ks_[2 * 128 + d]); sn += vj[3] * ks_[3 * 128 + d];
        __builtin_nontemporal_store(sn, (f32x4*)(So + d * 128 + 4 * v4));
    }
#pragma unroll
    for (int t = 0; t < 4; ++t) *(LAS f32x4*)(part + (dg * 4 + t) * 128 + 4 * v4) = cr[t];
    {
        const int t = dg >> 2, j = dg & 3; float p = 0.f;
#pragma unroll
        for (int d = v4; d < 128; d += 32) p += qs[t * 128 + d] * ks_[j * 128 + d];
#pragma unroll
        for (int o = 1; o < 32; o <<= 1) p += shx(p, o, tid);
        if (v4 == 0) qk[dg] = p;
    }
    __syncthreads();
    const int t = tid >> 7, v = tid & 127;
    float cross = 0.f;
#pragma unroll
    for (int d2 = 0; d2 < 16; ++d2) cross += part[(d2 * 4 + t) * 128 + v];
    float o = cross * ex2((float)(t + 1) * l2g);
#pragma unroll
    for (int j = 0; j < 4; ++j) if (j <= t) o += qk[t * 4 + j] * ex2((float)(t - j) * l2g) * vs_[j * 128 + v];
    float ss = o * o;
#pragma unroll
    for (int of = 1; of < 64; of <<= 1) ss += shx(ss, of, tid);
    if ((tid & 63) == 0) red[tid >> 6] = ss;
    __syncthreads();
    const float rn = rsqrtf((red[2 * t] + red[2 * t + 1]) * (1.0f / 128.0f) + 1e-6f);
    const int row = MP + 4 * n + t;
    MIX[(size_t)row * DM + 512 + 128 * h + v] = (bf16_t)(pk(o * rn * R.gate, 0.f) & 0xffffu);
    __syncthreads();
}

__device__ __forceinline__ void sample_outproj_slice(LAS unsigned char* lds, const bf16_t* MIX, const bf16_t* Wt, const float* xs_f32, const bf16_t* XBi, bf16_t* XBn, float* yout, float* rowss_next, int b, int tid) {
    const int lane = tid & 63, w = tid >> 6, fr = lane & 15, fq = lane >> 4;
    const int r0 = MP + 32 * (b >> 4), c0 = 64 * (b & 15), k0 = 128 * w;
    f32x4 res;
    {
        const int mt = w >> 1, nt = w & 1;
        const int col = c0 + 32 * (mt >> 1) + 8 * fq + 4 * (mt & 1), row = r0 + 16 * nt + fr;
        if (xs_f32) res = *(const f32x4*)(xs_f32 + (size_t)(row - MP) * DM + col);
        else { const u32x2 u = *(const u32x2*)(XBi + (size_t)row * DM + col); res = (f32x4){bflo(u.x), bfhi(u.x), bflo(u.y), bfhi(u.y)}; }
    }
    bf16x8 af[4][4], bfr[2][4];
#pragma unroll
    for (int mt = 0; mt < 4; ++mt)
#pragma unroll
        for (int ks = 0; ks < 4; ++ks) af[mt][ks] = *(const bf16x8*)(Wt + (size_t)(c0 + 16 * mt + fr) * DM + k0 + 32 * ks + 8 * fq);
#pragma unroll
    for (int nt = 0; nt < 2; ++nt)
#pragma unroll
        for (int ks = 0; ks < 4; ++ks) bfr[nt][ks] = *(const bf16x8*)(MIX + (size_t)(r0 + 16 * nt + fr) * DM + k0 + 32 * ks + 8 * fq);
    f32x4 acc[4][2];
#pragma unroll
    for (int mt = 0; mt < 4; ++mt)
#pragma unroll
        for (int nt = 0; nt < 2; ++nt) { f32x4 z = (f32x4){0.f, 0.f, 0.f, 0.f};
#pragma unroll
            for (int ks = 0; ks < 4; ++ks) z = __builtin_amdgcn_mfma_f32_16x16x32_bf16(af[mt][ks], bfr[nt][ks], z, 0, 0, 0);
            acc[mt][nt] = z; }
    LAS f32x4* red = (LAS f32x4*)lds;
#pragma unroll
    for (int mt = 0; mt < 4; ++mt)
#pragma unroll
        for (int nt = 0; nt < 2; ++nt) red[(w * 8 + mt * 2 + nt) * 64 + lane] = acc[mt][nt];
    __syncthreads();
    const int mt = w >> 1, nt = w & 1;
    f32x4 v = (f32x4){0.f, 0.f, 0.f, 0.f};
#pragma unroll
    for (int ww = 0; ww < 8; ++ww) v += red[(ww * 8 + w) * 64 + lane];
    const int col = c0 + 32 * (mt >> 1) + 8 * fq + 4 * (mt & 1);
    const int row = r0 + 16 * nt + fr;
    v += res;
    if (yout) *(f32x4*)(yout + (size_t)row * DM + col) = v;
    else {
        u32x2 o; o.x = pk(v[0], v[1]); o.y = pk(v[2], v[3]);
        *(u32x2*)(XBn + (size_t)row * DM + col) = o;
        float ss = (v[0] * v[0] + v[1] * v[1]) + (v[2] * v[2] + v[3] * v[3]);
        ss += shx(ss, 16, lane); ss += shx(ss, 32, lane);
        if (fq == 0) atomicAdd(rowss_next + row, ss);
    }
    __syncthreads();
}

__device__ __forceinline__ void scan_phase(const float* UT, bf16_t* SPT, float* sp_out_l, int tid, int G) {
    for (int gid = blockIdx.x * 512 + tid; gid < 2 * 4 * 16384; gid += G * 512) {
        const int n = gid >> 16, h = (gid >> 14) & 3, e = gid & 16383;
        const float gd = ex2(128.0f * l2gamma(h));
        const size_t base = ((size_t)(n * 64) * 4 + h) * 16384 + e;
        float S = 0.f;
        for (int c0 = 0; c0 < 64; c0 += 32) {
            float uu[32];
#pragma unroll
            for (int k = 0; k < 32; ++k) uu[k] = __builtin_nontemporal_load(UT + base + (size_t)(c0 + k) * 65536);
#pragma unroll
            for (int k = 0; k < 32; ++k) { SPT[base + (size_t)(c0 + k) * 65536] = (bf16_t)(pk(S, 0.f) & 0xffffu); S = gd * S + uu[k]; }
        }
        const int dv = e >> 7, dk = e & 127;
        sp_out_l[(size_t)(n * 4 + h) * 16384 + dk * 128 + dv] = S;
    }
}

__device__ __forceinline__ void ret_unit(LAS unsigned char* lds, const bf16_t* P, const bf16_t* SPT, bf16_t* MIX, int unit, int tid) {
    const int h = unit & 3, c = (unit >> 2) & 63, n = unit >> 8;
    const int R0 = n * SEQ + c * 128;
    const float l2g = l2gamma(h);
    LAS bf16_t* Ks = (LAS bf16_t*)lds;
    LAS bf16_t* Vt = (LAS bf16_t*)(lds + 128 * 272);
    LAS bf16_t* Ss = (LAS bf16_t*)(lds + 256 * 272);
    const int lane = tid & 63, w = __builtin_amdgcn_readfirstlane(tid >> 6), fr = lane & 15, fq = lane >> 4;
    const int qi = 16 * w + fr, row = R0 + qi;
    bf16x8 bq[4];
#pragma unroll
    for (int ks = 0; ks < 4; ++ks) bq[ks] = *(const bf16x8*)(P + (size_t)row * NIN + 1280 + 128 * h + 32 * ks + 8 * fq);
    u32x2 gts[8];
#pragma unroll
    for (int dt = 0; dt < 8; ++dt) gts[dt] = *(const u32x2*)(P + (size_t)row * NIN + 2816 + 128 * h + 16 * dt + 4 * fq);
#pragma unroll
    for (int i = 0; i < 4; ++i) {
        const int ch = tid + 512 * i, j = ch >> 4, c8 = ch & 15;
        const u32x4 kv = *(const u32x4*)(P + (size_t)(R0 + j) * NIN + 1792 + 128 * h + 8 * c8);
        const u32x4 sv = __builtin_nontemporal_load((const u32x4*)(SPT + (size_t)unit * 16384 + j * 128 + 8 * c8));
        *(LAS u32x4*)(Ks + j * 136 + 8 * c8) = kv;
        *(LAS u32x4*)(Ss + j * 136 + 8 * c8) = sv;
    }
    {
        u32x4 vv[4];
#pragma unroll
        for (int i = 0; i < 4; ++i) vv[i] = *(const u32x4*)(P + (size_t)(R0 + (tid >> 4) + 32 * i) * NIN + 2304 + 128 * h + 8 * (tid & 15));
#pragma unroll
        for (int i = 0; i < 4; ++i) tr_write_sw(Vt, 136, tid & 15, 15, (tid >> 4) + 32 * i, vv[i], 16, tid);
    }
    __syncthreads();
    f32x4 o[8];
#pragma unroll
    for (int dt = 0; dt < 8; ++dt) {
        f32x4 z = (f32x4){0.f, 0.f, 0.f, 0.f};
#pragma unroll
        for (int ks = 0; ks < 4; ++ks) z = __builtin_amdgcn_mfma_f32_16x16x32_bf16(*(const LAS bf16x8*)(Ss + (16 * dt + fr) * 136 + 32 * ks + 8 * fq), bq[ks], z, 0, 0, 0);
        o[dt] = z * ex2((float)(qi + 1) * l2g);
    }
    f32x4 sc[8];
#pragma unroll
    for (int jt = 0; jt < 8; ++jt) {
        f32x4 z = (f32x4){0.f, 0.f, 0.f, 0.f};
        if (jt <= w) {
#pragma unroll
            for (int ks = 0; ks < 4; ++ks) z = __builtin_amdgcn_mfma_f32_16x16x32_bf16(*(const LAS bf16x8*)(Ks + (16 * jt + fr) * 136 + 32 * ks + 8 * fq), bq[ks], z, 0, 0, 0);
#pragma unroll
            for (int r = 0; r < 4; ++r) { const int j = 16 * jt + 4 * fq + r; z[r] = (qi >= j) ? z[r] * ex2((float)(qi - j) * l2g) : 0.f; }
        }
        sc[jt] = z;
    }
#pragma unroll
    for (int k2 = 0; k2 < 4; ++k2) {
        if (2 * k2 <= w) {
            u32x4 pw; pw.x = pk(sc[2 * k2][0], sc[2 * k2][1]); pw.y = pk(sc[2 * k2][2], sc[2 * k2][3]); pw.z = pk(sc[2 * k2 + 1][0], sc[2 * k2 + 1][1]); pw.w = pk(sc[2 * k2 + 1][2], sc[2 * k2 + 1][3]);
            const bf16x8 pb = __builtin_bit_cast(bf16x8, pw);
#pragma unroll
            for (int dt = 0; dt < 8; ++dt) {
                const u32x2 lo = *(const LAS u32x2*)(Vt + sw_off(16 * dt + fr, 136, 15, 32 * k2 + 4 * fq)), hi = *(const LAS u32x2*)(Vt + sw_off(16 * dt + fr, 136, 15, 32 * k2 + 16 + 4 * fq));
                const u32x4 aw = (u32x4){lo.x, lo.y, hi.x, hi.y};
                o[dt] = __builtin_amdgcn_mfma_f32_16x16x32_bf16(__builtin_bit_cast(bf16x8, aw), pb, o[dt], 0, 0, 0);
            }
        }
    }
    float ss = 0.f;
#pragma unroll
    for (int dt = 0; dt < 8; ++dt) ss += (o[dt][0] * o[dt][0] + o[dt][1] * o[dt][1]) + (o[dt][2] * o[dt][2] + o[dt][3] * o[dt][3]);
    ss += shx(ss, 16, lane); ss += shx(ss, 32, lane);
    const float rn = rsqrtf(ss * (1.0f / 128.0f) + 1e-6f);
#pragma unroll
    for (int dt = 0; dt < 8; ++dt) {
        const u32x2 gt = gts[dt];
        u32x2 wv; wv.x = pk(o[dt][0] * rn * bflo(gt.x), o[dt][1] * rn * bfhi(gt.x)); wv.y = pk(o[dt][2] * rn * bflo(gt.y), o[dt][3] * rn * bfhi(gt.y));
        *(u32x2*)(MIX + (size_t)row * DM + 512 + 128 * h + 16 * dt + 4 * fq) = wv;
    }
    __syncthreads();
}


#define XB_TMO      128
#define XB_XCNT(j)  (256  + 64 * (j))
#define XB_XSUB(j)  (1280 + 64 * (j))
#define XB_XGEN(j)  (2304 + 64 * (j))
#define XB_TOP      3328
#define XB_TOPGEN   3392
#define XCD_BAR_WORDS 3456
#define XB_SPIN_CAP (1u << 22)
__device__ __forceinline__ unsigned xb_ld(unsigned* p)              { return __hip_atomic_load(p, __ATOMIC_RELAXED, __HIP_MEMORY_SCOPE_AGENT); }
__device__ __forceinline__ unsigned xb_add(unsigned* p, unsigned v) { return __hip_atomic_fetch_add(p, v, __ATOMIC_RELAXED, __HIP_MEMORY_SCOPE_AGENT); }
__device__ __forceinline__ unsigned xb_xcc_id() { return (unsigned)__builtin_amdgcn_s_getreg((3 << 11) | 20) & 0xFu; }
#define XB_SPIN(cond, bar) do { unsigned _sp = 0; while (cond) { __builtin_amdgcn_s_sleep(1); \
    if ((++_sp & 255u) == 0u) { if (xb_ld(&(bar)[XB_TMO])) break; if (_sp > XB_SPIN_CAP) { atomicAdd(&(bar)[XB_TMO], 1u); break; } } } } while (0)
struct XcdBarrier { unsigned* bar; unsigned x; volatile LAS unsigned* st; };
__device__ __forceinline__ XcdBarrier xcd_barrier_post(unsigned* bar, volatile LAS unsigned* st) {
    XcdBarrier b; b.bar = bar; b.x = xb_xcc_id(); b.st = st;
    if (threadIdx.x == 0) (void)xb_add(&bar[XB_XCNT(b.x)], 1u);
    return b;
}
__device__ __forceinline__ void xcd_barrier_complete(unsigned* bar, unsigned x, unsigned& nloc, unsigned& nx) {
    const unsigned G = gridDim.x * gridDim.y * gridDim.z;
    unsigned sum, cnt, mine, sp = 0u;
    for (;;) {
        sum = 0u; cnt = 0u; mine = 0u;
#pragma unroll
        for (unsigned j = 0; j < 16; ++j) { const unsigned c = xb_ld(&bar[XB_XCNT(j)]); sum += c; cnt += (c > 0u) ? 1u : 0u; mine = (j == x) ? c : mine; }
        if (sum == G) break;
        __builtin_amdgcn_s_sleep(1);
        if ((++sp & 255u) == 0u) { if (xb_ld(&bar[XB_TMO])) break; if (sp > XB_SPIN_CAP) { atomicAdd(&bar[XB_TMO], 1u); break; } }
    }
    nloc = mine > 0u ? mine : 1u; nx = cnt > 0u ? cnt : 1u;
}
__device__ __forceinline__ void xcd_barrier(const XcdBarrier& b0) {
    XcdBarrier b = b0;
    asm volatile("" : "+s"(b.x));
    asm volatile("s_waitcnt vmcnt(0)" ::: "memory");
    __syncthreads();
    if (threadIdx.x == 0) {
        unsigned* bar = b.bar;
        asm volatile("" : "+s"(bar));
        __builtin_amdgcn_s_waitcnt(0);
        unsigned nloc = b.st[0], nx = b.st[1];
        if (nloc == 0u) { xcd_barrier_complete(bar, b.x, nloc, nx); b.st[0] = nloc; b.st[1] = nx; }
        const unsigned old = xb_add(&bar[XB_XSUB(b.x)], 1u);
        const unsigned gen = old / nloc;
        if (old + 1u == (gen + 1u) * nloc) {
            __builtin_amdgcn_fence(__ATOMIC_RELEASE, "agent");
            asm volatile("s_waitcnt vmcnt(0)" ::: "memory");
            const unsigned og = xb_add(&bar[XB_TOP], 1u);
            const unsigned tg = og / nx;
            if (og + 1u == (tg + 1u) * nx) xb_add(&bar[XB_TOPGEN], 1u);
            else XB_SPIN(xb_ld(&bar[XB_TOPGEN]) == tg, bar);
            __builtin_amdgcn_fence(__ATOMIC_ACQUIRE, "agent");
            xb_add(&bar[XB_XGEN(b.x)], 1u);
            asm volatile("s_waitcnt vmcnt(0)" ::: "memory");
        } else {
            XB_SPIN(xb_ld(&bar[XB_XGEN(b.x)]) == gen, bar);
            __builtin_amdgcn_fence(__ATOMIC_ACQUIRE, "agent");
            asm volatile("s_waitcnt vmcnt(0)" ::: "memory");
        }
    }
    __syncthreads();
}
constexpr int MISC_OFF = 131072 + 320;
__device__ __forceinline__ int launder_tid() { int t = threadIdx.x; asm volatile("" : "+v"(t)); return t; }
__global__ void __launch_bounds__(512, 2) hymba_fwd(Args a) {
    extern __shared__ __attribute__((aligned(16))) unsigned char lds_raw[];
    LAS unsigned char* lds = (LAS unsigned char*)lds_raw;
    const int tid = threadIdx.x, G = gridDim.x;
    unsigned char* ws = a.ws;
    float* out = a.out;
    bf16_t* P = (bf16_t*)(ws + WS_P); bf16_t* MIX = (bf16_t*)(ws + WS_MIX);
    float* UT = (float*)(ws + WS_UT); bf16_t* SPT = (bf16_t*)(ws + WS_SPT);
    float* rowss = (float*)(ws + WS_ROWSS);
    const float* tabB = (const float*)(ws + WS_TABB); const float* tabA = (const float*)(ws + WS_TABA);
    const int lo = a.ph_lo, hi = a.ph_hi;
    volatile LAS unsigned* MISC = (volatile LAS unsigned*)(lds + MISC_OFF);
    if (tid < 32) MISC[tid] = 0u;
    __syncthreads();
    XcdBarrier bar = xcd_barrier_post((unsigned*)ws, MISC + 8);
    if (a.ph_lo < 0) cg::this_grid().sync();
#if MK_MULTI
#define IN(k) (lo <= (k) && (k) < hi)
#else
#define IN(k) true
#endif
#define LT() launder_tid()
#define SEAM(k) do { if (IN(k) && IN((k) + 1)) { xcd_barrier(bar); } } while (0)
#ifndef SKIP_P0
    if (IN(0)) for (int rep = 0; rep < REP_P0; ++rep) { p0_prologue(a, lds, tid, G); if (rep + 1 < REP_P0) xcd_barrier(bar); }
#endif
    SEAM(0);
    for (int l = 0; l < DEPTH; ++l) {
        const int pb = 1 + 5 * l;
        const float* sinks_l = a.in[10] + 8 * l;
        bf16_t* XB = (bf16_t*)(ws + ((l & 1) ? WS_XB2 : WS_XB)); bf16_t* XBn = (bf16_t*)(ws + ((l & 1) ? WS_XB : WS_XB2));
#ifndef SKIP_P1
        if (IN(pb)) for (int rep = 0; rep < REP_P1; ++rep) {
            const int b = (int)blockIdx.x;
            unsigned* cnt = (unsigned*)(ws + 14336) + 64 * l;
            pg8::Gemm g{XB, (const bf16_t*)(ws + WS_WIN) + (size_t)l * NIN * DM, MT, NIN, DM};
            EpiIn E{P, rowss + l * MT, a.in[8] + 64 * l, a.in[9] + 64 * l, tabA, tabB,
                    out + O_KP + (size_t)l * 32768, out + O_VP + (size_t)l * 32768, out + O_KS + (size_t)l * 2097152, out + O_VS + (size_t)l * 2097152};
            {
                SampleFirstOrder S; S.S.init(MP, NIN, G, b); S.cnt = cnt;
                const bool hs = (b >= 64 && b < 90);
                S.spm = hs ? 64 + (b - 64) / 13 : -1; S.spn = hs ? (b - 64) % 13 : 0;
                pg8::gemm_phase<EpiIn, SampleFirstOrder, true, true>(lds, g, S, E, LT());
            }
            if (b >= 90) {
                if (threadIdx.x == 0) {
                    XB_SPIN(xb_ld(cnt) < 26u * (unsigned)(rep + 1), (unsigned*)ws);
                    __builtin_amdgcn_fence(__ATOMIC_ACQUIRE, "agent"); asm volatile("s_waitcnt vmcnt(0)" ::: "memory");
                }
                __syncthreads();
                const float* ck = a.in[2] + (size_t)l * 2097152; const float* cv = a.in[3] + (size_t)l * 2097152;
                float* kso = out + O_KS + (size_t)l * 2097152; float* vso = out + O_VS + (size_t)l * 2097152;
                const float* sin_l = a.in[4] + (size_t)l * 8388608; float* sout_l = out + O_SS + (size_t)l * 8388608;
                {
                    const int stride = G - 90;
                    int u = b - 90;
                    if (u < 512) {
                        SretRegs cur; sret_load(cur, P, sin_l, u, LT());
#pragma unroll 1
                        for (; u < 512; u += stride) {
                            const int nx = u + stride;
                            SretRegs nxt = cur;
                            if (nx < 512) sret_load(nxt, P, sin_l, nx, LT());
                            sret_compute(lds, cur, MIX, sout_l, u, LT());
                            cur = nxt;
                        }
                    }
#pragma unroll 1
                    for (; u < 768; u += stride) sattn_unit(lds, P, MIX, ck, cv, kso, vso, sinks_l, u - 512, LT());
                }
            }
        }
#endif
        SEAM(pb);
#ifndef SKIP_P2
        if (IN(pb + 1)) for (int rep = 0; rep < REP_P2; ++rep) {
            const int b = (int)blockIdx.x;
            UcRegs u1, u2; AttnRegs ar;
            uc_load(u1, P, b, LT());
            uc_load(u2, P, b + 256, LT());
            uc_compute(lds, u1, UT, b, LT());
            attn_load(ar, P, b, LT());
            uc_compute(lds, u2, UT, b + 256, LT());
            attn_compute(lds, ar, P, MIX, sinks_l, b, LT());
        }
#endif
        SEAM(pb + 1);
#ifndef SKIP_SCAN
        if (IN(pb + 2)) for (int rep = 0; rep < REP_P3; ++rep) {
            const bool lastl = (l == DEPTH - 1);
            sample_outproj_slice(lds, MIX, (const bf16_t*)(ws + WS_WOUT) + (size_t)l * DM * DM, l == 0 ? a.in[1] : nullptr, XB, XBn, lastl ? out : nullptr,
                                 lastl ? nullptr : (rep == 0 ? rowss + (l + 1) * MT : (float*)(ws + WS_DUMMY)), (int)blockIdx.x, LT());
            scan_phase(UT, SPT, out + O_SP + (size_t)l * 131072, LT(), G);
        }
#endif
        SEAM(pb + 2);
#ifndef SKIP_RET
        if (IN(pb + 3)) for (int rep = 0; rep < REP_P4; ++rep) { for (int u = blockIdx.x; u < 512; u += G) ret_unit(lds, P, SPT, MIX, u, LT()); }
#endif
        SEAM(pb + 3);
#ifndef SKIP_P5
        if (IN(pb + 4)) for (int rep = 0; rep < REP_P5; ++rep) {
            pg8::Gemm g{MIX, (const bf16_t*)(ws + WS_WOUT) + (size_t)l * DM * DM, MP, DM, DM};
            pg8::StaticOrder S; S.init(MP, DM, G, (int)blockIdx.x);
            const bool lastl = (l == DEPTH - 1);
            EpiOut E{l == 0 ? a.in[0] : nullptr, l == 0 ? a.in[1] : nullptr, lastl ? out : nullptr, XB, XBn, lastl ? nullptr : (rep == 0 ? rowss + (l + 1) * MT : (float*)(ws + WS_DUMMY))};
            pg8::gemm_phase<EpiOut, pg8::StaticOrder, true, true>(lds, g, S, E, LT());
        }
#endif
        SEAM(pb + 4);
    }
#undef IN
#undef SEAM
}

extern "C" void kernel_launch(void* const* d_in, const int* in_sizes, int n_in, void* d_out, int out_size, void* d_ws, size_t ws_size, hipStream_t stream) {
    static int grid = 0;
    if (grid == 0) {
        int dev = 0, cus = 0, per_cu = 0;
        if (n_in != 11 || ws_size < WS_END) { fprintf(stderr, "kernel_launch: unexpected n_in %d / ws %zu\n", n_in, ws_size); grid = -1; return; }
        if (hipGetDevice(&dev) != hipSuccess || hipDeviceGetAttribute(&cus, hipDeviceAttributeMultiprocessorCount, dev) != hipSuccess) { grid = -1; return; }
        if (hipFuncSetAttribute((const void*)hymba_fwd, hipFuncAttributeMaxDynamicSharedMemorySize, LDS_BYTES) != hipSuccess) { fprintf(stderr, "kernel_launch: hipFuncSetAttribute failed\n"); grid = -1; return; }
        if (hipOccupancyMaxActiveBlocksPerMultiprocessor(&per_cu, (const void*)hymba_fwd, 512, LDS_BYTES) != hipSuccess || per_cu < 1) { fprintf(stderr, "kernel_launch: occupancy query says %d\n", per_cu); per_cu = 1; }
        (void)hipGetLastError();
        if (cus < 256) { fprintf(stderr, "kernel_launch: needs 256 CUs, got %d\n", cus); grid = -1; return; }
        grid = 256;
    }
    if (grid < 0) return;
    if (hipMemsetAsync(d_ws, 0, 16384, stream) != hipSuccess) { fprintf(stderr, "kernel_launch: memset failed\n"); return; }
    Args a{};
    for (int i = 0; i < 11; ++i) a.in[i] = (const float*)d_in[i];
    a.out = (float*)d_out; a.ws = (unsigned char*)d_ws;
    a.baseA = std::pow(500000.0, -1.0 / 8.0); a.baseB = std::pow(10000.0, -1.0 / 64.0);
    constexpr int NPH = 1 + 5 * DEPTH;
#if MK_MULTI
    for (int p = 0; p < NPH; ++p) { a.ph_lo = p; a.ph_hi = p + 1; hipLaunchKernelGGL(hymba_fwd, dim3(grid), dim3(512), LDS_BYTES, stream, a); }
#else
    a.ph_lo = 0; a.ph_hi = NPH;
    void* args[] = {&a};
    hipError_t e = hipLaunchCooperativeKernel((const void*)hymba_fwd, dim3(grid), dim3(512), args, LDS_BYTES, stream);
    if (e != hipSuccess) fprintf(stderr, "cooperative launch failed: %s (grid %d)\n", hipGetErrorString(e), grid);
#endif
}
```

```cpp
#include <hip/hip_runtime.h>
#include <hip/hip_cooperative_groups.h>
#include <cstdio>
#include <cstdint>
#include <cmath>
namespace cg = cooperative_groups;

#ifndef MK_MULTI
#define MK_MULTI 0
#endif

#ifndef REP_P0
#define REP_P0 1
#endif
#ifndef REP_P1
#define REP_P1 1
#endif
#ifndef REP_P2
#define REP_P2 1
#endif
#ifndef REP_P3
#define REP_P3 1
#endif
#ifndef REP_P4
#define REP_P4 1
#endif
#ifndef REP_P5
#define REP_P5 1
#endif
#define LAS __attribute__((address_space(3)))
typedef unsigned short bf16_t;
typedef short bf16x8 __attribute__((ext_vector_type(8)));
typedef float f32x4 __attribute__((ext_vector_type(4)));
typedef float f32x2 __attribute__((ext_vector_type(2)));
typedef unsigned u32x4 __attribute__((ext_vector_type(4)));
typedef unsigned u32x2 __attribute__((ext_vector_type(2)));

constexpr int DM = 1024, SEQ = 8192, NBATCH = 2, MP = NBATCH * SEQ, MS = 512, MT = MP + MS, NIN = 3328, DEPTH = 4;
constexpr int NPOS = 8196;
constexpr float LOG2E = 1.4426950408889634f;
constexpr size_t O_Y = 0, O_KP = 17301504, O_VP = 17432576, O_SP = 17563648, O_KS = 18087936, O_VS = 26476544, O_SS = 34865152;
constexpr size_t MiB = 1u << 20;
constexpr size_t WS_ROWSS = 1 * MiB, WS_TABB = 2 * MiB, WS_TABA = 7 * MiB, WS_WIN = 8 * MiB, WS_WOUT = 36 * MiB, WS_XB = 44 * MiB, WS_MIX = 80 * MiB,
                 WS_P = 116 * MiB, WS_UT = 224 * MiB, WS_SPT = 256 * MiB, WS_XB2 = 272 * MiB, WS_DUMMY = 308 * MiB, WS_END = 312 * MiB;
constexpr int LDS_BYTES = 147456;

__device__ __forceinline__ unsigned pk(float lo, float hi) { unsigned r; asm("v_cvt_pk_bf16_f32 %0, %1, %2" : "=v"(r) : "v"(lo), "v"(hi)); return r; }
__device__ __forceinline__ float bflo(unsigned u) { return __uint_as_float(u << 16); }
__device__ __forceinline__ float bfhi(unsigned u) { return __uint_as_float(u & 0xffff0000u); }
__device__ __forceinline__ float bf2f(bf16_t h) { return __uint_as_float((unsigned)h << 16); }
__device__ __forceinline__ float ex2(float x) { return __builtin_amdgcn_exp2f(x); }
__device__ __forceinline__ float shx(float v, int m, int lane) { return __builtin_bit_cast(float, __builtin_amdgcn_ds_bpermute(((lane ^ m) & 63) << 2, __builtin_bit_cast(int, v))); }
__device__ __forceinline__ int shxi(int v, int m, int lane) { return __builtin_amdgcn_ds_bpermute(((lane ^ m) & 63) << 2, v); }
__device__ __forceinline__ float l2gamma(int h) { const int hb = __builtin_amdgcn_readfirstlane(h); const unsigned b = hb == 0 ? 0xbd3b9ca6u : hb == 1 ? 0xbcba1f74u : hb == 2 ? 0xbc3963ddu : 0xbbb906ceu; return __builtin_bit_cast(float, b); }

namespace pg8 {
constexpr int BM = 256, BK = 64, HALF = 128, HTB = HALF * BK * 2, STAGE_BYTES = 8 * HTB, NXCD = 8, WGM = 8;
__host__ __device__ __forceinline__ int lds_byte(int r, int c) { const int st = (r >> 4) * 2 + (c >> 5), rr = r & 15, cc = c & 31, ob = rr * 64 + cc * 2; return st * 1024 + (ob ^ (((ob >> 9) & 1) << 5)); }
__host__ __device__ __forceinline__ void stage_rc(int b, int& R, int& C) { const int st = b / 1024, sb = b % 1024, swz = sb ^ (((sb >> 9) & 1) << 5); R = (st >> 1) * 16 + swz / 64; C = (st & 1) * 32 + (swz % 64) / 2; }
struct Unit { int pm, pn; };
struct Gemm { const bf16_t* A; const bf16_t* Bt; int M, N, K; };
struct StaticOrder {
    int nM, nN, nwg, G, c;
    __host__ __device__ void init(int M, int N, int G_, int c_) { nM = M / BM; nN = N / BM; nwg = nM * nN; G = G_; c = c_; }
    __host__ __device__ bool next(int i, Unit& u) const {
        const long L = (long)i * G + c; if (L >= nwg) return false;
        int wgid = (int)L; { const int q = nwg / NXCD, r = nwg % NXCD, xcd = wgid % NXCD, off = wgid / NXCD; wgid = (xcd < r ? xcd * (q + 1) : r * (q + 1) + (xcd - r) * q) + off; }
        const int nig = WGM * nN, gid = wgid / nig, fm = gid * WGM, gsz = (nM - fm) < WGM ? (nM - fm) : WGM;
        u.pm = fm + ((wgid % nig) % gsz); u.pn = (wgid % nig) / gsz; return true;
    }
    __device__ __forceinline__ void a_ready(const Unit&) const {}
    __device__ __forceinline__ void done(const Unit&) const {}
};

template <class Epi, class Sched, bool ALIGN_EPI = false, bool SP2 = false>
__device__ __forceinline__ void gemm_phase(LAS unsigned char* lds, const Gemm g, const Sched& S, const Epi& E, const int tid) {
    const int wid = __builtin_amdgcn_readfirstlane(tid >> 6), lane = tid & 63, wr = wid >> 2, wc = wid & 3, fr = lane & 15, fq = lane >> 4;
    const int K = g.K, nt = K / BK;
    unsigned voffA[2], voffB[2];
#pragma unroll
    for (int i = 0; i < 2; ++i) { int R, C; stage_rc(tid * 16 + i * 8192, R, C); voffA[i] = (unsigned)(R * K + C) * 2u; voffB[i] = voffA[i]; }
    const size_t kstep = (size_t)(BK * 2);
    const size_t hstep = (size_t)HALF * K * 2;
    const size_t tstep = 2 * hstep;
    const unsigned ldsw = (unsigned)wid * 1024u;
    const int aoff = lds_byte(wr * 64 + fr, fq * 8), boff = lds_byte(wc * 32 + fr, fq * 8);
#define PG8_SA(b, h) (((b) * 2 + (h)) * HTB)
#define PG8_SB(b, h) ((4 + (b) * 2 + (h)) * HTB)
#define PG8_STAGE(bufoff, gbase, voff) do { _Pragma("unroll") for (int _i = 0; _i < 2; ++_i) \
        __builtin_amdgcn_global_load_lds((const unsigned*)((const char*)(gbase) + (voff)[_i]), (LAS unsigned*)(lds + (bufoff) + ldsw + _i * 8192), 16, 0, 0); } while (0)
#define PG8_LDA(dst, b, h) do { _Pragma("unroll") for (int m = 0; m < 4; ++m) _Pragma("unroll") for (int k = 0; k < 2; ++k) dst[m][k] = *(const LAS bf16x8*)(lds + PG8_SA(b, h) + aoff + m * 2048 + k * 1024); } while (0)
#define PG8_LDB(dst, b, h) do { _Pragma("unroll") for (int n = 0; n < 2; ++n) _Pragma("unroll") for (int k = 0; k < 2; ++k) dst[n][k] = *(const LAS bf16x8*)(lds + PG8_SB(b, h) + boff + n * 2048 + k * 1024); } while (0)
#define PG8_MMA(ai, bj, At, Bt) do { __builtin_amdgcn_s_setprio(1); _Pragma("unroll") for (int m = 0; m < 4; ++m) _Pragma("unroll") for (int n = 0; n < 2; ++n) _Pragma("unroll") for (int k = 0; k < 2; ++k) \
        acc[ai][bj][m][n] = __builtin_amdgcn_mfma_f32_16x16x32_bf16(Bt[n][k], At[m][k], acc[ai][bj][m][n], 0, 0, 0); __builtin_amdgcn_s_setprio(0); } while (0)
#define PG8_WAIT_V(n) asm volatile("s_waitcnt vmcnt(" #n ")" ::: "memory")
#define PG8_WAIT_L(n) asm volatile("s_waitcnt lgkmcnt(" #n ")" ::: "memory")
#define PG8_BAR __builtin_amdgcn_s_barrier()
#define PG8_SCHED __builtin_amdgcn_sched_barrier(0)
    Unit cur, nxt; int ui = 0;
    if (!S.next(0, cur)) return;
    f32x4 acc[2][2][4][2];
#pragma unroll
    for (int a = 0; a < 2; ++a)
#pragma unroll
        for (int b = 0; b < 2; ++b)
#pragma unroll
            for (int m = 0; m < 4; ++m)
#pragma unroll
                for (int n = 0; n < 2; ++n) acc[a][b][m][n] = (f32x4){0.f, 0.f, 0.f, 0.f};
    bf16x8 At[4][2], B0[2][2], B1[2][2];
    const char* cA = (const char*)g.A + (size_t)cur.pm * tstep; const char* cB = (const char*)g.Bt + (size_t)cur.pn * tstep;
    S.a_ready(cur);
    if constexpr (SP2) {
        PG8_STAGE(PG8_SB(0, 0), cB, voffB); PG8_STAGE(PG8_SB(0, 1), cB + hstep, voffB); PG8_STAGE(PG8_SA(0, 0), cA, voffA); PG8_STAGE(PG8_SA(0, 1), cA + hstep, voffA);
        if (wr == 1) PG8_BAR;
        PG8_WAIT_V(2); PG8_BAR;
        PG8_STAGE(PG8_SB(1, 0), cB + kstep, voffB); PG8_STAGE(PG8_SA(1, 0), cA + kstep, voffA); PG8_STAGE(PG8_SB(1, 1), cB + hstep + kstep, voffB);
        PG8_WAIT_V(6); PG8_BAR;
    } else {
        PG8_STAGE(PG8_SB(0, 0), cB, voffB); PG8_STAGE(PG8_SA(0, 0), cA, voffA); PG8_STAGE(PG8_SB(0, 1), cB + hstep, voffB); PG8_STAGE(PG8_SA(0, 1), cA + hstep, voffA);
        if (wr == 1) PG8_BAR;
        PG8_WAIT_V(4); PG8_BAR;
        PG8_STAGE(PG8_SB(1, 0), cB + kstep, voffB); PG8_STAGE(PG8_SA(1, 0), cA + kstep, voffA); PG8_STAGE(PG8_SB(1, 1), cB + hstep + kstep, voffB);
        PG8_WAIT_V(6); PG8_BAR;
    }
    for (;;) {
        const bool has_next = S.next(ui + 1, nxt);
        const char* nA = has_next ? (const char*)g.A + (size_t)nxt.pm * tstep : cA; const char* nB = has_next ? (const char*)g.Bt + (size_t)nxt.pn * tstep : cB;
        for (int t = 0; t < nt; t += 2) {
            const bool last = (t == nt - 2);
            const char* a1 = cA + (size_t)(t + 1) * kstep;
            const char* a2 = last ? nA : cA + (size_t)(t + 2) * kstep; const char* b2 = last ? nB : cB + (size_t)(t + 2) * kstep;
            const char* a3 = a2 + kstep; const char* b3 = b2 + kstep;
            if (last && has_next) S.a_ready(nxt);
            if constexpr (SP2) {
            PG8_LDB(B0, 0, 0); PG8_LDB(B1, 0, 1); PG8_SCHED; PG8_LDA(At, 0, 0); PG8_STAGE(PG8_SA(1, 1), a1 + hstep, voffA);
            PG8_WAIT_V(8); PG8_WAIT_L(0); PG8_BAR; PG8_MMA(0, 0, At, B0); PG8_MMA(0, 1, At, B1); PG8_BAR; PG8_SCHED;
            PG8_LDA(At, 0, 1); PG8_STAGE(PG8_SB(0, 0), b2, voffB); PG8_STAGE(PG8_SB(0, 1), b2 + hstep, voffB); PG8_STAGE(PG8_SA(0, 0), a2, voffA);
            PG8_WAIT_V(8); PG8_WAIT_L(0); PG8_BAR; PG8_MMA(1, 0, At, B0); PG8_MMA(1, 1, At, B1); PG8_BAR; PG8_SCHED;
            PG8_LDB(B0, 1, 0); PG8_LDB(B1, 1, 1); PG8_SCHED; PG8_LDA(At, 1, 0); PG8_STAGE(PG8_SA(0, 1), a2 + hstep, voffA);
            PG8_WAIT_V(8); PG8_WAIT_L(0); PG8_BAR; PG8_MMA(0, 0, At, B0); PG8_MMA(0, 1, At, B1); PG8_BAR; PG8_SCHED;
            PG8_LDA(At, 1, 1); PG8_STAGE(PG8_SB(1, 0), b3, voffB); PG8_STAGE(PG8_SB(1, 1), b3 + hstep, voffB); PG8_STAGE(PG8_SA(1, 0), a3, voffA);
            PG8_WAIT_V(8); PG8_WAIT_L(0); PG8_BAR; PG8_MMA(1, 0, At, B0); PG8_MMA(1, 1, At, B1); PG8_BAR; PG8_SCHED;
            } else {
            PG8_LDB(B0, 0, 0); PG8_SCHED; PG8_LDA(At, 0, 0); PG8_STAGE(PG8_SA(1, 1), a1 + hstep, voffA);
            PG8_WAIT_L(8); PG8_BAR; PG8_WAIT_L(0); PG8_MMA(0, 0, At, B0); PG8_BAR; PG8_SCHED;
            PG8_LDB(B1, 0, 1); PG8_STAGE(PG8_SB(0, 0), b2, voffB);
            PG8_BAR; PG8_WAIT_L(0); PG8_MMA(0, 1, At, B1); PG8_BAR;
            PG8_LDA(At, 0, 1); PG8_STAGE(PG8_SA(0, 0), a2, voffA);
            PG8_BAR; PG8_WAIT_L(0); PG8_MMA(1, 0, At, B0); PG8_BAR; PG8_SCHED;
            PG8_STAGE(PG8_SB(0, 1), b2 + hstep, voffB);
            PG8_WAIT_V(6); PG8_BAR; PG8_MMA(1, 1, At, B1); PG8_BAR;
            PG8_LDB(B0, 1, 0); PG8_SCHED; PG8_LDA(At, 1, 0); PG8_STAGE(PG8_SA(0, 1), a2 + hstep, voffA);
            PG8_WAIT_L(8); PG8_BAR; PG8_WAIT_L(0); PG8_MMA(0, 0, At, B0); PG8_BAR; PG8_SCHED;
            PG8_LDB(B1, 1, 1); PG8_STAGE(PG8_SB(1, 0), b3, voffB);
            PG8_BAR; PG8_WAIT_L(0); PG8_MMA(0, 1, At, B1); PG8_BAR;
            PG8_LDA(At, 1, 1); PG8_STAGE(PG8_SA(1, 0), a3, voffA);
            PG8_BAR; PG8_WAIT_L(0); PG8_MMA(1, 0, At, B0); PG8_BAR; PG8_SCHED;
            PG8_STAGE(PG8_SB(1, 1), b3 + hstep, voffB);
            PG8_WAIT_V(6); PG8_BAR; PG8_MMA(1, 1, At, B1); PG8_BAR;
            }
        }
        if constexpr (ALIGN_EPI) { if (wr == 0) PG8_BAR; }
        E(acc, cur, wr, wc, fr, fq); S.done(cur);
        if (!has_next) break;
#pragma unroll
        for (int a = 0; a < 2; ++a)
#pragma unroll
            for (int b = 0; b < 2; ++b)
#pragma unroll
                for (int m = 0; m < 4; ++m)
#pragma unroll
                    for (int n = 0; n < 2; ++n) acc[a][b][m][n] = (f32x4){0.f, 0.f, 0.f, 0.f};
        cur = nxt; cA = nA; cB = nB; ++ui;
        if constexpr (ALIGN_EPI) { if (wr == 1) PG8_BAR; }
    }
    PG8_WAIT_V(0);
    if constexpr (!ALIGN_EPI) { if (wr == 0) PG8_BAR; }
    PG8_BAR;
#undef PG8_SA
#undef PG8_SB
#undef PG8_STAGE
#undef PG8_LDA
#undef PG8_LDB
#undef PG8_MMA
#undef PG8_WAIT_V
#undef PG8_WAIT_L
#undef PG8_BAR
#undef PG8_SCHED
}
}

__device__ __forceinline__ int colmap_in(int np) {
    const int pn = np >> 8, c = np & 255;
    const int bj = c >> 7, wc = (c >> 5) & 3, n = (c >> 4) & 1, fq = (c >> 2) & 3, j = c & 3;
    const int cnat = 128 * bj + 32 * wc + 8 * fq + 4 * n + j;
    const int d64 = 16 * fq + 8 * bj + 4 * n + j;
    const int d128 = 64 * bj + 32 * (wc & 1) + 8 * fq + 4 * n + j;
    if (pn <= 1) return 64 * (4 * pn + wc) + d64;
    if (pn == 2) return (wc < 2 ? 512 + 64 * wc : 640 + 64 * (wc - 2)) + d64;
    if (pn <= 4) return 768 + 256 * (pn - 3) + cnat;
    if (pn <= 6) return 1280 + 128 * (2 * (pn - 5) + (wc >> 1)) + d128;
    if (pn <= 8) return 1792 + 128 * (2 * (pn - 7) + (wc >> 1)) + d128;
    if (pn <= 10) return 2304 + 256 * (pn - 9) + cnat;
    return 2816 + 256 * (pn - 11) + cnat;
}
__device__ __forceinline__ int colmap_out(int np) {
    const int pn = np >> 8, c = np & 255;
    const int bj = c >> 7, wc = (c >> 5) & 3, n = (c >> 4) & 1, fq = (c >> 2) & 3, j = c & 3;
    return 256 * pn + 128 * bj + 32 * wc + 8 * fq + 4 * n + j;
}

__device__ __forceinline__ int cm_c64(int d, int wc) { return 128 * ((d >> 3) & 1) + 32 * wc + 16 * ((d >> 2) & 1) + 4 * (d >> 4) + (d & 3); }
__device__ __forceinline__ int cm_nat(int x) { return 128 * (x >> 7) + 32 * ((x >> 5) & 3) + 16 * ((x >> 2) & 1) + 4 * ((x >> 3) & 3) + (x & 3); }
__device__ __forceinline__ int cm_c128(int d, int hsel) { return 128 * (d >> 6) + 32 * (2 * hsel + ((d >> 5) & 1)) + 16 * ((d >> 2) & 1) + 4 * ((d >> 3) & 3) + (d & 3); }
__device__ __forceinline__ int colinv_in(int col) {
    if (col < 512) { const int head = col >> 6; return 256 * (head >> 2) + cm_c64(col & 63, head & 3); }
    if (col < 640) { const int o = col - 512; return 512 + cm_c64(o & 63, o >> 6); }
    if (col < 768) { const int o = col - 640; return 512 + cm_c64(o & 63, 2 + (o >> 6)); }
    if (col < 1280) { const int o = col - 768; return 256 * (3 + (o >> 8)) + cm_nat(o & 255); }
    if (col < 1792) { const int o = col - 1280, head = o >> 7; return 256 * (5 + (head >> 1)) + cm_c128(o & 127, head & 1); }
    if (col < 2304) { const int o = col - 1792, head = o >> 7; return 256 * (7 + (head >> 1)) + cm_c128(o & 127, head & 1); }
    if (col < 2816) { const int o = col - 2304; return 256 * (9 + (o >> 8)) + cm_nat(o & 255); }
    const int o = col - 2816; return 256 * (11 + (o >> 8)) + cm_nat(o & 255);
}
__device__ __forceinline__ int colinv_out(int col) { return 256 * (col >> 8) + cm_nat(col & 255); }
struct EpiIn {
    bf16_t* P; const unsigned* rowss; const float* qg; const float* kg; const float* tabA; const float* tabB;
    float* kp; float* vp; float* ks; float* vs;
    __device__ __forceinline__ void operator()(const f32x4 (&acc)[2][2][4][2], const pg8::Unit& u, int wr, int wc, int fr, int fq) const {
        const int pn = u.pn;
        const int rowb = u.pm * 256 + wr * 64 + fr;
        float rr[2][4];
#pragma unroll
        for (int ai = 0; ai < 2; ++ai)
#pragma unroll
            for (int m = 0; m < 4; ++m) rr[ai][m] = (float)rowss[rowb + ai * 128 + m * 16] * (1.0f / 65536.0f);
        if (pn <= 2) {
            const bool isv = (pn == 2 && wc >= 2), isk = (pn == 2 && wc < 2);
            const int head = (pn == 2) ? (wc & 1) : 4 * pn + wc;
            const int colbase = ((pn == 2) ? (isv ? 640 : 512) : 0) + 64 * head + 16 * fq;
            const float* gp = isk ? kg : qg;
#pragma unroll
            for (int am = 0; am < 4; ++am) {
                const int ai = am >> 1;
                f32x4 ca[4][2], sa[4][2];
                if (!isv) {
#pragma unroll
                    for (int m = 2 * (am & 1); m < 2 * (am & 1) + 2; ++m) {
                        const int row = rowb + ai * 128 + m * 16;
                        const int pos = (row < MP) ? (row & 8191) : (8192 + ((row - MP) & 3));
#pragma unroll
                        for (int n = 0; n < 2; ++n) { ca[m][n] = *(const f32x4*)(tabA + pos * 16 + 4 * n); sa[m][n] = *(const f32x4*)(tabA + pos * 16 + 8 + 4 * n); }
                    }
                }
#pragma unroll
                for (int m = 2 * (am & 1); m < 2 * (am & 1) + 2; ++m) {
                    const int row = rowb + ai * 128 + m * 16;
                    const float r = rsqrtf(rr[ai][m] * (1.0f / 1024.0f) + 1e-6f);
                    const int pos = (row < MP) ? (row & 8191) : (8192 + ((row - MP) & 3));
                    f32x4 v[2][2];
#pragma unroll
                    for (int bj = 0; bj < 2; ++bj)
#pragma unroll
                        for (int n = 0; n < 2; ++n) v[bj][n] = acc[ai][bj][m][n] * r;
                    if (!isv) {
                        float ss = 0.f;
#pragma unroll
                        for (int bj = 0; bj < 2; ++bj)
#pragma unroll
                            for (int n = 0; n < 2; ++n) { const f32x4 x = v[bj][n]; ss += (x[0] * x[0] + x[1] * x[1]) + (x[2] * x[2] + x[3] * x[3]); }
                        ss += shx(ss, 16, (fq * 16 + fr)); ss += shx(ss, 32, (fq * 16 + fr));
                        const float rn = rsqrtf(ss * (1.0f / 64.0f) + 1e-6f);
#pragma unroll
                        for (int bj = 0; bj < 2; ++bj)
#pragma unroll
                            for (int n = 0; n < 2; ++n) v[bj][n] = v[bj][n] * rn * *(const f32x4*)(gp + 16 * fq + 8 * bj + 4 * n);
                        if (fq == 0) {
#pragma unroll
                            for (int n = 0; n < 2; ++n) {
                                const f32x4 c = ca[m][n], s = sa[m][n];
                                const f32x4 x1 = v[0][n], x2 = v[1][n];
                                v[0][n] = x1 * c - x2 * s; v[1][n] = x2 * c + x1 * s;
                            }
                        }
                    }
                    if (pn == 2) {
                        float* dst = nullptr;
                        if (row < MP) { if (pos >= SEQ - 128) dst = (isv ? vp : kp) + ((((row >> 13) * 128 + (pos - (SEQ - 128))) * 2 + head) * 64 + 16 * fq); }
                        else { const int sr = row - MP; dst = (isv ? vs : ks) + ((((sr >> 2) * 128 + 124 + (sr & 3)) * 2 + head) * 64 + 16 * fq); }
                        if (dst) {
#pragma unroll
                            for (int bj = 0; bj < 2; ++bj)
#pragma unroll
                                for (int n = 0; n < 2; ++n) *(f32x4*)(dst + 8 * bj + 4 * n) = v[bj][n];
                        }
                    }
                    bf16_t* pp = P + (size_t)row * NIN + colbase;
                    if (pn < 2) {
#pragma unroll
                        for (int bj = 0; bj < 2; ++bj)
#pragma unroll
                            for (int n = 0; n < 2; ++n) v[bj][n] = v[bj][n] * (0.125f * LOG2E);
                    }
#pragma unroll
                    for (int bj = 0; bj < 2; ++bj) {
                        u32x4 w; w.x = pk(v[bj][0][0], v[bj][0][1]); w.y = pk(v[bj][0][2], v[bj][0][3]);
                        w.z = pk(v[bj][1][0], v[bj][1][1]); w.w = pk(v[bj][1][2], v[bj][1][3]);
                        *(u32x4*)(pp + 8 * bj) = w;
                    }
                }
            }
        } else if (pn <= 4 || pn >= 9) {
            const bool silu = (pn <= 4 || pn >= 11);
            const int colbase = (pn <= 4 ? 768 + 256 * (pn - 3) : (pn <= 10 ? 2304 + 256 * (pn - 9) : 2816 + 256 * (pn - 11))) + 32 * wc + 8 * fq;
#pragma unroll
            for (int ai = 0; ai < 2; ++ai)
#pragma unroll
                for (int m = 0; m < 4; ++m) {
                    const int row = rowb + ai * 128 + m * 16;
                    const float r = rsqrtf(rr[ai][m] * (1.0f / 1024.0f) + 1e-6f);
                    bf16_t* pp = P + (size_t)row * NIN + colbase;
#pragma unroll
                    for (int bj = 0; bj < 2; ++bj) {
                        f32x4 v0 = acc[ai][bj][m][0] * r, v1 = acc[ai][bj][m][1] * r;
                        if (silu) {
#pragma unroll
                            for (int e = 0; e < 4; ++e) { v0[e] = v0[e] * __builtin_amdgcn_rcpf(1.0f + ex2(-v0[e] * LOG2E)); v1[e] = v1[e] * __builtin_amdgcn_rcpf(1.0f + ex2(-v1[e] * LOG2E)); }
                        }
                        u32x4 w; w.x = pk(v0[0], v0[1]); w.y = pk(v0[2], v0[3]); w.z = pk(v1[0], v1[1]); w.w = pk(v1[2], v1[3]);
                        *(u32x4*)(pp + 128 * bj) = w;
                    }
                }
        } else {
            const bool isk = pn >= 7;
            const int head = 2 * ((pn - 5) & 1) + (wc >> 1), hh = wc & 1;
            const int colbase = (isk ? 1792 : 1280) + 128 * head + 32 * hh + 8 * fq;
            const float post = __builtin_bit_cast(float, __builtin_amdgcn_readfirstlane(isk ? 0x3db504f3 : 0x3f800000));
#pragma unroll
            for (int am = 0; am < 4; ++am) {
                const int ai = am >> 1;
                f32x4 cc[4][2], sn[4][2];
#pragma unroll
                for (int m = 2 * (am & 1); m < 2 * (am & 1) + 2; ++m) {
                    const int row = rowb + ai * 128 + m * 16;
                    const int pos = (row < MP) ? (row & 8191) : (8192 + ((row - MP) & 3));
                    const float* tb = tabB + pos * 128 + 32 * hh + 8 * fq;
#pragma unroll
                    for (int n = 0; n < 2; ++n) { cc[m][n] = *(const f32x4*)(tb + 4 * n); sn[m][n] = *(const f32x4*)(tb + 64 + 4 * n); }
                }
#pragma unroll
                for (int m = 2 * (am & 1); m < 2 * (am & 1) + 2; ++m) {
                    const int row = rowb + ai * 128 + m * 16;
                    const float r = rsqrtf(rr[ai][m] * (1.0f / 1024.0f) + 1e-6f) * post;
                    f32x4 y1[2], y2[2];
#pragma unroll
                    for (int n = 0; n < 2; ++n) {
                        const f32x4 c = cc[m][n], s = sn[m][n];
                        const f32x4 x1 = acc[ai][0][m][n] * r, x2 = acc[ai][1][m][n] * r;
                        y1[n] = x1 * c - x2 * s; y2[n] = x2 * c + x1 * s;
                    }
                    bf16_t* pp = P + (size_t)row * NIN + colbase;
                    u32x4 w; w.x = pk(y1[0][0], y1[0][1]); w.y = pk(y1[0][2], y1[0][3]); w.z = pk(y1[1][0], y1[1][1]); w.w = pk(y1[1][2], y1[1][3]);
                    *(u32x4*)pp = w;
                    w.x = pk(y2[0][0], y2[0][1]); w.y = pk(y2[0][2], y2[0][3]); w.z = pk(y2[1][0], y2[1][1]); w.w = pk(y2[1][2], y2[1][3]);
                    *(u32x4*)(pp + 64) = w;
                }
            }
        }
    }
};

struct EpiOut {
    const float* xin_p; const float* xin_s;
    float* xout;
    const bf16_t* XBi; bf16_t* XB; unsigned* rowss_next;
    __device__ __forceinline__ void operator()(const f32x4 (&acc)[2][2][4][2], const pg8::Unit& u, int wr, int wc, int fr, int fq) const {
        const int rowb = u.pm * 256 + wr * 64 + fr;
        const int colb = u.pn * 256 + 32 * wc + 8 * fq;
        const bool f32in = (xin_p != nullptr), last = (xout != nullptr);
#pragma unroll
        for (int ai = 0; ai < 2; ++ai) {
            f32x4 pre[4][2][2];
            if (f32in) {
#pragma unroll
                for (int m = 0; m < 4; ++m) { const int row = rowb + ai * 128 + m * 16;
                    const float* xr = (row < MP) ? xin_p + (size_t)row * DM : xin_s + (size_t)(row - MP) * DM;
#pragma unroll
                    for (int bj = 0; bj < 2; ++bj) { pre[m][bj][0] = *(const f32x4*)(xr + colb + 128 * bj); pre[m][bj][1] = *(const f32x4*)(xr + colb + 128 * bj + 4); } }
            } else {
                u32x4 pb[4][2];
#pragma unroll
                for (int m = 0; m < 4; ++m) { const int row = rowb + ai * 128 + m * 16;
#pragma unroll
                    for (int bj = 0; bj < 2; ++bj) pb[m][bj] = __builtin_nontemporal_load((const u32x4*)(XBi + (size_t)row * DM + colb + 128 * bj)); }
#pragma unroll
                for (int m = 0; m < 4; ++m)
#pragma unroll
                    for (int bj = 0; bj < 2; ++bj) { const u32x4 w = pb[m][bj];
                        pre[m][bj][0] = (f32x4){bflo(w.x), bfhi(w.x), bflo(w.y), bfhi(w.y)}; pre[m][bj][1] = (f32x4){bflo(w.z), bfhi(w.z), bflo(w.w), bfhi(w.w)}; }
            }
#pragma unroll
            for (int m = 0; m < 4; ++m) {
                const int row = rowb + ai * 128 + m * 16;
                float ss = 0.f;
#pragma unroll
                for (int bj = 0; bj < 2; ++bj) {
                    const int col = colb + 128 * bj;
                    const f32x4 v0 = pre[m][bj][0] + acc[ai][bj][m][0], v1 = pre[m][bj][1] + acc[ai][bj][m][1];
                    if (last) { __builtin_nontemporal_store(v0, (f32x4*)(xout + (size_t)row * DM + col)); __builtin_nontemporal_store(v1, (f32x4*)(xout + (size_t)row * DM + col + 4)); }
                    else {
                        u32x4 w; w.x = pk(v0[0], v0[1]); w.y = pk(v0[2], v0[3]); w.z = pk(v1[0], v1[1]); w.w = pk(v1[2], v1[3]);
                        *(u32x4*)(XB + (size_t)row * DM + col) = w;
                        ss += (v0[0] * v0[0] + v0[1] * v0[1]) + (v0[2] * v0[2] + v0[3] * v0[3]) + (v1[0] * v1[0] + v1[1] * v1[1]) + (v1[2] * v1[2] + v1[3] * v1[3]);
                    }
                }
                if (!last) { ss += shx(ss, 16, (fq * 16 + fr)); ss += shx(ss, 32, (fq * 16 + fr)); if (fq == 0) atomicAdd(rowss_next + row, (unsigned)(ss * 65536.0f + 0.5f)); }
            }
        }
    }
};
struct OneUnit {
    int pm, pn;
    __device__ __forceinline__ bool next(int i, pg8::Unit& u) const { if (i > 0) return false; u.pm = pm; u.pn = pn; return true; }
    __device__ __forceinline__ void a_ready(const pg8::Unit&) const {}
    __device__ __forceinline__ void done(const pg8::Unit&) const {}
};

struct SampleFirstOrder {
    pg8::StaticOrder S; int spm, spn; unsigned* cnt;
    __device__ __forceinline__ bool next(int i, pg8::Unit& u) const {
        if (spm >= 0) { if (i == 0) { u.pm = spm; u.pn = spn; return true; } return S.next(i - 1, u); }
        return S.next(i, u);
    }
    __device__ __forceinline__ void a_ready(const pg8::Unit&) const {}
    __device__ __forceinline__ void done(const pg8::Unit& u) const {
        if (u.pm >= 64) {
            asm volatile("s_waitcnt vmcnt(0)" ::: "memory");
            __builtin_amdgcn_s_barrier();
            if (threadIdx.x == 0) { __builtin_amdgcn_fence(__ATOMIC_RELEASE, "agent"); asm volatile("s_waitcnt vmcnt(0)" ::: "memory"); __hip_atomic_fetch_add(cnt, 1u, __ATOMIC_RELAXED, __HIP_MEMORY_SCOPE_AGENT); }
        }
    }
};
__device__ __forceinline__ void p0_transpose_item(const float* W, int K, int N, const float* g, bf16_t* WT, bool is_in, LAS float* scr, int item, int lane) {
    const int nblk = N / 32, kb = item / nblk, nb = item % nblk, k0 = 64 * kb, s0 = 32 * nb;
    float tw[32];
#pragma unroll
    for (int i = 0; i < 32; ++i) tw[i] = __builtin_nontemporal_load(W + (size_t)(k0 + 2 * i + (lane >> 5)) * N + s0 + (lane & 31));
#pragma unroll
    for (int i = 0; i < 32; ++i) { const int kk = 2 * i + (lane >> 5); const float gvv = g ? g[k0 + kk] : 1.0f; scr[kk * 33 + (lane & 31)] = tw[i] * gvv; }
    asm volatile("s_waitcnt lgkmcnt(0)" ::: "memory");
    const int c = lane & 7;
#pragma unroll
    for (int j = 0; j < 4; ++j) { const int n = (lane >> 3) + 8 * j; const LAS float* s = scr + (8 * c) * 33 + n;
        const int drow = is_in ? colinv_in(s0 + n) : colinv_out(s0 + n);
        u32x4 o; o.x = pk(s[0 * 33], s[1 * 33]); o.y = pk(s[2 * 33], s[3 * 33]); o.z = pk(s[4 * 33], s[5 * 33]); o.w = pk(s[6 * 33], s[7 * 33]);
        *(u32x4*)(WT + (size_t)drow * K + k0 + 8 * c) = o; }
    asm volatile("s_waitcnt lgkmcnt(0)" ::: "memory");
}
__device__ __forceinline__ void sincos_d(double x, double& s, double& c) {
    const double kd = __builtin_rint(x * 0.63661977236758134308);
    const double r = (x - kd * 1.57079632673412561417e+00) - kd * 6.07710050650619224932e-11;
    const int k = ((int)kd) & 3;
    const double r2 = r * r;
    const double sp = r * (1.0 + r2 * (-1.0 / 6.0 + r2 * (1.0 / 120.0 + r2 * (-1.0 / 5040.0 + r2 * (1.0 / 362880.0 + r2 * (-1.0 / 39916800.0 + r2 * (1.0 / 6227020800.0)))))));
    const double cp = 1.0 + r2 * (-0.5 + r2 * (1.0 / 24.0 + r2 * (-1.0 / 720.0 + r2 * (1.0 / 40320.0 + r2 * (-1.0 / 3628800.0 + r2 * (1.0 / 479001600.0 + r2 * (-1.0 / 87178291200.0)))))));
    s = (k == 0) ? sp : (k == 1) ? cp : (k == 2) ? -sp : -cp;
    c = (k == 0) ? cp : (k == 1) ? -sp : (k == 2) ? -cp : sp;
}

struct Args { const float* in[11]; float* out; unsigned char* ws; double baseA, baseB; int ph_lo, ph_hi; };

__device__ __forceinline__ void p0_prologue(const Args& a, LAS unsigned char* lds, int tid, int G) {
    const int lane = tid & 63, wave = tid >> 6;
    LAS float* scr = (LAS float*)(lds + wave * 16384);
    const int gw = blockIdx.x * 8 + wave, NGW = G * 8;
    unsigned char* ws = a.ws;
    constexpr int I_IN = (DM / 64) * (NIN / 32), I_OUT = (DM / 64) * (DM / 32);
    for (int it = gw; it < DEPTH * (I_IN + I_OUT); it += NGW) {
        const int l = it / (I_IN + I_OUT); int r = it - l * (I_IN + I_OUT);
        if (r < I_IN) p0_transpose_item(a.in[5] + (size_t)l * DM * NIN, DM, NIN, a.in[7] + l * DM, (bf16_t*)(ws + WS_WIN) + (size_t)l * NIN * DM, true, scr, r, lane);
        else p0_transpose_item(a.in[6] + (size_t)l * DM * DM, DM, DM, nullptr, (bf16_t*)(ws + WS_WOUT) + (size_t)l * DM * DM, false, scr, r - I_IN, lane);
    }
    unsigned* rowss = (unsigned*)(ws + WS_ROWSS);
    bf16_t* XB = (bf16_t*)(ws + WS_XB);
    for (int m0 = gw; m0 < MT; m0 += 4 * NGW) {
        f32x4 v[4][4];
#pragma unroll
        for (int q = 0; q < 4; ++q) { const int m = m0 + q * NGW; if (m < MT) { const float* xr = (m < MP) ? a.in[0] + (size_t)m * DM : a.in[1] + (size_t)(m - MP) * DM;
#pragma unroll
            for (int j = 0; j < 4; ++j) v[q][j] = *(const f32x4*)(xr + 4 * lane + 256 * j); } }
#pragma unroll
        for (int q = 0; q < 4; ++q) { const int m = m0 + q * NGW; if (m < MT) {
            float s = 0.f;
#pragma unroll
            for (int j = 0; j < 4; ++j) { const f32x4 x = v[q][j]; s += (x[0] * x[0] + x[1] * x[1]) + (x[2] * x[2] + x[3] * x[3]);
                u32x2 w; w.x = pk(x[0], x[1]); w.y = pk(x[2], x[3]); *(u32x2*)(XB + (size_t)m * DM + 4 * lane + 256 * j) = w; }
#pragma unroll
            for (int o = 1; o < 64; o <<= 1) s += shx(s, o, lane);
            if (lane == 0) rowss[m] = (unsigned)(s * 65536.0f + 0.5f); } }
    }
    const int gt = blockIdx.x * 512 + tid, NGT = G * 512;
    for (int i = gt; i < 3 * MT; i += NGT) rowss[MT + i] = 0u;
    float* tabB = (float*)(ws + WS_TABB); float* tabA = (float*)(ws + WS_TABA);
    for (int idx = gt; idx < NPOS * 72; idx += NGT) {
        const int pos = idx / 72, i = idx - pos * 72;
        const bool isB = i < 64; const int ii = isB ? i : i - 64; const double base = isB ? a.baseB : a.baseA;
        double p = 1.0; for (int k = 0; k < ii; ++k) p *= base;
        const float inv = (float)p; const float ang = (float)pos * inv;
        double s, c; sincos_d((double)ang, s, c);
        if (isB) { tabB[pos * 128 + ii] = (float)c; tabB[pos * 128 + 64 + ii] = (float)s; }
        else { tabA[pos * 16 + ii] = (float)c; tabA[pos * 16 + 8 + ii] = (float)s; }
    }
}


__device__ __forceinline__ void tr_write_sw(LAS bf16_t* img, int RS, int c8, int SM, int tok, u32x4 vv, int XL, int lane) {
    const bool odd = tok & 1;
    const unsigned s0 = odd ? vv.x : vv.z, s1 = odd ? vv.y : vv.w;
    const unsigned r0 = (unsigned)shxi((int)s0, XL, lane), r1 = (unsigned)shxi((int)s1, XL, lane);
    const unsigned a0 = odd ? r0 : vv.x, a1 = odd ? r1 : vv.y, b0 = odd ? vv.z : r0, b1 = odd ? vv.w : r1;
    LAS unsigned* p = (LAS unsigned*)(img + (8 * c8 + (odd ? 4 : 0)) * RS + ((((tok >> 3) ^ (c8 & SM)) << 3) + (tok & 6)));
    const int rs2 = RS >> 1;
    p[0] = (a0 & 0xffffu) | (b0 << 16); p[rs2] = (a0 >> 16) | (b0 & 0xffff0000u);
    p[2 * rs2] = (a1 & 0xffffu) | (b1 << 16); p[3 * rs2] = (a1 >> 16) | (b1 & 0xffff0000u);
}
__device__ __forceinline__ int sw_off(int d, int RS, int SM, int t0) { return d * RS + ((((t0 >> 3) ^ ((d >> 3) & SM)) << 3) + (t0 & 7)); }
struct AttnRegs { u32x4 kv[4], vv[4]; float sink; };
__device__ __forceinline__ void attn_load(AttnRegs& R, const bf16_t* P, int unit, int tid) {
    const int g = unit & 1, qb = (unit >> 1) & 63, n = unit >> 7;
    const int R0 = n * SEQ + qb * 128;
    const int lane = tid & 63, w = tid >> 6, fr = lane & 15, fq = lane >> 4;
#pragma unroll
    for (int i = 0; i < 4; ++i) {
        const int ch = tid + 512 * i, key = ch >> 3, c8 = ch & 7;
        R.kv[i] = (u32x4){0u, 0u, 0u, 0u};
        if (qb > 0 || key >= 128) R.kv[i] = *(const u32x4*)(P + (size_t)(R0 - 128 + key) * NIN + 512 + 64 * g + 8 * c8);
    }
#pragma unroll
    for (int i = 0; i < 4; ++i) { const int key = (tid >> 3) + 64 * i, c8 = tid & 7; R.vv[i] = (u32x4){0u, 0u, 0u, 0u};
        if (qb > 0 || key >= 128) R.vv[i] = *(const u32x4*)(P + (size_t)(R0 - 128 + key) * NIN + 640 + 64 * g + 8 * c8); }
}
__device__ __forceinline__ void attn_compute(LAS unsigned char* lds, const AttnRegs& R, const bf16_t* P, bf16_t* MIX, const float* sinks_l, int unit, int tid) {
    const int g = unit & 1, qb = (unit >> 1) & 63, n = unit >> 7;
    const int R0 = n * SEQ + qb * 128;
    LAS bf16_t* Ks = (LAS bf16_t*)lds;
    LAS bf16_t* Vt = (LAS bf16_t*)(lds + 256 * 144);
    const int lane = tid & 63, w = tid >> 6, fr = lane & 15, fq = lane >> 4;
    const int head = 4 * g + (w >> 1);
#pragma unroll
    for (int i = 0; i < 4; ++i) {
        const int ch = tid + 512 * i, key = ch >> 3, c8 = ch & 7;
        *(LAS u32x4*)(Ks + key * 72 + 8 * c8) = R.kv[i];
    }
#pragma unroll
    for (int i = 0; i < 4; ++i) tr_write_sw(Vt, 264, tid & 7, 7, (tid >> 3) + 64 * i, R.vv[i], 8, tid);
    __syncthreads();
    const float sink2 = sinks_l[head] * LOG2E;
#pragma unroll 1
    for (int qt = 0; qt < 4; ++qt) {
        const int qi = 64 * (w & 1) + 16 * qt + fr;
        const int row = R0 + qi;
        const bf16_t* qp = P + (size_t)row * NIN + 64 * head + 8 * fq;
        const bf16x8 bq0 = *(const bf16x8*)qp, bq1 = *(const bf16x8*)(qp + 32);
        u32x2 gts[4];
#pragma unroll
        for (int dt = 0; dt < 4; ++dt) gts[dt] = *(const u32x2*)(P + (size_t)row * NIN + 768 + 64 * head + 16 * dt + 4 * fq);
        f32x4 s[16];
#pragma unroll
        for (int kt = 0; kt < 16; ++kt) {
            const LAS bf16_t* kr = Ks + (16 * kt + fr) * 72 + 8 * fq;
            const bf16x8 a0 = *(const LAS bf16x8*)kr, a1 = *(const LAS bf16x8*)(kr + 32);
            f32x4 z = (f32x4){0.f, 0.f, 0.f, 0.f};
            z = __builtin_amdgcn_mfma_f32_16x16x32_bf16(a0, bq0, z, 0, 0, 0);
            s[kt] = __builtin_amdgcn_mfma_f32_16x16x32_bf16(a1, bq1, z, 0, 0, 0);
            if ((kt & 3) == 3) __builtin_amdgcn_sched_barrier(0);
        }
        float mx = -INFINITY;
#pragma unroll
        for (int kt = 0; kt < 16; ++kt)
#pragma unroll
            for (int r = 0; r < 4; ++r) {
                const int key = 16 * kt + 4 * fq + r;
                const bool valid = (kt < 8) ? (qb > 0 && key > qi) : (key - 128 <= qi);
                const float x = valid ? s[kt][r] : -INFINITY; s[kt][r] = x; mx = fmaxf(mx, x);
            }
        mx = fmaxf(mx, shx(mx, 16, lane)); mx = fmaxf(mx, shx(mx, 32, lane)); mx = fmaxf(mx, sink2);
        float sum = 0.f;
#pragma unroll
        for (int kt = 0; kt < 16; ++kt)
#pragma unroll
            for (int r = 0; r < 4; ++r) { const float p = ex2(s[kt][r] - mx); s[kt][r] = p; sum += p; }
        sum += shx(sum, 16, lane); sum += shx(sum, 32, lane); sum += ex2(sink2 - mx);
        f32x4 o[4];
#pragma unroll
        for (int dt = 0; dt < 4; ++dt) o[dt] = (f32x4){0.f, 0.f, 0.f, 0.f};
#pragma unroll
        for (int k2 = 0; k2 < 8; ++k2) {
            u32x4 pw; pw.x = pk(s[2 * k2][0], s[2 * k2][1]); pw.y = pk(s[2 * k2][2], s[2 * k2][3]); pw.z = pk(s[2 * k2 + 1][0], s[2 * k2 + 1][1]); pw.w = pk(s[2 * k2 + 1][2], s[2 * k2 + 1][3]);
            const bf16x8 pb = __builtin_bit_cast(bf16x8, pw);
#pragma unroll
            for (int dt = 0; dt < 4; ++dt) {
                const u32x2 lo = *(const LAS u32x2*)(Vt + sw_off(16 * dt + fr, 264, 7, 32 * k2 + 4 * fq)), hi = *(const LAS u32x2*)(Vt + sw_off(16 * dt + fr, 264, 7, 32 * k2 + 16 + 4 * fq));
                const u32x4 aw = (u32x4){lo.x, lo.y, hi.x, hi.y};
                o[dt] = __builtin_amdgcn_mfma_f32_16x16x32_bf16(__builtin_bit_cast(bf16x8, aw), pb, o[dt], 0, 0, 0);
            }
        }
        const float inv = 1.0f / sum;
#pragma unroll
        for (int dt = 0; dt < 4; ++dt) {
            const u32x2 gt = gts[dt];
            u32x2 wv; wv.x = pk(o[dt][0] * inv * bflo(gt.x), o[dt][1] * inv * bfhi(gt.x)); wv.y = pk(o[dt][2] * inv * bflo(gt.y), o[dt][3] * inv * bfhi(gt.y));
            *(u32x2*)(MIX + (size_t)row * DM + 64 * head + 16 * dt + 4 * fq) = wv;
        }
    }
    __syncthreads();
}

struct UcRegs { u32x4 kv[4], vv[4]; };
__device__ __forceinline__ void uc_load(UcRegs& R, const bf16_t* P, int unit, int tid) {
    const int h = unit & 3, c = (unit >> 2) & 63, n = unit >> 8;
    const int R0 = n * SEQ + c * 128;
#pragma unroll
    for (int i = 0; i < 4; ++i) { const int j = (tid >> 4) + 32 * i, c8 = tid & 15; const bf16_t* pr = P + (size_t)(R0 + j) * NIN + 128 * h + 8 * c8;
        R.kv[i] = *(const u32x4*)(pr + 1792); R.vv[i] = *(const u32x4*)(pr + 2304); }
}
__device__ __forceinline__ void uc_compute(LAS unsigned char* lds, const UcRegs& R, float* UT, int unit, int tid) {
    const int h = unit & 3;
    const float l2g = l2gamma(h);
    LAS bf16_t* Kt = (LAS bf16_t*)lds;
    LAS bf16_t* Vt = (LAS bf16_t*)(lds + 128 * 272);
    const int lane = tid & 63, w = tid >> 6, fr = lane & 15, fq = lane >> 4;
#pragma unroll
    for (int i = 0; i < 4; ++i) { const int j = (tid >> 4) + 32 * i, c8 = tid & 15; const u32x4 kv = R.kv[i];
        const float dec = ex2((float)(127 - j) * l2g);
        u32x4 kd; kd.x = pk(bflo(kv.x) * dec, bfhi(kv.x) * dec); kd.y = pk(bflo(kv.y) * dec, bfhi(kv.y) * dec);
        kd.z = pk(bflo(kv.z) * dec, bfhi(kv.z) * dec); kd.w = pk(bflo(kv.w) * dec, bfhi(kv.w) * dec);
        tr_write_sw(Kt, 136, c8, 15, j, kd, 16, tid); tr_write_sw(Vt, 136, c8, 15, j, R.vv[i], 16, tid); }
    __syncthreads();
    const int mt0 = 2 * (w & 3), nt0 = 4 * (w >> 2);
    f32x4 acc[2][4];
#pragma unroll
    for (int mi = 0; mi < 2; ++mi)
#pragma unroll
        for (int ni = 0; ni < 4; ++ni) acc[mi][ni] = (f32x4){0.f, 0.f, 0.f, 0.f};
#pragma unroll
    for (int ks = 0; ks < 4; ++ks) {
        bf16x8 af[2], bfr[4];
#pragma unroll
        for (int mi = 0; mi < 2; ++mi) af[mi] = *(const LAS bf16x8*)(Kt + sw_off(16 * (mt0 + mi) + fr, 136, 15, 32 * ks + 8 * fq));
#pragma unroll
        for (int ni = 0; ni < 4; ++ni) bfr[ni] = *(const LAS bf16x8*)(Vt + sw_off(16 * (nt0 + ni) + fr, 136, 15, 32 * ks + 8 * fq));
#pragma unroll
        for (int mi = 0; mi < 2; ++mi)
#pragma unroll
            for (int ni = 0; ni < 4; ++ni) acc[mi][ni] = __builtin_amdgcn_mfma_f32_16x16x32_bf16(af[mi], bfr[ni], acc[mi][ni], 0, 0, 0);
    }
    float* ub = UT + (size_t)unit * 16384;
#pragma unroll
    for (int mi = 0; mi < 2; ++mi)
#pragma unroll
        for (int ni = 0; ni < 4; ++ni) *(f32x4*)(ub + (16 * (nt0 + ni) + fr) * 128 + 16 * (mt0 + mi) + 4 * fq) = acc[mi][ni];
    __syncthreads();
}

__device__ __forceinline__ void sattn_unit(LAS unsigned char* lds, const bf16_t* P, bf16_t* MIX, const float* ck, const float* cv, float* kso, float* vso, const float* sinks_l, int unit, int tid) {
    const int n = unit >> 1, g = unit & 1;
    LAS float* Kc = (LAS float*)lds;
    LAS float* Vc = Kc + 132 * 68;
    LAS float* Qs = Vc + 132 * 68;
    LAS float* Sc = Qs + 1024;
    const float sink_pre = sinks_l[4 * g + ((tid >> 5) & 3)];
    bf16_t gate_pre[4];
    {
        const int lane_ = tid & 63, w_ = tid >> 6, d_ = 16 * (w_ & 3) + (lane_ & 15);
        const bf16_t* gp_ = P + (size_t)(MP + 4 * n + (lane_ >> 4)) * NIN + 768 + 64 * 4 * g + d_;
#pragma unroll
        for (int r = 0; r < 4; ++r) gate_pre[r] = gp_[64 * r];
    }
#pragma unroll
    for (int i = 0; i < 4; ++i) {
        const int ch = tid + 512 * i, wp = ch >> 4, c4 = ch & 15;
        const size_t src = (size_t)((n * 128 + wp) * 2 + g) * 64 + 4 * c4;
        const f32x4 kv = __builtin_nontemporal_load((const f32x4*)(ck + src)), vv = __builtin_nontemporal_load((const f32x4*)(cv + src));
        *(LAS f32x4*)(Kc + wp * 68 + 4 * c4) = kv; *(LAS f32x4*)(Vc + wp * 68 + 4 * c4) = vv;
        if (wp >= 4) { const size_t dst = (size_t)((n * 128 + wp - 4) * 2 + g) * 64 + 4 * c4; __builtin_nontemporal_store(kv, (f32x4*)(kso + dst)); __builtin_nontemporal_store(vv, (f32x4*)(vso + dst)); }
    }
    if (tid < 64) {
        const int t = tid >> 4, c4 = tid & 15;
        const size_t src = (size_t)((n * 128 + 124 + t) * 2 + g) * 64 + 4 * c4;
        *(LAS f32x4*)(Kc + (128 + t) * 68 + 4 * c4) = *(const f32x4*)(kso + src); *(LAS f32x4*)(Vc + (128 + t) * 68 + 4 * c4) = *(const f32x4*)(vso + src);
    }
    const int qi = tid >> 5, ln = tid & 31;
    const int head = 4 * g + (qi & 3), row = MP + 4 * n + (qi >> 2);
    { const unsigned u = *(const unsigned*)(P + (size_t)row * NIN + 64 * head + 2 * ln); Qs[qi * 64 + 2 * ln] = bflo(u); Qs[qi * 64 + 2 * ln + 1] = bfhi(u); }
    __syncthreads();
    const int lane = tid & 63, w = tid >> 6, fr = lane & 15, fq = lane >> 4;
#pragma unroll 1
    for (int kt = w; kt < 9; kt += 8) {
        f32x4 z = (f32x4){0.f, 0.f, 0.f, 0.f};
#pragma unroll
        for (int st = 0; st < 16; ++st) z = __builtin_amdgcn_mfma_f32_16x16x4f32(Qs[fr * 64 + 4 * st + fq], Kc[(16 * kt + fr) * 68 + 4 * st + fq], z, 0, 0, 0);
        const int k = 16 * kt + fr;
        if (k < 132) {
            const bool valid = (k >= fq + 1) && (k <= fq + 128);
#pragma unroll
            for (int r = 0; r < 4; ++r) Sc[(4 * fq + r) * 136 + k] = valid ? z[r] : -INFINITY;
        }
    }
    __syncthreads();
    const float sink2 = sink_pre * LOG2E;
    float mx = -INFINITY;
    for (int k = ln; k < 132; k += 32) mx = fmaxf(mx, Sc[qi * 136 + k]);
#pragma unroll
    for (int o = 1; o < 32; o <<= 1) mx = fmaxf(mx, shx(mx, o, tid));
    mx = fmaxf(mx, sink2);
    float sum = 0.f;
    for (int k = ln; k < 132; k += 32) { const float p = ex2(Sc[qi * 136 + k] - mx); Sc[qi * 136 + k] = p; sum += p; }
#pragma unroll
    for (int o = 1; o < 32; o <<= 1) sum += shx(sum, o, tid);
    if (ln == 0) Sc[qi * 136 + 132] = 1.0f / (sum + ex2(sink2 - mx));
    __syncthreads();
    if (w < 4) {
        f32x4 o = (f32x4){0.f, 0.f, 0.f, 0.f};
#pragma unroll 11
        for (int st = 0; st < 33; ++st) o = __builtin_amdgcn_mfma_f32_16x16x4f32(Sc[fr * 136 + 4 * st + fq], Vc[(4 * st + fq) * 68 + 16 * w + fr], o, 0, 0, 0);
        const int d = 16 * w + fr, orow = MP + 4 * n + fq;
#pragma unroll
        for (int r = 0; r < 4; ++r) {
            const int hd = 4 * g + r;
            const float gate = bf2f(gate_pre[r]);
            MIX[(size_t)orow * DM + 64 * hd + d] = (bf16_t)(pk(o[r] * Sc[(4 * fq + r) * 136 + 132] * gate, 0.f) & 0xffffu);
        }
    }
    __syncthreads();
}

struct SretRegs { f32x4 s4[8]; float gate; unsigned qkv; unsigned vv; };
__device__ __forceinline__ void sret_load(SretRegs& R, const bf16_t* P, const float* Sin, int unit, int tid) {
    const int n = unit >> 2, h = unit & 3;
    const int v4 = tid & 31, dg = tid >> 5;
    const float* Sb = Sin + (size_t)unit * 16384;
    const int t = tid >> 7, d = tid & 127;
    const bf16_t* pr = P + (size_t)(MP + 4 * n + t) * NIN + 128 * h + d;
    R.qkv = (unsigned)pr[1280] | ((unsigned)pr[1792] << 16); R.vv = (unsigned)pr[2304];
    R.gate = bf2f(pr[2816]);
#pragma unroll
    for (int i = 0; i < 8; ++i) R.s4[i] = __builtin_nontemporal_load((const f32x4*)(Sb + (8 * dg + i) * 128 + 4 * v4));
}
__device__ __forceinline__ void sret_compute(LAS unsigned char* lds, const SretRegs& R, bf16_t* MIX, float* Sout, int unit, int tid) {
    const int n = unit >> 2, h = unit & 3;
    const float l2g = l2gamma(h);
    LAS float* qs = (LAS float*)lds;
    LAS float* ks_ = qs + 512;
    LAS float* vs_ = qs + 1024;
    LAS float* qk = qs + 1536;
    LAS float* red = qs + 1552;
    LAS float* part = qs + 2048;
    const int v4 = tid & 31, dg = tid >> 5;
    float* So = Sout + (size_t)unit * 16384;
    qs[tid] = bflo(R.qkv); ks_[tid] = bfhi(R.qkv); vs_[tid] = bflo(R.vv);
    __syncthreads();
    f32x4 vj[4], cr[4];
#pragma unroll
    for (int j = 0; j < 4; ++j) { vj[j] = *(const LAS f32x4*)(vs_ + j * 128 + 4 * v4); cr[j] = (f32x4){0.f, 0.f, 0.f, 0.f}; }
    const float g1 = ex2(l2g), g2 = g1 * g1, g3 = g2 * g1, g4 = g2 * g2;
#pragma unroll
    for (int i = 0; i < 8; ++i) {
        const int d = 8 * dg + i;
#pragma unroll
        for (int t = 0; t < 4; ++t) cr[t] += R.s4[i] * qs[t * 128 + d];
        f32x4 sn = R.s4[i] * g4;
        sn += vj[0] * (g3 * ks_[0 * 128 + d]); sn += vj[1] * (g2 * ks_[1 * 128 + d]); sn += vj[2] * (g1 * ks_[2 * 128 + d]); sn += vj[3] * ks_[3 * 128 + d];
        __builtin_nontemporal_store(sn, (f32x4*)(So + d * 128 + 4 * v4));
    }
#pragma unroll
    for (int t = 0; t < 4; ++t) *(LAS f32x4*)(part + (dg * 4 + t) * 128 + 4 * v4) = cr[t];
    {
        const int t = dg >> 2, j = dg & 3; float p = 0.f;
#pragma unroll
        for (int d = v4; d < 128; d += 32) p += qs[t * 128 + d] * ks_[j * 128 + d];
#pragma unroll
        for (int o = 1; o < 32; o <<= 1) p += shx(p, o, tid);
        if (v4 == 0) qk[dg] = p;
    }
    __syncthreads();
    const int t = tid >> 7, v = tid & 127;
    float cross = 0.f;
#pragma unroll
    for (int d2 = 0; d2 < 16; ++d2) cross += part[(d2 * 4 + t) * 128 + v];
    float o = cross * ex2((float)(t + 1) * l2g);
#pragma unroll
    for (int j = 0; j < 4; ++j) if (j <= t) o += qk[t * 4 + j] * ex2((float)(t - j) * l2g) * vs_[j * 128 + v];
    float ss = o * o;
#pragma unroll
    for (int of = 1; of < 64; of <<= 1) ss += shx(ss, of, tid);
    if ((tid & 63) == 0) red[tid >> 6] = ss;
    __syncthreads();
    const float rn = rsqrtf((red[2 * t] + red[2 * t + 1]) * (1.0f / 128.0f) + 1e-6f);
    const int row = MP + 4 * n + t;
    MIX[(size_t)row * DM + 512 + 128 * h + v] = (bf16_t)(pk(o * rn * R.gate, 0.f) & 0xffffu);
    __syncthreads();
}

__device__ __forceinline__ void sample_outproj_slice(LAS unsigned char* lds, const bf16_t* MIX, const bf16_t* Wt, const float* xs_f32, const bf16_t* XBi, bf16_t* XBn, float* yout, unsigned* rowss_next, int b, int tid) {
    const int lane = tid & 63, w = tid >> 6, fr = lane & 15, fq = lane >> 4;
    const int r0 = MP + 32 * (b >> 4), c0 = 64 * (b & 15), k0 = 128 * w;
    f32x4 res;
    {
        const int mt = w >> 1, nt = w & 1;
        const int col = c0 + 32 * (mt >> 1) + 8 * fq + 4 * (mt & 1), row = r0 + 16 * nt + fr;
        if (xs_f32) res = *(const f32x4*)(xs_f32 + (size_t)(row - MP) * DM + col);
        else { const u32x2 u = *(const u32x2*)(XBi + (size_t)row * DM + col); res = (f32x4){bflo(u.x), bfhi(u.x), bflo(u.y), bfhi(u.y)}; }
    }
    bf16x8 af[4][4], bfr[2][4];
#pragma unroll
    for (int mt = 0; mt < 4; ++mt)
#pragma unroll
        for (int ks = 0; ks < 4; ++ks) af[mt][ks] = *(const bf16x8*)(Wt + (size_t)(c0 + 16 * mt + fr) * DM + k0 + 32 * ks + 8 * fq);
#pragma unroll
    for (int nt = 0; nt < 2; ++nt)
#pragma unroll
        for (int ks = 0; ks < 4; ++ks) bfr[nt][ks] = *(const bf16x8*)(MIX + (size_t)(r0 + 16 * nt + fr) * DM + k0 + 32 * ks + 8 * fq);
    f32x4 acc[4][2];
#pragma unroll
    for (int mt = 0; mt < 4; ++mt)
#pragma unroll
        for (int nt = 0; nt < 2; ++nt) { f32x4 z = (f32x4){0.f, 0.f, 0.f, 0.f};
#pragma unroll
            for (int ks = 0; ks < 4; ++ks) z = __builtin_amdgcn_mfma_f32_16x16x32_bf16(af[mt][ks], bfr[nt][ks], z, 0, 0, 0);
            acc[mt][nt] = z; }
    LAS f32x4* red = (LAS f32x4*)lds;
#pragma unroll
    for (int mt = 0; mt < 4; ++mt)
#pragma unroll
        for (int nt = 0; nt < 2; ++nt) red[(w * 8 + mt * 2 + nt) * 64 + lane] = acc[mt][nt];
    __syncthreads();
    const int mt = w >> 1, nt = w & 1;
    f32x4 v = (f32x4){0.f, 0.f, 0.f, 0.f};
#pragma unroll
    for (int ww = 0; ww < 8; ++ww) v += red[(ww * 8 + w) * 64 + lane];
    const int col = c0 + 32 * (mt >> 1) + 8 * fq + 4 * (mt & 1);
    const int row = r0 + 16 * nt + fr;
    v += res;
    if (yout) *(f32x4*)(yout + (size_t)row * DM + col) = v;
    else {
        u32x2 o; o.x = pk(v[0], v[1]); o.y = pk(v[2], v[3]);
        *(u32x2*)(XBn + (size_t)row * DM + col) = o;
        float ss = (v[0] * v[0] + v[1] * v[1]) + (v[2] * v[2] + v[3] * v[3]);
        ss += shx(ss, 16, lane); ss += shx(ss, 32, lane);
        if (fq == 0) atomicAdd(rowss_next + row, (unsigned)(ss * 65536.0f + 0.5f));
    }
    __syncthreads();
}

__device__ __forceinline__ void scan_phase(const float* UT, bf16_t* SPT, float* sp_out_l, int tid, int G) {
    for (int gid = blockIdx.x * 512 + tid; gid < 2 * 4 * 16384; gid += G * 512) {
        const int n = gid >> 16, h = (gid >> 14) & 3, e = gid & 16383;
        const float gd = ex2(128.0f * l2gamma(h));
        const size_t base = ((size_t)(n * 64) * 4 + h) * 16384 + e;
        float S = 0.f;
        for (int c0 = 0; c0 < 64; c0 += 32) {
            float uu[32];
#pragma unroll
            for (int k = 0; k < 32; ++k) uu[k] = __builtin_nontemporal_load(UT + base + (size_t)(c0 + k) * 65536);
#pragma unroll
            for (int k = 0; k < 32; ++k) { SPT[base + (size_t)(c0 + k) * 65536] = (bf16_t)(pk(S, 0.f) & 0xffffu); S = gd * S + uu[k]; }
        }
        const int dv = e >> 7, dk = e & 127;
        sp_out_l[(size_t)(n * 4 + h) * 16384 + dk * 128 + dv] = S;
    }
}

__device__ __forceinline__ void ret_unit(LAS unsigned char* lds, const bf16_t* P, const bf16_t* SPT, bf16_t* MIX, int unit, int tid) {
    const int h = unit & 3, c = (unit >> 2) & 63, n = unit >> 8;
    const int R0 = n * SEQ + c * 128;
    const float l2g = l2gamma(h);
    LAS bf16_t* Ks = (LAS bf16_t*)lds;
    LAS bf16_t* Vt = (LAS bf16_t*)(lds + 128 * 272);
    LAS bf16_t* Ss = (LAS bf16_t*)(lds + 256 * 272);
    const int lane = tid & 63, w = __builtin_amdgcn_readfirstlane(tid >> 6), fr = lane & 15, fq = lane >> 4;
    const int qi = 16 * w + fr, row = R0 + qi;
    bf16x8 bq[4];
#pragma unroll
    for (int ks = 0; ks < 4; ++ks) bq[ks] = *(const bf16x8*)(P + (size_t)row * NIN + 1280 + 128 * h + 32 * ks + 8 * fq);
    u32x2 gts[8];
#pragma unroll
    for (int dt = 0; dt < 8; ++dt) gts[dt] = *(const u32x2*)(P + (size_t)row * NIN + 2816 + 128 * h + 16 * dt + 4 * fq);
#pragma unroll
    for (int i = 0; i < 4; ++i) {
        const int ch = tid + 512 * i, j = ch >> 4, c8 = ch & 15;
        const u32x4 kv = *(const u32x4*)(P + (size_t)(R0 + j) * NIN + 1792 + 128 * h + 8 * c8);
        const u32x4 sv = __builtin_nontemporal_load((const u32x4*)(SPT + (size_t)unit * 16384 + j * 128 + 8 * c8));
        *(LAS u32x4*)(Ks + j * 136 + 8 * c8) = kv;
        *(LAS u32x4*)(Ss + j * 136 + 8 * c8) = sv;
    }
    {
        u32x4 vv[4];
#pragma unroll
        for (int i = 0; i < 4; ++i) vv[i] = *(const u32x4*)(P + (size_t)(R0 + (tid >> 4) + 32 * i) * NIN + 2304 + 128 * h + 8 * (tid & 15));
#pragma unroll
        for (int i = 0; i < 4; ++i) tr_write_sw(Vt, 136, tid & 15, 15, (tid >> 4) + 32 * i, vv[i], 16, tid);
    }
    __syncthreads();
    f32x4 o[8];
#pragma unroll
    for (int dt = 0; dt < 8; ++dt) {
        f32x4 z = (f32x4){0.f, 0.f, 0.f, 0.f};
#pragma unroll
        for (int ks = 0; ks < 4; ++ks) z = __builtin_amdgcn_mfma_f32_16x16x32_bf16(*(const LAS bf16x8*)(Ss + (16 * dt + fr) * 136 + 32 * ks + 8 * fq), bq[ks], z, 0, 0, 0);
        o[dt] = z * ex2((float)(qi + 1) * l2g);
    }
    f32x4 sc[8];
#pragma unroll
    for (int jt = 0; jt < 8; ++jt) {
        f32x4 z = (f32x4){0.f, 0.f, 0.f, 0.f};
        if (jt <= w) {
#pragma unroll
            for (int ks = 0; ks < 4; ++ks) z = __builtin_amdgcn_mfma_f32_16x16x32_bf16(*(const LAS bf16x8*)(Ks + (16 * jt + fr) * 136 + 32 * ks + 8 * fq), bq[ks], z, 0, 0, 0);
#pragma unroll
            for (int r = 0; r < 4; ++r) { const int j = 16 * jt + 4 * fq + r; z[r] = (qi >= j) ? z[r] * ex2((float)(qi - j) * l2g) : 0.f; }
        }
        sc[jt] = z;
    }
#pragma unroll
    for (int k2 = 0; k2 < 4; ++k2) {
        if (2 * k2 <= w) {
            u32x4 pw; pw.x = pk(sc[2 * k2][0], sc[2 * k2][1]); pw.y = pk(sc[2 * k2][2], sc[2 * k2][3]); pw.z = pk(sc[2 * k2 + 1][0], sc[2 * k2 + 1][1]); pw.w = pk(sc[2 * k2 + 1][2], sc[2 * k2 + 1][3]);
            const bf16x8 pb = __builtin_bit_cast(bf16x8, pw);
#pragma unroll
            for (int dt = 0; dt < 8; ++dt) {
                const u32x2 lo = *(const LAS u32x2*)(Vt + sw_off(16 * dt + fr, 136, 15, 32 * k2 + 4 * fq)), hi = *(const LAS u32x2*)(Vt + sw_off(16 * dt + fr, 136, 15, 32 * k2 + 16 + 4 * fq));
                const u32x4 aw = (u32x4){lo.x, lo.y, hi.x, hi.y};
                o[dt] = __builtin_amdgcn_mfma_f32_16x16x32_bf16(__builtin_bit_cast(bf16x8, aw), pb, o[dt], 0, 0, 0);
            }
        }
    }
    float ss = 0.f;
#pragma unroll
    for (int dt = 0; dt < 8; ++dt) ss += (o[dt][0] * o[dt][0] + o[dt][1] * o[dt][1]) + (o[dt][2] * o[dt][2] + o[dt][3] * o[dt][3]);
    ss += shx(ss, 16, lane); ss += shx(ss, 32, lane);
    const float rn = rsqrtf(ss * (1.0f / 128.0f) + 1e-6f);
#pragma unroll
    for (int dt = 0; dt < 8; ++dt) {
        const u32x2 gt = gts[dt];
        u32x2 wv; wv.x = pk(o[dt][0] * rn * bflo(gt.x), o[dt][1] * rn * bfhi(gt.x)); wv.y = pk(o[dt][2] * rn * bflo(gt.y), o[dt][3] * rn * bfhi(gt.y));
        *(u32x2*)(MIX + (size_t)row * DM + 512 + 128 * h + 16 * dt + 4 * fq) = wv;
    }
    __syncthreads();
}


#define XB_TMO      128
#define XB_XCNT(j)  (256  + 64 * (j))
#define XB_XSUB(j)  (1280 + 64 * (j))
#define XB_XGEN(j)  (2304 + 64 * (j))
#define XB_TOP      3328
#define XB_TOPGEN   3392
#define XCD_BAR_WORDS 3456
#define XB_SPIN_CAP (1u << 22)
__device__ __forceinline__ unsigned xb_ld(unsigned* p)              { return __hip_atomic_load(p, __ATOMIC_RELAXED, __HIP_MEMORY_SCOPE_AGENT); }
__device__ __forceinline__ unsigned xb_add(unsigned* p, unsigned v) { return __hip_atomic_fetch_add(p, v, __ATOMIC_RELAXED, __HIP_MEMORY_SCOPE_AGENT); }
__device__ __forceinline__ unsigned xb_xcc_id() { return (unsigned)__builtin_amdgcn_s_getreg((3 << 11) | 20) & 0xFu; }
#define XB_SPIN(cond, bar) do { unsigned _sp = 0; while (cond) { __builtin_amdgcn_s_sleep(1); \
    if ((++_sp & 255u) == 0u) { if (xb_ld(&(bar)[XB_TMO])) break; if (_sp > XB_SPIN_CAP) { atomicAdd(&(bar)[XB_TMO], 1u); break; } } } } while (0)
struct XcdBarrier { unsigned* bar; unsigned x; volatile LAS unsigned* st; };
__device__ __forceinline__ XcdBarrier xcd_barrier_post(unsigned* bar, volatile LAS unsigned* st) {
    XcdBarrier b; b.bar = bar; b.x = xb_xcc_id(); b.st = st;
    if (threadIdx.x == 0) (void)xb_add(&bar[XB_XCNT(b.x)], 1u);
    return b;
}
__device__ __forceinline__ void xcd_barrier_complete(unsigned* bar, unsigned x, unsigned& nloc, unsigned& nx) {
    const unsigned G = gridDim.x * gridDim.y * gridDim.z;
    unsigned sum, cnt, mine, sp = 0u;
    for (;;) {
        sum = 0u; cnt = 0u; mine = 0u;
#pragma unroll
        for (unsigned j = 0; j < 16; ++j) { const unsigned c = xb_ld(&bar[XB_XCNT(j)]); sum += c; cnt += (c > 0u) ? 1u : 0u; mine = (j == x) ? c : mine; }
        if (sum == G) break;
        __builtin_amdgcn_s_sleep(1);
        if ((++sp & 255u) == 0u) { if (xb_ld(&bar[XB_TMO])) break; if (sp > XB_SPIN_CAP) { atomicAdd(&bar[XB_TMO], 1u); break; } }
    }
    nloc = mine > 0u ? mine : 1u; nx = cnt > 0u ? cnt : 1u;
}
__device__ __forceinline__ void xcd_barrier(const XcdBarrier& b0) {
    XcdBarrier b = b0;
    asm volatile("" : "+s"(b.x));
    asm volatile("s_waitcnt vmcnt(0)" ::: "memory");
    __syncthreads();
    if (threadIdx.x == 0) {
        unsigned* bar = b.bar;
        asm volatile("" : "+s"(bar));
        __builtin_amdgcn_s_waitcnt(0);
        unsigned nloc = b.st[0], nx = b.st[1];
        if (nloc == 0u) { xcd_barrier_complete(bar, b.x, nloc, nx); b.st[0] = nloc; b.st[1] = nx; }
        const unsigned old = xb_add(&bar[XB_XSUB(b.x)], 1u);
        const unsigned gen = old / nloc;
        if (old + 1u == (gen + 1u) * nloc) {
            __builtin_amdgcn_fence(__ATOMIC_RELEASE, "agent");
            asm volatile("s_waitcnt vmcnt(0)" ::: "memory");
            const unsigned og = xb_add(&bar[XB_TOP], 1u);
            const unsigned tg = og / nx;
            if (og + 1u == (tg + 1u) * nx) xb_add(&bar[XB_TOPGEN], 1u);
            else XB_SPIN(xb_ld(&bar[XB_TOPGEN]) == tg, bar);
            __builtin_amdgcn_fence(__ATOMIC_ACQUIRE, "agent");
            xb_add(&bar[XB_XGEN(b.x)], 1u);
            asm volatile("s_waitcnt vmcnt(0)" ::: "memory");
        } else {
            XB_SPIN(xb_ld(&bar[XB_XGEN(b.x)]) == gen, bar);
            __builtin_amdgcn_fence(__ATOMIC_ACQUIRE, "agent");
            asm volatile("s_waitcnt vmcnt(0)" ::: "memory");
        }
    }
    __syncthreads();
}
constexpr int MISC_OFF = 131072 + 320;
__device__ __forceinline__ int launder_tid() { int t = threadIdx.x; asm volatile("" : "+v"(t)); return t; }
__global__ void __launch_bounds__(512, 2) hymba_fwd(Args a) {
    extern __shared__ __attribute__((aligned(16))) unsigned char lds_raw[];
    LAS unsigned char* lds = (LAS unsigned char*)lds_raw;
    const int tid = threadIdx.x, G = gridDim.x;
    unsigned char* ws = a.ws;
    float* out = a.out;
    bf16_t* P = (bf16_t*)(ws + WS_P); bf16_t* MIX = (bf16_t*)(ws + WS_MIX);
    float* UT = (float*)(ws + WS_UT); bf16_t* SPT = (bf16_t*)(ws + WS_SPT);
    unsigned* rowss = (unsigned*)(ws + WS_ROWSS);
    const float* tabB = (const float*)(ws + WS_TABB); const float* tabA = (const float*)(ws + WS_TABA);
    const int lo = a.ph_lo, hi = a.ph_hi;
    volatile LAS unsigned* MISC = (volatile LAS unsigned*)(lds + MISC_OFF);
    if (tid < 32) MISC[tid] = 0u;
    __syncthreads();
    XcdBarrier bar = xcd_barrier_post((unsigned*)ws, MISC + 8);
    if (a.ph_lo < 0) cg::this_grid().sync();
#if MK_MULTI
#define IN(k) (lo <= (k) && (k) < hi)
#else
#define IN(k) true
#endif
#define LT() launder_tid()
#define SEAM(k) do { if (IN(k) && IN((k) + 1)) { xcd_barrier(bar); } } while (0)
#ifndef SKIP_P0
    if (IN(0)) for (int rep = 0; rep < REP_P0; ++rep) { p0_prologue(a, lds, tid, G); if (rep + 1 < REP_P0) xcd_barrier(bar); }
#endif
    SEAM(0);
    for (int l = 0; l < DEPTH; ++l) {
        const int pb = 1 + 5 * l;
        const float* sinks_l = a.in[10] + 8 * l;
        bf16_t* XB = (bf16_t*)(ws + ((l & 1) ? WS_XB2 : WS_XB)); bf16_t* XBn = (bf16_t*)(ws + ((l & 1) ? WS_XB : WS_XB2));
#ifndef SKIP_P1
        if (IN(pb)) for (int rep = 0; rep < REP_P1; ++rep) {
            const int b = (int)blockIdx.x;
            unsigned* cnt = (unsigned*)(ws + 14336) + 64 * l;
            pg8::Gemm g{XB, (const bf16_t*)(ws + WS_WIN) + (size_t)l * NIN * DM, MT, NIN, DM};
            EpiIn E{P, rowss + l * MT, a.in[8] + 64 * l, a.in[9] + 64 * l, tabA, tabB,
                    out + O_KP + (size_t)l * 32768, out + O_VP + (size_t)l * 32768, out + O_KS + (size_t)l * 2097152, out + O_VS + (size_t)l * 2097152};
            {
                SampleFirstOrder S; S.S.init(MP, NIN, G, b); S.cnt = cnt;
                const bool hs = (b >= 64 && b < 90);
                S.spm = hs ? 64 + (b - 64) / 13 : -1; S.spn = hs ? (b - 64) % 13 : 0;
                pg8::gemm_phase<EpiIn, SampleFirstOrder, true, true>(lds, g, S, E, LT());
            }
            if (b >= 90) {
                if (threadIdx.x == 0) {
                    XB_SPIN(xb_ld(cnt) < 26u * (unsigned)(rep + 1), (unsigned*)ws);
                    __builtin_amdgcn_fence(__ATOMIC_ACQUIRE, "agent"); asm volatile("s_waitcnt vmcnt(0)" ::: "memory");
                }
                __syncthreads();
                const float* ck = a.in[2] + (size_t)l * 2097152; const float* cv = a.in[3] + (size_t)l * 2097152;
                float* kso = out + O_KS + (size_t)l * 2097152; float* vso = out + O_VS + (size_t)l * 2097152;
                const float* sin_l = a.in[4] + (size_t)l * 8388608; float* sout_l = out + O_SS + (size_t)l * 8388608;
                {
                    const int stride = G - 90;
                    int u = b - 90;
                    if (u < 512) {
                        SretRegs cur; sret_load(cur, P, sin_l, u, LT());
#pragma unroll 1
                        for (; u < 512; u += stride) {
                            const int nx = u + stride;
                            SretRegs nxt = cur;
                            if (nx < 512) sret_load(nxt, P, sin_l, nx, LT());
                            sret_compute(lds, cur, MIX, sout_l, u, LT());
                            cur = nxt;
                        }
                    }
#pragma unroll 1
                    for (; u < 768; u += stride) sattn_unit(lds, P, MIX, ck, cv, kso, vso, sinks_l, u - 512, LT());
                }
            }
        }
#endif
        SEAM(pb);
#ifndef SKIP_P2
        if (IN(pb + 1)) for (int rep = 0; rep < REP_P2; ++rep) {
            const int b = (int)blockIdx.x;
            UcRegs u1, u2; AttnRegs ar;
            uc_load(u1, P, b, LT());
            uc_load(u2, P, b + 256, LT());
            uc_compute(lds, u1, UT, b, LT());
            attn_load(ar, P, b, LT());
            uc_compute(lds, u2, UT, b + 256, LT());
            attn_compute(lds, ar, P, MIX, sinks_l, b, LT());
        }
#endif
        SEAM(pb + 1);
#ifndef SKIP_SCAN
        if (IN(pb + 2)) for (int rep = 0; rep < REP_P3; ++rep) {
            const bool lastl = (l == DEPTH - 1);
            sample_outproj_slice(lds, MIX, (const bf16_t*)(ws + WS_WOUT) + (size_t)l * DM * DM, l == 0 ? a.in[1] : nullptr, XB, XBn, lastl ? out : nullptr,
                                 lastl ? nullptr : (rep == 0 ? rowss + (l + 1) * MT : (unsigned*)(ws + WS_DUMMY)), (int)blockIdx.x, LT());
            scan_phase(UT, SPT, out + O_SP + (size_t)l * 131072, LT(), G);
        }
#endif
        SEAM(pb + 2);
#ifndef SKIP_RET
        if (IN(pb + 3)) for (int rep = 0; rep < REP_P4; ++rep) { for (int u = blockIdx.x; u < 512; u += G) ret_unit(lds, P, SPT, MIX, u, LT()); }
#endif
        SEAM(pb + 3);
#ifndef SKIP_P5
        if (IN(pb + 4)) for (int rep = 0; rep < REP_P5; ++rep) {
            pg8::Gemm g{MIX, (const bf16_t*)(ws + WS_WOUT) + (size_t)l * DM * DM, MP, DM, DM};
            pg8::StaticOrder S; S.init(MP, DM, G, (int)blockIdx.x);
            const bool lastl = (l == DEPTH - 1);
            EpiOut E{l == 0 ? a.in[0] : nullptr, l == 0 ? a.in[1] : nullptr, lastl ? out : nullptr, XB, XBn, lastl ? nullptr : (rep == 0 ? rowss + (l + 1) * MT : (unsigned*)(ws + WS_DUMMY))};
            pg8::gemm_phase<EpiOut, pg8::StaticOrder, true, true>(lds, g, S, E, LT());
        }
#endif
        SEAM(pb + 4);
    }
#undef IN
#undef SEAM
}

extern "C" void kernel_launch(void* const* d_in, const int* in_sizes, int n_in, void* d_out, int out_size, void* d_ws, size_t ws_size, hipStream_t stream) {
    static int grid = 0;
    if (grid == 0) {
        int dev = 0, cus = 0, per_cu = 0;
        if (n_in != 11 || ws_size < WS_END) { fprintf(stderr, "kernel_launch: unexpected n_in %d / ws %zu\n", n_in, ws_size); grid = -1; return; }
        if (hipGetDevice(&dev) != hipSuccess || hipDeviceGetAttribute(&cus, hipDeviceAttributeMultiprocessorCount, dev) != hipSuccess) { grid = -1; return; }
        if (hipFuncSetAttribute((const void*)hymba_fwd, hipFuncAttributeMaxDynamicSharedMemorySize, LDS_BYTES) != hipSuccess) { fprintf(stderr, "kernel_launch: hipFuncSetAttribute failed\n"); grid = -1; return; }
        if (hipOccupancyMaxActiveBlocksPerMultiprocessor(&per_cu, (const void*)hymba_fwd, 512, LDS_BYTES) != hipSuccess || per_cu < 1) { fprintf(stderr, "kernel_launch: occupancy query says %d\n", per_cu); per_cu = 1; }
        (void)hipGetLastError();
        if (cus < 256) { fprintf(stderr, "kernel_launch: needs 256 CUs, got %d\n", cus); grid = -1; return; }
        grid = 256;
    }
    if (grid < 0) return;
    if (hipMemsetAsync(d_ws, 0, 16384, stream) != hipSuccess) { fprintf(stderr, "kernel_launch: memset failed\n"); return; }
    Args a{};
    for (int i = 0; i < 11; ++i) a.in[i] = (const float*)d_in[i];
    a.out = (float*)d_out; a.ws = (unsigned char*)d_ws;
    a.baseA = std::pow(500000.0, -1.0 / 8.0); a.baseB = std::pow(10000.0, -1.0 / 64.0);
    constexpr int NPH = 1 + 5 * DEPTH;
#if MK_MULTI
    for (int p = 0; p < NPH; ++p) { a.ph_lo = p; a.ph_hi = p + 1; hipLaunchKernelGGL(hymba_fwd, dim3(grid), dim3(512), LDS_BYTES, stream, a); }
#else
    a.ph_lo = 0; a.ph_hi = NPH;
    void* args[] = {&a};
    hipError_t e = hipLaunchCooperativeKernel((const void*)hymba_fwd, dim3(grid), dim3(512), args, LDS_BYTES, stream);
    if (e != hipSuccess) fprintf(stderr, "cooperative launch failed: %s (grid %d)\n", hipGetErrorString(e), grid);
#endif
}
```

```cpp
#include <hip/hip_runtime.h>
#include <hip/hip_cooperative_groups.h>
#include <cstdio>
#include <cstdint>
#include <cmath>
namespace cg = cooperative_groups;

#ifndef MK_MULTI
#define MK_MULTI 0
#endif

#ifndef REP_P0
#define REP_P0 1
#endif
#ifndef REP_P1
#define REP_P1 1
#endif
#ifndef REP_P2
#define REP_P2 1
#endif
#ifndef REP_P3
#define REP_P3 1
#endif
#ifndef REP_P4
#define REP_P4 1
#endif
#ifndef REP_P5
#define REP_P5 1
#endif
#define LAS __attribute__((address_space(3)))
typedef unsigned short bf16_t;
typedef short bf16x8 __attribute__((ext_vector_type(8)));
typedef float f32x4 __attribute__((ext_vector_type(4)));
typedef float f32x2 __attribute__((ext_vector_type(2)));
typedef unsigned u32x4 __attribute__((ext_vector_type(4)));
typedef unsigned u32x2 __attribute__((ext_vector_type(2)));

constexpr int DM = 1024, SEQ = 8192, NBATCH = 2, MP = NBATCH * SEQ, MS = 512, MT = MP + MS, NIN = 3328, DEPTH = 4;
constexpr int NPOS = 8196;
constexpr float LOG2E = 1.4426950408889634f;
constexpr size_t O_Y = 0, O_KP = 17301504, O_VP = 17432576, O_SP = 17563648, O_KS = 18087936, O_VS = 26476544, O_SS = 34865152;
constexpr size_t MiB = 1u << 20;
constexpr size_t WS_ROWSS = 1 * MiB, WS_TABB = 2 * MiB, WS_TABA = 7 * MiB, WS_WIN = 8 * MiB, WS_WOUT = 36 * MiB, WS_XB = 44 * MiB, WS_MIX = 80 * MiB,
                 WS_P = 116 * MiB, WS_UT = 224 * MiB, WS_SPT = 256 * MiB, WS_XB2 = 272 * MiB, WS_DUMMY = 308 * MiB, WS_END = 312 * MiB;
constexpr int LDS_BYTES = 147456;

__device__ __forceinline__ unsigned pk(float lo, float hi) { unsigned r; asm("v_cvt_pk_bf16_f32 %0, %1, %2" : "=v"(r) : "v"(lo), "v"(hi)); return r; }
__device__ __forceinline__ float bflo(unsigned u) { return __uint_as_float(u << 16); }
__device__ __forceinline__ float bfhi(unsigned u) { return __uint_as_float(u & 0xffff0000u); }
__device__ __forceinline__ float bf2f(bf16_t h) { return __uint_as_float((unsigned)h << 16); }
__device__ __forceinline__ float ex2(float x) { return __builtin_amdgcn_exp2f(x); }
__device__ __forceinline__ float shx(float v, int m, int lane) { return __builtin_bit_cast(float, __builtin_amdgcn_ds_bpermute(((lane ^ m) & 63) << 2, __builtin_bit_cast(int, v))); }
__device__ __forceinline__ int shxi(int v, int m, int lane) { return __builtin_amdgcn_ds_bpermute(((lane ^ m) & 63) << 2, v); }
__device__ __forceinline__ float l2gamma(int h) { const int hb = __builtin_amdgcn_readfirstlane(h); const unsigned b = hb == 0 ? 0xbd3b9ca6u : hb == 1 ? 0xbcba1f74u : hb == 2 ? 0xbc3963ddu : 0xbbb906ceu; return __builtin_bit_cast(float, b); }

namespace pg8 {
constexpr int BM = 256, BK = 64, HALF = 128, HTB = HALF * BK * 2, STAGE_BYTES = 8 * HTB, NXCD = 8, WGM = 8;
__host__ __device__ __forceinline__ int lds_byte(int r, int c) { const int st = (r >> 4) * 2 + (c >> 5), rr = r & 15, cc = c & 31, ob = rr * 64 + cc * 2; return st * 1024 + (ob ^ (((ob >> 9) & 1) << 5)); }
__host__ __device__ __forceinline__ void stage_rc(int b, int& R, int& C) { const int st = b / 1024, sb = b % 1024, swz = sb ^ (((sb >> 9) & 1) << 5); R = (st >> 1) * 16 + swz / 64; C = (st & 1) * 32 + (swz % 64) / 2; }
struct Unit { int pm, pn; };
struct Gemm { const bf16_t* A; const bf16_t* Bt; int M, N, K; };
struct StaticOrder {
    int nM, nN, nwg, G, c;
    __host__ __device__ void init(int M, int N, int G_, int c_) { nM = M / BM; nN = N / BM; nwg = nM * nN; G = G_; c = c_; }
    __host__ __device__ bool next(int i, Unit& u) const {
        const long L = (long)i * G + c; if (L >= nwg) return false;
        int wgid = (int)L; { const int q = nwg / NXCD, r = nwg % NXCD, xcd = wgid % NXCD, off = wgid / NXCD; wgid = (xcd < r ? xcd * (q + 1) : r * (q + 1) + (xcd - r) * q) + off; }
        const int nig = WGM * nN, gid = wgid / nig, fm = gid * WGM, gsz = (nM - fm) < WGM ? (nM - fm) : WGM;
        u.pm = fm + ((wgid % nig) % gsz); u.pn = (wgid % nig) / gsz; return true;
    }
    __device__ __forceinline__ void a_ready(const Unit&) const {}
    __device__ __forceinline__ void done(const Unit&) const {}
};

template <class Epi, class Sched, bool ALIGN_EPI = false, bool SP2 = false>
__device__ __forceinline__ void gemm_phase(LAS unsigned char* lds, const Gemm g, const Sched& S, const Epi& E, const int tid) {
    const int wid = __builtin_amdgcn_readfirstlane(tid >> 6), lane = tid & 63, wr = wid >> 2, wc = wid & 3, fr = lane & 15, fq = lane >> 4;
    const int K = g.K, nt = K / BK;
    unsigned voffA[2], voffB[2];
#pragma unroll
    for (int i = 0; i < 2; ++i) { int R, C; stage_rc(tid * 16 + i * 8192, R, C); voffA[i] = (unsigned)(R * K + C) * 2u; voffB[i] = voffA[i]; }
    const size_t kstep = (size_t)(BK * 2);
    const size_t hstep = (size_t)HALF * K * 2;
    const size_t tstep = 2 * hstep;
    const unsigned ldsw = (unsigned)wid * 1024u;
    const int aoff = lds_byte(wr * 64 + fr, fq * 8), boff = lds_byte(wc * 32 + fr, fq * 8);
#define PG8_SA(b, h) (((b) * 2 + (h)) * HTB)
#define PG8_SB(b, h) ((4 + (b) * 2 + (h)) * HTB)
#define PG8_STAGE(bufoff, gbase, voff) do { _Pragma("unroll") for (int _i = 0; _i < 2; ++_i) \
        __builtin_amdgcn_global_load_lds((const unsigned*)((const char*)(gbase) + (voff)[_i]), (LAS unsigned*)(lds + (bufoff) + ldsw + _i * 8192), 16, 0, 0); } while (0)
#define PG8_LDA(dst, b, h) do { _Pragma("unroll") for (int m = 0; m < 4; ++m) _Pragma("unroll") for (int k = 0; k < 2; ++k) dst[m][k] = *(const LAS bf16x8*)(lds + PG8_SA(b, h) + aoff + m * 2048 + k * 1024); } while (0)
#define PG8_LDB(dst, b, h) do { _Pragma("unroll") for (int n = 0; n < 2; ++n) _Pragma("unroll") for (int k = 0; k < 2; ++k) dst[n][k] = *(const LAS bf16x8*)(lds + PG8_SB(b, h) + boff + n * 2048 + k * 1024); } while (0)
#define PG8_MMA(ai, bj, At, Bt) do { __builtin_amdgcn_s_setprio(1); _Pragma("unroll") for (int m = 0; m < 4; ++m) _Pragma("unroll") for (int n = 0; n < 2; ++n) _Pragma("unroll") for (int k = 0; k < 2; ++k) \
        acc[ai][bj][m][n] = __builtin_amdgcn_mfma_f32_16x16x32_bf16(Bt[n][k], At[m][k], acc[ai][bj][m][n], 0, 0, 0); __builtin_amdgcn_s_setprio(0); } while (0)
#define PG8_WAIT_V(n) asm volatile("s_waitcnt vmcnt(" #n ")" ::: "memory")
#define PG8_WAIT_L(n) asm volatile("s_waitcnt lgkmcnt(" #n ")" ::: "memory")
#define PG8_BAR __builtin_amdgcn_s_barrier()
#define PG8_SCHED __builtin_amdgcn_sched_barrier(0)
    Unit cur, nxt; int ui = 0;
    if (!S.next(0, cur)) return;
    f32x4 acc[2][2][4][2];
#pragma unroll
    for (int a = 0; a < 2; ++a)
#pragma unroll
        for (int b = 0; b < 2; ++b)
#pragma unroll
            for (int m = 0; m < 4; ++m)
#pragma unroll
                for (int n = 0; n < 2; ++n) acc[a][b][m][n] = (f32x4){0.f, 0.f, 0.f, 0.f};
    bf16x8 At[4][2], B0[2][2], B1[2][2];
    const char* cA = (const char*)g.A + (size_t)cur.pm * tstep; const char* cB = (const char*)g.Bt + (size_t)cur.pn * tstep;
    S.a_ready(cur);
    if constexpr (SP2) {
        PG8_STAGE(PG8_SB(0, 0), cB, voffB); PG8_STAGE(PG8_SB(0, 1), cB + hstep, voffB); PG8_STAGE(PG8_SA(0, 0), cA, voffA); PG8_STAGE(PG8_SA(0, 1), cA + hstep, voffA);
        if (wr == 1) PG8_BAR;
        PG8_WAIT_V(2); PG8_BAR;
        PG8_STAGE(PG8_SB(1, 0), cB + kstep, voffB); PG8_STAGE(PG8_SA(1, 0), cA + kstep, voffA); PG8_STAGE(PG8_SB(1, 1), cB + hstep + kstep, voffB);
        PG8_WAIT_V(6); PG8_BAR;
    } else {
        PG8_STAGE(PG8_SB(0, 0), cB, voffB); PG8_STAGE(PG8_SA(0, 0), cA, voffA); PG8_STAGE(PG8_SB(0, 1), cB + hstep, voffB); PG8_STAGE(PG8_SA(0, 1), cA + hstep, voffA);
        if (wr == 1) PG8_BAR;
        PG8_WAIT_V(4); PG8_BAR;
        PG8_STAGE(PG8_SB(1, 0), cB + kstep, voffB); PG8_STAGE(PG8_SA(1, 0), cA + kstep, voffA); PG8_STAGE(PG8_SB(1, 1), cB + hstep + kstep, voffB);
        PG8_WAIT_V(6); PG8_BAR;
    }
    for (;;) {
        const bool has_next = S.next(ui + 1, nxt);
        const char* nA = has_next ? (const char*)g.A + (size_t)nxt.pm * tstep : cA; const char* nB = has_next ? (const char*)g.Bt + (size_t)nxt.pn * tstep : cB;
        for (int t = 0; t < nt; t += 2) {
            const bool last = (t == nt - 2);
            const char* a1 = cA + (size_t)(t + 1) * kstep;
            const char* a2 = last ? nA : cA + (size_t)(t + 2) * kstep; const char* b2 = last ? nB : cB + (size_t)(t + 2) * kstep;
            const char* a3 = a2 + kstep; const char* b3 = b2 + kstep;
            if (last && has_next) S.a_ready(nxt);
            if constexpr (SP2) {
            PG8_LDB(B0, 0, 0); PG8_LDB(B1, 0, 1); PG8_SCHED; PG8_LDA(At, 0, 0); PG8_STAGE(PG8_SA(1, 1), a1 + hstep, voffA);
            PG8_WAIT_V(8); PG8_WAIT_L(0); PG8_BAR; PG8_MMA(0, 0, At, B0); PG8_MMA(0, 1, At, B1); PG8_BAR; PG8_SCHED;
            PG8_LDA(At, 0, 1); PG8_STAGE(PG8_SB(0, 0), b2, voffB); PG8_STAGE(PG8_SB(0, 1), b2 + hstep, voffB); PG8_STAGE(PG8_SA(0, 0), a2, voffA);
            PG8_WAIT_V(8); PG8_WAIT_L(0); PG8_BAR; PG8_MMA(1, 0, At, B0); PG8_MMA(1, 1, At, B1); PG8_BAR; PG8_SCHED;
            PG8_LDB(B0, 1, 0); PG8_LDB(B1, 1, 1); PG8_SCHED; PG8_LDA(At, 1, 0); PG8_STAGE(PG8_SA(0, 1), a2 + hstep, voffA);
            PG8_WAIT_V(8); PG8_WAIT_L(0); PG8_BAR; PG8_MMA(0, 0, At, B0); PG8_MMA(0, 1, At, B1); PG8_BAR; PG8_SCHED;
            PG8_LDA(At, 1, 1); PG8_STAGE(PG8_SB(1, 0), b3, voffB); PG8_STAGE(PG8_SB(1, 1), b3 + hstep, voffB); PG8_STAGE(PG8_SA(1, 0), a3, voffA);
            PG8_WAIT_V(8); PG8_WAIT_L(0); PG8_BAR; PG8_MMA(1, 0, At, B0); PG8_MMA(1, 1, At, B1); PG8_BAR; PG8_SCHED;
            } else {
            PG8_LDB(B0, 0, 0); PG8_SCHED; PG8_LDA(At, 0, 0); PG8_STAGE(PG8_SA(1, 1), a1 + hstep, voffA);
            PG8_WAIT_L(8); PG8_BAR; PG8_WAIT_L(0); PG8_MMA(0, 0, At, B0); PG8_BAR; PG8_SCHED;
            PG8_LDB(B1, 0, 1); PG8_STAGE(PG8_SB(0, 0), b2, voffB);
            PG8_BAR; PG8_WAIT_L(0); PG8_MMA(0, 1, At, B1); PG8_BAR;
            PG8_LDA(At, 0, 1); PG8_STAGE(PG8_SA(0, 0), a2, voffA);
            PG8_BAR; PG8_WAIT_L(0); PG8_MMA(1, 0, At, B0); PG8_BAR; PG8_SCHED;
            PG8_STAGE(PG8_SB(0, 1), b2 + hstep, voffB);
            PG8_WAIT_V(6); PG8_BAR; PG8_MMA(1, 1, At, B1); PG8_BAR;
            PG8_LDB(B0, 1, 0); PG8_SCHED; PG8_LDA(At, 1, 0); PG8_STAGE(PG8_SA(0, 1), a2 + hstep, voffA);
            PG8_WAIT_L(8); PG8_BAR; PG8_WAIT_L(0); PG8_MMA(0, 0, At, B0); PG8_BAR; PG8_SCHED;
            PG8_LDB(B1, 1, 1); PG8_STAGE(PG8_SB(1, 0), b3, voffB);
            PG8_BAR; PG8_WAIT_L(0); PG8_MMA(0, 1, At, B1); PG8_BAR;
            PG8_LDA(At, 1, 1); PG8_STAGE(PG8_SA(1, 0), a3, voffA);
            PG8_BAR; PG8_WAIT_L(0); PG8_MMA(1, 0, At, B0); PG8_BAR; PG8_SCHED;
            PG8_STAGE(PG8_SB(1, 1), b3 + hstep, voffB);
            PG8_WAIT_V(6); PG8_BAR; PG8_MMA(1, 1, At, B1); PG8_BAR;
            }
        }
        if constexpr (ALIGN_EPI) { if (wr == 0) PG8_BAR; }
        E(acc, cur, wr, wc, fr, fq); S.done(cur);
        if (!has_next) break;
#pragma unroll
        for (int a = 0; a < 2; ++a)
#pragma unroll
            for (int b = 0; b < 2; ++b)
#pragma unroll
                for (int m = 0; m < 4; ++m)
#pragma unroll
                    for (int n = 0; n < 2; ++n) acc[a][b][m][n] = (f32x4){0.f, 0.f, 0.f, 0.f};
        cur = nxt; cA = nA; cB = nB; ++ui;
        if constexpr (ALIGN_EPI) { if (wr == 1) PG8_BAR; }
    }
    PG8_WAIT_V(0);
    if constexpr (!ALIGN_EPI) { if (wr == 0) PG8_BAR; }
    PG8_BAR;
#undef PG8_SA
#undef PG8_SB
#undef PG8_STAGE
#undef PG8_LDA
#undef PG8_LDB
#undef PG8_MMA
#undef PG8_WAIT_V
#undef PG8_WAIT_L
#undef PG8_BAR
#undef PG8_SCHED
}
}

__device__ __forceinline__ int colmap_in(int np) {
    const int pn = np >> 8, c = np & 255;
    const int bj = c >> 7, wc = (c >> 5) & 3, n = (c >> 4) & 1, fq = (c >> 2) & 3, j = c & 3;
    const int cnat = 128 * bj + 32 * wc + 8 * fq + 4 * n + j;
    const int d64 = 16 * fq + 8 * bj + 4 * n + j;
    const int d128 = 64 * bj + 32 * (wc & 1) + 8 * fq + 4 * n + j;
    if (pn <= 1) return 64 * (4 * pn + wc) + d64;
    if (pn == 2) return (wc < 2 ? 512 + 64 * wc : 640 + 64 * (wc - 2)) + d64;
    if (pn <= 4) return 768 + 256 * (pn - 3) + cnat;
    if (pn <= 6) return 1280 + 128 * (2 * (pn - 5) + (wc >> 1)) + d128;
    if (pn <= 8) return 1792 + 128 * (2 * (pn - 7) + (wc >> 1)) + d128;
    if (pn <= 10) return 2304 + 256 * (pn - 9) + cnat;
    return 2816 + 256 * (pn - 11) + cnat;
}
__device__ __forceinline__ int colmap_out(int np) {
    const int pn = np >> 8, c = np & 255;
    const int bj = c >> 7, wc = (c >> 5) & 3, n = (c >> 4) & 1, fq = (c >> 2) & 3, j = c & 3;
    return 256 * pn + 128 * bj + 32 * wc + 8 * fq + 4 * n + j;
}

__device__ __forceinline__ int cm_c64(int d, int wc) { return 128 * ((d >> 3) & 1) + 32 * wc + 16 * ((d >> 2) & 1) + 4 * (d >> 4) + (d & 3); }
__device__ __forceinline__ int cm_nat(int x) { return 128 * (x >> 7) + 32 * ((x >> 5) & 3) + 16 * ((x >> 2) & 1) + 4 * ((x >> 3) & 3) + (x & 3); }
__device__ __forceinline__ int cm_c128(int d, int hsel) { return 128 * (d >> 6) + 32 * (2 * hsel + ((d >> 5) & 1)) + 16 * ((d >> 2) & 1) + 4 * ((d >> 3) & 3) + (d & 3); }
__device__ __forceinline__ int colinv_in(int col) {
    if (col < 512) { const int head = col >> 6; return 256 * (head >> 2) + cm_c64(col & 63, head & 3); }
    if (col < 640) { const int o = col - 512; return 512 + cm_c64(o & 63, o >> 6); }
    if (col < 768) { const int o = col - 640; return 512 + cm_c64(o & 63, 2 + (o >> 6)); }
    if (col < 1280) { const int o = col - 768; return 256 * (3 + (o >> 8)) + cm_nat(o & 255); }
    if (col < 1792) { const int o = col - 1280, head = o >> 7; return 256 * (5 + (head >> 1)) + cm_c128(o & 127, head & 1); }
    if (col < 2304) { const int o = col - 1792, head = o >> 7; return 256 * (7 + (head >> 1)) + cm_c128(o & 127, head & 1); }
    if (col < 2816) { const int o = col - 2304; return 256 * (9 + (o >> 8)) + cm_nat(o & 255); }
    const int o = col - 2816; return 256 * (11 + (o >> 8)) + cm_nat(o & 255);
}
__device__ __forceinline__ int colinv_out(int col) { return 256 * (col >> 8) + cm_nat(col & 255); }
struct EpiIn {
    bf16_t* P; const unsigned* rowss; const float* qg; const float* kg; const float* tabA; const float* tabB;
    float* kp; float* vp; float* ks; float* vs;
    __device__ __forceinline__ void operator()(const f32x4 (&acc)[2][2][4][2], const pg8::Unit& u, int wr, int wc, int fr, int fq) const {
        const int pn = u.pn;
        const int rowb = u.pm * 256 + wr * 64 + fr;
        float rr[2][4];
#pragma unroll
        for (int ai = 0; ai < 2; ++ai)
#pragma unroll
            for (int m = 0; m < 4; ++m) rr[ai][m] = (float)rowss[rowb + ai * 128 + m * 16] * (1.0f / 65536.0f);
        if (pn <= 2) {
            const bool isv = (pn == 2 && wc >= 2), isk = (pn == 2 && wc < 2);
            const int head = (pn == 2) ? (wc & 1) : 4 * pn + wc;
            const int colbase = ((pn == 2) ? (isv ? 640 : 512) : 0) + 64 * head + 16 * fq;
            const float* gp = isk ? kg : qg;
#pragma unroll
            for (int am = 0; am < 4; ++am) {
                const int ai = am >> 1;
                f32x4 ca[4][2], sa[4][2];
                if (!isv) {
#pragma unroll
                    for (int m = 2 * (am & 1); m < 2 * (am & 1) + 2; ++m) {
                        const int row = rowb + ai * 128 + m * 16;
                        const int pos = (row < MP) ? (row & 8191) : (8192 + ((row - MP) & 3));
#pragma unroll
                        for (int n = 0; n < 2; ++n) { ca[m][n] = *(const f32x4*)(tabA + pos * 16 + 4 * n); sa[m][n] = *(const f32x4*)(tabA + pos * 16 + 8 + 4 * n); }
                    }
                }
#pragma unroll
                for (int m = 2 * (am & 1); m < 2 * (am & 1) + 2; ++m) {
                    const int row = rowb + ai * 128 + m * 16;
                    const float r = rsqrtf(rr[ai][m] * (1.0f / 1024.0f) + 1e-6f);
                    const int pos = (row < MP) ? (row & 8191) : (8192 + ((row - MP) & 3));
                    f32x4 v[2][2];
#pragma unroll
                    for (int bj = 0; bj < 2; ++bj)
#pragma unroll
                        for (int n = 0; n < 2; ++n) v[bj][n] = acc[ai][bj][m][n] * r;
                    if (!isv) {
                        float ss = 0.f;
#pragma unroll
                        for (int bj = 0; bj < 2; ++bj)
#pragma unroll
                            for (int n = 0; n < 2; ++n) { const f32x4 x = v[bj][n]; ss += (x[0] * x[0] + x[1] * x[1]) + (x[2] * x[2] + x[3] * x[3]); }
                        ss += shx(ss, 16, (fq * 16 + fr)); ss += shx(ss, 32, (fq * 16 + fr));
                        const float rn = rsqrtf(ss * (1.0f / 64.0f) + 1e-6f);
#pragma unroll
                        for (int bj = 0; bj < 2; ++bj)
#pragma unroll
                            for (int n = 0; n < 2; ++n) v[bj][n] = v[bj][n] * rn * *(const f32x4*)(gp + 16 * fq + 8 * bj + 4 * n);
                        if (fq == 0) {
#pragma unroll
                            for (int n = 0; n < 2; ++n) {
                                const f32x4 c = ca[m][n], s = sa[m][n];
                                const f32x4 x1 = v[0][n], x2 = v[1][n];
                                v[0][n] = x1 * c - x2 * s; v[1][n] = x2 * c + x1 * s;
                            }
                        }
                    }
                    if (pn == 2) {
                        float* dst = nullptr;
                        if (row < MP) { if (pos >= SEQ - 128) dst = (isv ? vp : kp) + ((((row >> 13) * 128 + (pos - (SEQ - 128))) * 2 + head) * 64 + 16 * fq); }
                        else { const int sr = row - MP; dst = (isv ? vs : ks) + ((((sr >> 2) * 128 + 124 + (sr & 3)) * 2 + head) * 64 + 16 * fq); }
                        if (dst) {
#pragma unroll
                            for (int bj = 0; bj < 2; ++bj)
#pragma unroll
                                for (int n = 0; n < 2; ++n) *(f32x4*)(dst + 8 * bj + 4 * n) = v[bj][n];
                        }
                    }
                    bf16_t* pp = P + (size_t)row * NIN + colbase;
                    if (pn < 2) {
#pragma unroll
                        for (int bj = 0; bj < 2; ++bj)
#pragma unroll
                            for (int n = 0; n < 2; ++n) v[bj][n] = v[bj][n] * (0.125f * LOG2E);
                    }
#pragma unroll
                    for (int bj = 0; bj < 2; ++bj) {
                        u32x4 w; w.x = pk(v[bj][0][0], v[bj][0][1]); w.y = pk(v[bj][0][2], v[bj][0][3]);
                        w.z = pk(v[bj][1][0], v[bj][1][1]); w.w = pk(v[bj][1][2], v[bj][1][3]);
                        *(u32x4*)(pp + 8 * bj) = w;
                    }
                }
            }
        } else if (pn <= 4 || pn >= 9) {
            const bool silu = (pn <= 4 || pn >= 11);
            const int colbase = (pn <= 4 ? 768 + 256 * (pn - 3) : (pn <= 10 ? 2304 + 256 * (pn - 9) : 2816 + 256 * (pn - 11))) + 32 * wc + 8 * fq;
#pragma unroll
            for (int ai = 0; ai < 2; ++ai)
#pragma unroll
                for (int m = 0; m < 4; ++m) {
                    const int row = rowb + ai * 128 + m * 16;
                    const float r = rsqrtf(rr[ai][m] * (1.0f / 1024.0f) + 1e-6f);
                    bf16_t* pp = P + (size_t)row * NIN + colbase;
#pragma unroll
                    for (int bj = 0; bj < 2; ++bj) {
                        f32x4 v0 = acc[ai][bj][m][0] * r, v1 = acc[ai][bj][m][1] * r;
                        if (silu) {
#pragma unroll
                            for (int e = 0; e < 4; ++e) { v0[e] = v0[e] * __builtin_amdgcn_rcpf(1.0f + ex2(-v0[e] * LOG2E)); v1[e] = v1[e] * __builtin_amdgcn_rcpf(1.0f + ex2(-v1[e] * LOG2E)); }
                        }
                        u32x4 w; w.x = pk(v0[0], v0[1]); w.y = pk(v0[2], v0[3]); w.z = pk(v1[0], v1[1]); w.w = pk(v1[2], v1[3]);
                        *(u32x4*)(pp + 128 * bj) = w;
                    }
                }
        } else {
            const bool isk = pn >= 7;
            const int head = 2 * ((pn - 5) & 1) + (wc >> 1), hh = wc & 1;
            const int colbase = (isk ? 1792 : 1280) + 128 * head + 32 * hh + 8 * fq;
            const float post = __builtin_bit_cast(float, __builtin_amdgcn_readfirstlane(isk ? 0x3db504f3 : 0x3f800000));
#pragma unroll
            for (int am = 0; am < 4; ++am) {
                const int ai = am >> 1;
                f32x4 cc[4][2], sn[4][2];
#pragma unroll
                for (int m = 2 * (am & 1); m < 2 * (am & 1) + 2; ++m) {
                    const int row = rowb + ai * 128 + m * 16;
                    const int pos = (row < MP) ? (row & 8191) : (8192 + ((row - MP) & 3));
                    const float* tb = tabB + pos * 128 + 32 * hh + 8 * fq;
#pragma unroll
                    for (int n = 0; n < 2; ++n) { cc[m][n] = *(const f32x4*)(tb + 4 * n); sn[m][n] = *(const f32x4*)(tb + 64 + 4 * n); }
                }
#pragma unroll
                for (int m = 2 * (am & 1); m < 2 * (am & 1) + 2; ++m) {
                    const int row = rowb + ai * 128 + m * 16;
                    const float r = rsqrtf(rr[ai][m] * (1.0f / 1024.0f) + 1e-6f) * post;
                    f32x4 y1[2], y2[2];
#pragma unroll
                    for (int n = 0; n < 2; ++n) {
                        const f32x4 c = cc[m][n], s = sn[m][n];
                        const f32x4 x1 = acc[ai][0][m][n] * r, x2 = acc[ai][1][m][n] * r;
                        y1[n] = x1 * c - x2 * s; y2[n] = x2 * c + x1 * s;
                    }
                    bf16_t* pp = P + (size_t)row * NIN + colbase;
                    u32x4 w; w.x = pk(y1[0][0], y1[0][1]); w.y = pk(y1[0][2], y1[0][3]); w.z = pk(y1[1][0], y1[1][1]); w.w = pk(y1[1][2], y1[1][3]);
                    *(u32x4*)pp = w;
                    w.x = pk(y2[0][0], y2[0][1]); w.y = pk(y2[0][2], y2[0][3]); w.z = pk(y2[1][0], y2[1][1]); w.w = pk(y2[1][2], y2[1][3]);
                    *(u32x4*)(pp + 64) = w;
                }
            }
        }
    }
};

struct EpiOut {
    const float* xin_p; const float* xin_s;
    float* xout;
    const bf16_t* XBi; bf16_t* XB; unsigned* rowss_next;
    __device__ __forceinline__ void operator()(const f32x4 (&acc)[2][2][4][2], const pg8::Unit& u, int wr, int wc, int fr, int fq) const {
        const int rowb = u.pm * 256 + wr * 64 + fr;
        const int colb = u.pn * 256 + 32 * wc + 8 * fq;
        const bool f32in = (xin_p != nullptr), last = (xout != nullptr);
#pragma unroll
        for (int ai = 0; ai < 2; ++ai) {
            f32x4 pre[4][2][2];
            if (f32in) {
#pragma unroll
                for (int m = 0; m < 4; ++m) { const int row = rowb + ai * 128 + m * 16;
                    const float* xr = (row < MP) ? xin_p + (size_t)row * DM : xin_s + (size_t)(row - MP) * DM;
#pragma unroll
                    for (int bj = 0; bj < 2; ++bj) { pre[m][bj][0] = *(const f32x4*)(xr + colb + 128 * bj); pre[m][bj][1] = *(const f32x4*)(xr + colb + 128 * bj + 4); } }
            } else {
                u32x4 pb[4][2];
#pragma unroll
                for (int m = 0; m < 4; ++m) { const int row = rowb + ai * 128 + m * 16;
#pragma unroll
                    for (int bj = 0; bj < 2; ++bj) pb[m][bj] = __builtin_nontemporal_load((const u32x4*)(XBi + (size_t)row * DM + colb + 128 * bj)); }
#pragma unroll
                for (int m = 0; m < 4; ++m)
#pragma unroll
                    for (int bj = 0; bj < 2; ++bj) { const u32x4 w = pb[m][bj];
                        pre[m][bj][0] = (f32x4){bflo(w.x), bfhi(w.x), bflo(w.y), bfhi(w.y)}; pre[m][bj][1] = (f32x4){bflo(w.z), bfhi(w.z), bflo(w.w), bfhi(w.w)}; }
            }
#pragma unroll
            for (int m = 0; m < 4; ++m) {
                const int row = rowb + ai * 128 + m * 16;
                float ss = 0.f;
#pragma unroll
                for (int bj = 0; bj < 2; ++bj) {
                    const int col = colb + 128 * bj;
                    const f32x4 v0 = pre[m][bj][0] + acc[ai][bj][m][0], v1 = pre[m][bj][1] + acc[ai][bj][m][1];
                    if (last) { __builtin_nontemporal_store(v0, (f32x4*)(xout + (size_t)row * DM + col)); __builtin_nontemporal_store(v1, (f32x4*)(xout + (size_t)row * DM + col + 4)); }
                    else {
                        u32x4 w; w.x = pk(v0[0], v0[1]); w.y = pk(v0[2], v0[3]); w.z = pk(v1[0], v1[1]); w.w = pk(v1[2], v1[3]);
                        *(u32x4*)(XB + (size_t)row * DM + col) = w;
                        ss += (v0[0] * v0[0] + v0[1] * v0[1]) + (v0[2] * v0[2] + v0[3] * v0[3]) + (v1[0] * v1[0] + v1[1] * v1[1]) + (v1[2] * v1[2] + v1[3] * v1[3]);
                    }
                }
                if (!last) { ss += shx(ss, 16, (fq * 16 + fr)); ss += shx(ss, 32, (fq * 16 + fr)); if (fq == 0) atomicAdd(rowss_next + row, (unsigned)(ss * 65536.0f + 0.5f)); }
            }
        }
    }
};
struct OneUnit {
    int pm, pn;
    __device__ __forceinline__ bool next(int i, pg8::Unit& u) const { if (i > 0) return false; u.pm = pm; u.pn = pn; return true; }
    __device__ __forceinline__ void a_ready(const pg8::Unit&) const {}
    __device__ __forceinline__ void done(const pg8::Unit&) const {}
};

struct SampleFirstOrder {
    pg8::StaticOrder S; int spm, spn; unsigned* cnt;
    __device__ __forceinline__ bool next(int i, pg8::Unit& u) const {
        if (spm >= 0) { if (i == 0) { u.pm = spm; u.pn = spn; return true; } return S.next(i - 1, u); }
        return S.next(i, u);
    }
    __device__ __forceinline__ void a_ready(const pg8::Unit&) const {}
    __device__ __forceinline__ void done(const pg8::Unit& u) const {
        if (u.pm >= 64) {
            asm volatile("s_waitcnt vmcnt(0)" ::: "memory");
            __builtin_amdgcn_s_barrier();
            if (threadIdx.x == 0) { __builtin_amdgcn_fence(__ATOMIC_RELEASE, "agent"); asm volatile("s_waitcnt vmcnt(0)" ::: "memory"); __hip_atomic_fetch_add(cnt, 1u, __ATOMIC_RELAXED, __HIP_MEMORY_SCOPE_AGENT); }
        }
    }
};
__device__ __forceinline__ void p0_transpose_item(const float* W, int K, int N, const float* g, bf16_t* WT, bool is_in, LAS float* scr, int item, int lane) {
    const int nblk = N / 32, kb = item / nblk, nb = item % nblk, k0 = 64 * kb, s0 = 32 * nb;
    float tw[32];
#pragma unroll
    for (int i = 0; i < 32; ++i) tw[i] = __builtin_nontemporal_load(W + (size_t)(k0 + 2 * i + (lane >> 5)) * N + s0 + (lane & 31));
#pragma unroll
    for (int i = 0; i < 32; ++i) { const int kk = 2 * i + (lane >> 5); const float gvv = g ? g[k0 + kk] : 1.0f; scr[kk * 33 + (lane & 31)] = tw[i] * gvv; }
    asm volatile("s_waitcnt lgkmcnt(0)" ::: "memory");
    const int c = lane & 7;
#pragma unroll
    for (int j = 0; j < 4; ++j) { const int n = (lane >> 3) + 8 * j; const LAS float* s = scr + (8 * c) * 33 + n;
        const int drow = is_in ? colinv_in(s0 + n) : colinv_out(s0 + n);
        u32x4 o; o.x = pk(s[0 * 33], s[1 * 33]); o.y = pk(s[2 * 33], s[3 * 33]); o.z = pk(s[4 * 33], s[5 * 33]); o.w = pk(s[6 * 33], s[7 * 33]);
        *(u32x4*)(WT + (size_t)drow * K + k0 + 8 * c) = o; }
    asm volatile("s_waitcnt lgkmcnt(0)" ::: "memory");
}
__device__ __forceinline__ void sincos_d(double x, double& s, double& c) {
    const double kd = __builtin_rint(x * 0.63661977236758134308);
    const double r = (x - kd * 1.57079632673412561417e+00) - kd * 6.07710050650619224932e-11;
    const int k = ((int)kd) & 3;
    const double r2 = r * r;
    const double sp = r * (1.0 + r2 * (-1.0 / 6.0 + r2 * (1.0 / 120.0 + r2 * (-1.0 / 5040.0 + r2 * (1.0 / 362880.0 + r2 * (-1.0 / 39916800.0 + r2 * (1.0 / 6227020800.0)))))));
    const double cp = 1.0 + r2 * (-0.5 + r2 * (1.0 / 24.0 + r2 * (-1.0 / 720.0 + r2 * (1.0 / 40320.0 + r2 * (-1.0 / 3628800.0 + r2 * (1.0 / 479001600.0 + r2 * (-1.0 / 87178291200.0)))))));
    s = (k == 0) ? sp : (k == 1) ? cp : (k == 2) ? -sp : -cp;
    c = (k == 0) ? cp : (k == 1) ? -sp : (k == 2) ? -cp : sp;
}

struct Args { const float* in[11]; float* out; unsigned char* ws; double baseA, baseB; int ph_lo, ph_hi; };

__device__ __forceinline__ void p0_prologue(const Args& a, LAS unsigned char* lds, int tid, int G) {
    const int lane = tid & 63, wave = tid >> 6;
    LAS float* scr = (LAS float*)(lds + wave * 16384);
    const int gw = blockIdx.x * 8 + wave, NGW = G * 8;
    unsigned char* ws = a.ws;
    constexpr int I_IN = (DM / 64) * (NIN / 32), I_OUT = (DM / 64) * (DM / 32);
    for (int it = gw; it < DEPTH * (I_IN + I_OUT); it += NGW) {
        const int l = it / (I_IN + I_OUT); int r = it - l * (I_IN + I_OUT);
        if (r < I_IN) p0_transpose_item(a.in[5] + (size_t)l * DM * NIN, DM, NIN, a.in[7] + l * DM, (bf16_t*)(ws + WS_WIN) + (size_t)l * NIN * DM, true, scr, r, lane);
        else p0_transpose_item(a.in[6] + (size_t)l * DM * DM, DM, DM, nullptr, (bf16_t*)(ws + WS_WOUT) + (size_t)l * DM * DM, false, scr, r - I_IN, lane);
    }
    unsigned* rowss = (unsigned*)(ws + WS_ROWSS);
    bf16_t* XB = (bf16_t*)(ws + WS_XB);
    for (int m0 = gw; m0 < MT; m0 += 4 * NGW) {
        f32x4 v[4][4];
#pragma unroll
        for (int q = 0; q < 4; ++q) { const int m = m0 + q * NGW; if (m < MT) { const float* xr = (m < MP) ? a.in[0] + (size_t)m * DM : a.in[1] + (size_t)(m - MP) * DM;
#pragma unroll
            for (int j = 0; j < 4; ++j) v[q][j] = *(const f32x4*)(xr + 4 * lane + 256 * j); } }
#pragma unroll
        for (int q = 0; q < 4; ++q) { const int m = m0 + q * NGW; if (m < MT) {
            float s = 0.f;
#pragma unroll
            for (int j = 0; j < 4; ++j) { const f32x4 x = v[q][j]; s += (x[0] * x[0] + x[1] * x[1]) + (x[2] * x[2] + x[3] * x[3]);
                u32x2 w; w.x = pk(x[0], x[1]); w.y = pk(x[2], x[3]); *(u32x2*)(XB + (size_t)m * DM + 4 * lane + 256 * j) = w; }
#pragma unroll
            for (int o = 1; o < 64; o <<= 1) s += shx(s, o, lane);
            if (lane == 0) rowss[m] = (unsigned)(s * 65536.0f + 0.5f); } }
    }
    const int gt = blockIdx.x * 512 + tid, NGT = G * 512;
    for (int i = gt; i < 3 * MT; i += NGT) rowss[MT + i] = 0u;
    float* tabB = (float*)(ws + WS_TABB); float* tabA = (float*)(ws + WS_TABA);
    for (int idx = gt; idx < NPOS * 72; idx += NGT) {
        const int pos = idx / 72, i = idx - pos * 72;
        const bool isB = i < 64; const int ii = isB ? i : i - 64; const double base = isB ? a.baseB : a.baseA;
        double p = 1.0; for (int k = 0; k < ii; ++k) p *= base;
        const float inv = (float)p; const float ang = (float)pos * inv;
        double s, c; sincos_d((double)ang, s, c);
        if (isB) { tabB[pos * 128 + ii] = (float)c; tabB[pos * 128 + 64 + ii] = (float)s; }
        else { tabA[pos * 16 + ii] = (float)c; tabA[pos * 16 + 8 + ii] = (float)s; }
    }
}


__device__ __forceinline__ void tr_write_sw(LAS bf16_t* img, int RS, int c8, int SM, int tok, u32x4 vv, int XL, int lane) {
    const bool odd = tok & 1;
    const unsigned s0 = odd ? vv.x : vv.z, s1 = odd ? vv.y : vv.w;
    const unsigned r0 = (unsigned)shxi((int)s0, XL, lane), r1 = (unsigned)shxi((int)s1, XL, lane);
    const unsigned a0 = odd ? r0 : vv.x, a1 = odd ? r1 : vv.y, b0 = odd ? vv.z : r0, b1 = odd ? vv.w : r1;
    LAS unsigned* p = (LAS unsigned*)(img + (8 * c8 + (odd ? 4 : 0)) * RS + ((((tok >> 3) ^ (c8 & SM)) << 3) + (tok & 6)));
    const int rs2 = RS >> 1;
    p[0] = (a0 & 0xffffu) | (b0 << 16); p[rs2] = (a0 >> 16) | (b0 & 0xffff0000u);
    p[2 * rs2] = (a1 & 0xffffu) | (b1 << 16); p[3 * rs2] = (a1 >> 16) | (b1 & 0xffff0000u);
}
__device__ __forceinline__ int sw_off(int d, int RS, int SM, int t0) { return d * RS + ((((t0 >> 3) ^ ((d >> 3) & SM)) << 3) + (t0 & 7)); }
struct AttnRegs { u32x4 kv[4], vv[4]; float sink; };
__device__ __forceinline__ void attn_load(AttnRegs& R, const bf16_t* P, int unit, int tid) {
    const int g = unit & 1, qb = (unit >> 1) & 63, n = unit >> 7;
    const int R0 = n * SEQ + qb * 128;
    const int lane = tid & 63, w = tid >> 6, fr = lane & 15, fq = lane >> 4;
#pragma unroll
    for (int i = 0; i < 4; ++i) {
        const int ch = tid + 512 * i, key = ch >> 3, c8 = ch & 7;
        R.kv[i] = (u32x4){0u, 0u, 0u, 0u};
        if (qb > 0 || key >= 128) R.kv[i] = *(const u32x4*)(P + (size_t)(R0 - 128 + key) * NIN + 512 + 64 * g + 8 * c8);
    }
#pragma unroll
    for (int i = 0; i < 4; ++i) { const int key = (tid >> 3) + 64 * i, c8 = tid & 7; R.vv[i] = (u32x4){0u, 0u, 0u, 0u};
        if (qb > 0 || key >= 128) R.vv[i] = *(const u32x4*)(P + (size_t)(R0 - 128 + key) * NIN + 640 + 64 * g + 8 * c8); }
}
__device__ __forceinline__ void attn_compute(LAS unsigned char* lds, const AttnRegs& R, const bf16_t* P, bf16_t* MIX, const float* sinks_l, int unit, int tid) {
    const int g = unit & 1, qb = (unit >> 1) & 63, n = unit >> 7;
    const int R0 = n * SEQ + qb * 128;
    LAS bf16_t* Ks = (LAS bf16_t*)lds;
    LAS bf16_t* Vt = (LAS bf16_t*)(lds + 256 * 144);
    const int lane = tid & 63, w = tid >> 6, fr = lane & 15, fq = lane >> 4;
    const int head = 4 * g + (w >> 1);
#pragma unroll
    for (int i = 0; i < 4; ++i) {
        const int ch = tid + 512 * i, key = ch >> 3, c8 = ch & 7;
        *(LAS u32x4*)(Ks + key * 72 + 8 * c8) = R.kv[i];
    }
#pragma unroll
    for (int i = 0; i < 4; ++i) tr_write_sw(Vt, 264, tid & 7, 7, (tid >> 3) + 64 * i, R.vv[i], 8, tid);
    __syncthreads();
    const float sink2 = sinks_l[head] * LOG2E;
#pragma unroll 1
    for (int qt = 0; qt < 4; ++qt) {
        const int qi = 64 * (w & 1) + 16 * qt + fr;
        const int row = R0 + qi;
        const bf16_t* qp = P + (size_t)row * NIN + 64 * head + 8 * fq;
        const bf16x8 bq0 = *(const bf16x8*)qp, bq1 = *(const bf16x8*)(qp + 32);
        u32x2 gts[4];
#pragma unroll
        for (int dt = 0; dt < 4; ++dt) gts[dt] = *(const u32x2*)(P + (size_t)row * NIN + 768 + 64 * head + 16 * dt + 4 * fq);
        f32x4 s[16];
#pragma unroll
        for (int kt = 0; kt < 16; ++kt) {
            const LAS bf16_t* kr = Ks + (16 * kt + fr) * 72 + 8 * fq;
            const bf16x8 a0 = *(const LAS bf16x8*)kr, a1 = *(const LAS bf16x8*)(kr + 32);
            f32x4 z = (f32x4){0.f, 0.f, 0.f, 0.f};
            z = __builtin_amdgcn_mfma_f32_16x16x32_bf16(a0, bq0, z, 0, 0, 0);
            s[kt] = __builtin_amdgcn_mfma_f32_16x16x32_bf16(a1, bq1, z, 0, 0, 0);
            if ((kt & 3) == 3) __builtin_amdgcn_sched_barrier(0);
        }
        float mx = -INFINITY;
#pragma unroll
        for (int kt = 0; kt < 16; ++kt)
#pragma unroll
            for (int r = 0; r < 4; ++r) {
                const int key = 16 * kt + 4 * fq + r;
                const bool valid = (kt < 8) ? (qb > 0 && key > qi) : (key - 128 <= qi);
                const float x = valid ? s[kt][r] : -INFINITY; s[kt][r] = x; mx = fmaxf(mx, x);
            }
        mx = fmaxf(mx, shx(mx, 16, lane)); mx = fmaxf(mx, shx(mx, 32, lane)); mx = fmaxf(mx, sink2);
        float sum = 0.f;
#pragma unroll
        for (int kt = 0; kt < 16; ++kt)
#pragma unroll
            for (int r = 0; r < 4; ++r) { const float p = ex2(s[kt][r] - mx); s[kt][r] = p; sum += p; }
        sum += shx(sum, 16, lane); sum += shx(sum, 32, lane); sum += ex2(sink2 - mx);
        f32x4 o[4];
#pragma unroll
        for (int dt = 0; dt < 4; ++dt) o[dt] = (f32x4){0.f, 0.f, 0.f, 0.f};
#pragma unroll
        for (int k2 = 0; k2 < 8; ++k2) {
            u32x4 pw; pw.x = pk(s[2 * k2][0], s[2 * k2][1]); pw.y = pk(s[2 * k2][2], s[2 * k2][3]); pw.z = pk(s[2 * k2 + 1][0], s[2 * k2 + 1][1]); pw.w = pk(s[2 * k2 + 1][2], s[2 * k2 + 1][3]);
            const bf16x8 pb = __builtin_bit_cast(bf16x8, pw);
#pragma unroll
            for (int dt = 0; dt < 4; ++dt) {
                const u32x2 lo = *(const LAS u32x2*)(Vt + sw_off(16 * dt + fr, 264, 7, 32 * k2 + 4 * fq)), hi = *(const LAS u32x2*)(Vt + sw_off(16 * dt + fr, 264, 7, 32 * k2 + 16 + 4 * fq));
                const u32x4 aw = (u32x4){lo.x, lo.y, hi.x, hi.y};
                o[dt] = __builtin_amdgcn_mfma_f32_16x16x32_bf16(__builtin_bit_cast(bf16x8, aw), pb, o[dt], 0, 0, 0);
            }
        }
        const float inv = 1.0f / sum;
#pragma unroll
        for (int dt = 0; dt < 4; ++dt) {
            const u32x2 gt = gts[dt];
            u32x2 wv; wv.x = pk(o[dt][0] * inv * bflo(gt.x), o[dt][1] * inv * bfhi(gt.x)); wv.y = pk(o[dt][2] * inv * bflo(gt.y), o[dt][3] * inv * bfhi(gt.y));
            *(u32x2*)(MIX + (size_t)row * DM + 64 * head + 16 * dt + 4 * fq) = wv;
        }
    }
    __syncthreads();
}

struct UcRegs { u32x4 kv[4], vv[4]; };
__device__ __forceinline__ void uc_load(UcRegs& R, const bf16_t* P, int unit, int tid) {
    const int h = unit & 3, c = (unit >> 2) & 63, n = unit >> 8;
    const int R0 = n * SEQ + c * 128;
#pragma unroll
    for (int i = 0; i < 4; ++i) { const int j = (tid >> 4) + 32 * i, c8 = tid & 15; const bf16_t* pr = P + (size_t)(R0 + j) * NIN + 128 * h + 8 * c8;
        R.kv[i] = *(const u32x4*)(pr + 1792); R.vv[i] = *(const u32x4*)(pr + 2304); }
}
__device__ __forceinline__ void uc_compute(LAS unsigned char* lds, const UcRegs& R, float* UT, int unit, int tid) {
    const int h = unit & 3;
    const float l2g = l2gamma(h);
    LAS bf16_t* Kt = (LAS bf16_t*)lds;
    LAS bf16_t* Vt = (LAS bf16_t*)(lds + 128 * 272);
    const int lane = tid & 63, w = tid >> 6, fr = lane & 15, fq = lane >> 4;
#pragma unroll
    for (int i = 0; i < 4; ++i) { const int j = (tid >> 4) + 32 * i, c8 = tid & 15; const u32x4 kv = R.kv[i];
        const float dec = ex2((float)(127 - j) * l2g);
        u32x4 kd; kd.x = pk(bflo(kv.x) * dec, bfhi(kv.x) * dec); kd.y = pk(bflo(kv.y) * dec, bfhi(kv.y) * dec);
        kd.z = pk(bflo(kv.z) * dec, bfhi(kv.z) * dec); kd.w = pk(bflo(kv.w) * dec, bfhi(kv.w) * dec);
        tr_write_sw(Kt, 136, c8, 15, j, kd, 16, tid); tr_write_sw(Vt, 136, c8, 15, j, R.vv[i], 16, tid); }
    __syncthreads();
    const int mt0 = 2 * (w & 3), nt0 = 4 * (w >> 2);
    f32x4 acc[2][4];
#pragma unroll
    for (int mi = 0; mi < 2; ++mi)
#pragma unroll
        for (int ni = 0; ni < 4; ++ni) acc[mi][ni] = (f32x4){0.f, 0.f, 0.f, 0.f};
#pragma unroll
    for (int ks = 0; ks < 4; ++ks) {
        bf16x8 af[2], bfr[4];
#pragma unroll
        for (int mi = 0; mi < 2; ++mi) af[mi] = *(const LAS bf16x8*)(Kt + sw_off(16 * (mt0 + mi) + fr, 136, 15, 32 * ks + 8 * fq));
#pragma unroll
        for (int ni = 0; ni < 4; ++ni) bfr[ni] = *(const LAS bf16x8*)(Vt + sw_off(16 * (nt0 + ni) + fr, 136, 15, 32 * ks + 8 * fq));
#pragma unroll
        for (int mi = 0; mi < 2; ++mi)
#pragma unroll
            for (int ni = 0; ni < 4; ++ni) acc[mi][ni] = __builtin_amdgcn_mfma_f32_16x16x32_bf16(af[mi], bfr[ni], acc[mi][ni], 0, 0, 0);
    }
    float* ub = UT + (size_t)unit * 16384;
#pragma unroll
    for (int mi = 0; mi < 2; ++mi)
#pragma unroll
        for (int ni = 0; ni < 4; ++ni) *(f32x4*)(ub + (16 * (nt0 + ni) + fr) * 128 + 16 * (mt0 + mi) + 4 * fq) = acc[mi][ni];
    __syncthreads();
}

__device__ __forceinline__ void sattn_unit(LAS unsigned char* lds, const bf16_t* P, bf16_t* MIX, const float* ck, const float* cv, float* kso, float* vso, const float* sinks_l, int unit, int tid) {
    const int n = unit >> 1, g = unit & 1;
    LAS float* Kc = (LAS float*)lds;
    LAS float* Vc = Kc + 132 * 68;
    LAS float* Qs = Vc + 132 * 68;
    LAS float* Sc = Qs + 1024;
    const float sink_pre = sinks_l[4 * g + ((tid >> 5) & 3)];
    bf16_t gate_pre[4];
    {
        const int lane_ = tid & 63, w_ = tid >> 6, d_ = 16 * (w_ & 3) + (lane_ & 15);
        const bf16_t* gp_ = P + (size_t)(MP + 4 * n + (lane_ >> 4)) * NIN + 768 + 64 * 4 * g + d_;
#pragma unroll
        for (int r = 0; r < 4; ++r) gate_pre[r] = gp_[64 * r];
    }
#pragma unroll
    for (int i = 0; i < 4; ++i) {
        const int ch = tid + 512 * i, wp = ch >> 4, c4 = ch & 15;
        const size_t src = (size_t)((n * 128 + wp) * 2 + g) * 64 + 4 * c4;
        const f32x4 kv = __builtin_nontemporal_load((const f32x4*)(ck + src)), vv = __builtin_nontemporal_load((const f32x4*)(cv + src));
        *(LAS f32x4*)(Kc + wp * 68 + 4 * c4) = kv; *(LAS f32x4*)(Vc + wp * 68 + 4 * c4) = vv;
        if (wp >= 4) { const size_t dst = (size_t)((n * 128 + wp - 4) * 2 + g) * 64 + 4 * c4; __builtin_nontemporal_store(kv, (f32x4*)(kso + dst)); __builtin_nontemporal_store(vv, (f32x4*)(vso + dst)); }
    }
    if (tid < 64) {
        const int t = tid >> 4, c4 = tid & 15;
        const size_t src = (size_t)((n * 128 + 124 + t) * 2 + g) * 64 + 4 * c4;
        *(LAS f32x4*)(Kc + (128 + t) * 68 + 4 * c4) = *(const f32x4*)(kso + src); *(LAS f32x4*)(Vc + (128 + t) * 68 + 4 * c4) = *(const f32x4*)(vso + src);
    }
    const int qi = tid >> 5, ln = tid & 31;
    const int head = 4 * g + (qi & 3), row = MP + 4 * n + (qi >> 2);
    { const unsigned u = *(const unsigned*)(P + (size_t)row * NIN + 64 * head + 2 * ln); Qs[qi * 64 + 2 * ln] = bflo(u); Qs[qi * 64 + 2 * ln + 1] = bfhi(u); }
    __syncthreads();
    const int lane = tid & 63, w = tid >> 6, fr = lane & 15, fq = lane >> 4;
#pragma unroll 1
    for (int kt = w; kt < 9; kt += 8) {
        f32x4 z = (f32x4){0.f, 0.f, 0.f, 0.f};
#pragma unroll
        for (int st = 0; st < 16; ++st) z = __builtin_amdgcn_mfma_f32_16x16x4f32(Qs[fr * 64 + 4 * st + fq], Kc[(16 * kt + fr) * 68 + 4 * st + fq], z, 0, 0, 0);
        const int k = 16 * kt + fr;
        if (k < 132) {
            const bool valid = (k >= fq + 1) && (k <= fq + 128);
#pragma unroll
            for (int r = 0; r < 4; ++r) Sc[(4 * fq + r) * 136 + k] = valid ? z[r] : -INFINITY;
        }
    }
    __syncthreads();
    const float sink2 = sink_pre * LOG2E;
    float mx = -INFINITY;
    for (int k = ln; k < 132; k += 32) mx = fmaxf(mx, Sc[qi * 136 + k]);
#pragma unroll
    for (int o = 1; o < 32; o <<= 1) mx = fmaxf(mx, shx(mx, o, tid));
    mx = fmaxf(mx, sink2);
    float sum = 0.f;
    for (int k = ln; k < 132; k += 32) { const float p = ex2(Sc[qi * 136 + k] - mx); Sc[qi * 136 + k] = p; sum += p; }
#pragma unroll
    for (int o = 1; o < 32; o <<= 1) sum += shx(sum, o, tid);
    if (ln == 0) Sc[qi * 136 + 132] = 1.0f / (sum + ex2(sink2 - mx));
    __syncthreads();
    if (w < 4) {
        f32x4 o = (f32x4){0.f, 0.f, 0.f, 0.f};
#pragma unroll 11
        for (int st = 0; st < 33; ++st) o = __builtin_amdgcn_mfma_f32_16x16x4f32(Sc[fr * 136 + 4 * st + fq], Vc[(4 * st + fq) * 68 + 16 * w + fr], o, 0, 0, 0);
        const int d = 16 * w + fr, orow = MP + 4 * n + fq;
#pragma unroll
        for (int r = 0; r < 4; ++r) {
            const int hd = 4 * g + r;
            const float gate = bf2f(gate_pre[r]);
            MIX[(size_t)orow * DM + 64 * hd + d] = (bf16_t)(pk(o[r] * Sc[(4 * fq + r) * 136 + 132] * gate, 0.f) & 0xffffu);
        }
    }
    __syncthreads();
}

struct SretRegs { f32x4 s4[8]; float gate; unsigned qkv; unsigned vv; };
__device__ __forceinline__ void sret_load(SretRegs& R, const bf16_t* P, const float* Sin, int unit, int tid) {
    const int n = unit >> 2, h = unit & 3;
    const int v4 = tid & 31, dg = tid >> 5;
    const float* Sb = Sin + (size_t)unit * 16384;
    const int t = tid >> 7, d = tid & 127;
    const bf16_t* pr = P + (size_t)(MP + 4 * n + t) * NIN + 128 * h + d;
    R.qkv = (unsigned)pr[1280] | ((unsigned)pr[1792] << 16); R.vv = (unsigned)pr[2304];
    R.gate = bf2f(pr[2816]);
#pragma unroll
    for (int i = 0; i < 8; ++i) R.s4[i] = __builtin_nontemporal_load((const f32x4*)(Sb + (8 * dg + i) * 128 + 4 * v4));
}
__device__ __forceinline__ void sret_compute(LAS unsigned char* lds, const SretRegs& R, bf16_t* MIX, float* Sout, int unit, int tid) {
    const int n = unit >> 2, h = unit & 3;
    const float l2g = l2gamma(h);
    LAS float* qs = (LAS float*)lds;
    LAS float* ks_ = qs + 512;
    LAS float* vs_ = qs + 1024;
    LAS float* qk = qs + 1536;
    LAS float* red = qs + 1552;
    LAS float* part = qs + 2048;
    const int v4 = tid & 31, dg = tid >> 5;
    float* So = Sout + (size_t)unit * 16384;
    qs[tid] = bflo(R.qkv); ks_[tid] = bfhi(R.qkv); vs_[tid] = bflo(R.vv);
    __syncthreads();
    f32x4 vj[4], cr[4];
#pragma unroll
    for (int j = 0; j < 4; ++j) { vj[j] = *(const LAS f32x4*)(vs_ + j * 128 + 4 * v4); cr[j] = (f32x4){0.f, 0.f, 0.f, 0.f}; }
    const float g1 = ex2(l2g), g2 = g1 * g1, g3 = g2 * g1, g4 = g2 * g2;
#pragma unroll
    for (int i = 0; i < 8; ++i) {
        const int d = 8 * dg + i;
#pragma unroll
        for (int t = 0; t < 4; ++t) cr[t] += R.s4[i] * qs[t * 128 + d];
        f32x4 sn = R.s4[i] * g4;
        sn += vj[0] * (g3 * ks_[0 * 128 + d]); sn += vj[1] * (g2 * ks_[1 * 128 + d]); sn += vj[2] * (g1 * ks_[2 * 128 + d]); sn += vj[3] * ks_[3 * 128 + d];
        __builtin_nontemporal_store(sn, (f32x4*)(So + d * 128 + 4 * v4));
    }
#pragma unroll
    for (int t = 0; t < 4; ++t) *(LAS f32x4*)(part + (dg * 4 + t) * 128 + 4 * v4) = cr[t];
    {
        const int t = dg >> 2, j = dg & 3; float p = 0.f;
#pragma unroll
        for (int d = v4; d < 128; d += 32) p += qs[t * 128 + d] * ks_[j * 128 + d];
#pragma unroll
        for (int o = 1; o < 32; o <<= 1) p += shx(p, o, tid);
        if (v4 == 0) qk[dg] = p;
    }
    __syncthreads();
    const int t = tid >> 7, v = tid & 127;
    float cross = 0.f;
#pragma unroll
    for (int d2 = 0; d2 < 16; ++d2) cross += part[(d2 * 4 + t) * 128 + v];
    float o = cross * ex2((float)(t + 1) * l2g);
#pragma unroll
    for (int j = 0; j < 4; ++j) if (j <= t) o += qk[t * 4 + j] * ex2((float)(t - j) * l2g) * vs_[j * 128 + v];
    float ss = o * o;
#pragma unroll
    for (int of = 1; of < 64; of <<= 1) ss += shx(ss, of, tid);
    if ((tid & 63) == 0) red[tid >> 6] = ss;
    __syncthreads();
    const float rn = rsqrtf((red[2 * t] + red[2 * t + 1]) * (1.0f / 128.0f) + 1e-6f);
    const int row = MP + 4 * n + t;
    MIX[(size_t)row * DM + 512 + 128 * h + v] = (bf16_t)(pk(o * rn * R.gate, 0.f) & 0xffffu);
    __syncthreads();
}

__device__ __forceinline__ void sample_outproj_slice(LAS unsigned char* lds, const bf16_t* MIX, const bf16_t* Wt, const float* xs_f32, const bf16_t* XBi, bf16_t* XBn, float* yout, unsigned* rowss_next, int b, int tid) {
    const int lane = tid & 63, w = tid >> 6, fr = lane & 15, fq = lane >> 4;
    const int r0 = MP + 32 * (b >> 4), c0 = 64 * (b & 15), k0 = 128 * w;
    f32x4 res;
    {
        const int mt = w >> 1, nt = w & 1;
        const int col = c0 + 32 * (mt >> 1) + 8 * fq + 4 * (mt & 1), row = r0 + 16 * nt + fr;
        if (xs_f32) res = *(const f32x4*)(xs_f32 + (size_t)(row - MP) * DM + col);
        else { const u32x2 u = *(const u32x2*)(XBi + (size_t)row * DM + col); res = (f32x4){bflo(u.x), bfhi(u.x), bflo(u.y), bfhi(u.y)}; }
    }
    bf16x8 af[4][4], bfr[2][4];
#pragma unroll
    for (int mt = 0; mt < 4; ++mt)
#pragma unroll
        for (int ks = 0; ks < 4; ++ks) af[mt][ks] = *(const bf16x8*)(Wt + (size_t)(c0 + 16 * mt + fr) * DM + k0 + 32 * ks + 8 * fq);
#pragma unroll
    for (int nt = 0; nt < 2; ++nt)
#pragma unroll
        for (int ks = 0; ks < 4; ++ks) bfr[nt][ks] = *(const bf16x8*)(MIX + (size_t)(r0 + 16 * nt + fr) * DM + k0 + 32 * ks + 8 * fq);
    f32x4 acc[4][2];
#pragma unroll
    for (int mt = 0; mt < 4; ++mt)
#pragma unroll
        for (int nt = 0; nt < 2; ++nt) { f32x4 z = (f32x4){0.f, 0.f, 0.f, 0.f};
#pragma unroll
            for (int ks = 0; ks < 4; ++ks) z = __builtin_amdgcn_mfma_f32_16x16x32_bf16(af[mt][ks], bfr[nt][ks], z, 0, 0, 0);
            acc[mt][nt] = z; }
    LAS f32x4* red = (LAS f32x4*)lds;
#pragma unroll
    for (int mt = 0; mt < 4; ++mt)
#pragma unroll
        for (int nt = 0; nt < 2; ++nt) red[(w * 8 + mt * 2 + nt) * 64 + lane] = acc[mt][nt];
    __syncthreads();
    const int mt = w >> 1, nt = w & 1;
    f32x4 v = (f32x4){0.f, 0.f, 0.f, 0.f};
#pragma unroll
    for (int ww = 0; ww < 8; ++ww) v += red[(ww * 8 + w) * 64 + lane];
    const int col = c0 + 32 * (mt >> 1) + 8 * fq + 4 * (mt & 1);
    const int row = r0 + 16 * nt + fr;
    v += res;
    if (yout) *(f32x4*)(yout + (size_t)row * DM + col) = v;
    else {
        u32x2 o; o.x = pk(v[0], v[1]); o.y = pk(v[2], v[3]);
        *(u32x2*)(XBn + (size_t)row * DM + col) = o;
        float ss = (v[0] * v[0] + v[1] * v[1]) + (v[2] * v[2] + v[3] * v[3]);
        ss += shx(ss, 16, lane); ss += shx(ss, 32, lane);
        if (fq == 0) atomicAdd(rowss_next + row, (unsigned)(ss * 65536.0f + 0.5f));
    }
    __syncthreads();
}

__device__ __forceinline__ void scan_phase(const float* UT, bf16_t* SPT, float* sp_out_l, int tid, int G) {
    for (int gid = blockIdx.x * 512 + tid; gid < 2 * 4 * 16384; gid += G * 512) {
        const int n = gid >> 16, h = (gid >> 14) & 3, e = gid & 16383;
        const float gd = ex2(128.0f * l2gamma(h));
        const size_t base = ((size_t)(n * 64) * 4 + h) * 16384 + e;
        float S = 0.f;
        for (int c0 = 0; c0 < 64; c0 += 32) {
            float uu[32];
#pragma unroll
            for (int k = 0; k < 32; ++k) uu[k] = __builtin_nontemporal_load(UT + base + (size_t)(c0 + k) * 65536);
#pragma unroll
            for (int k = 0; k < 32; ++k) { SPT[base + (size_t)(c0 + k) * 65536] = (bf16_t)(pk(S, 0.f) & 0xffffu); S = gd * S + uu[k]; }
        }
        const int dv = e >> 7, dk = e & 127;
        sp_out_l[(size_t)(n * 4 + h) * 16384 + dk * 128 + dv] = S;
    }
}

struct RetRegs { u32x4 kv[4], sv[4], vv[4]; };
__device__ __forceinline__ void ret_load(RetRegs& R, const bf16_t* P, const bf16_t* SPT, int unit, int tid) {
    const int h = unit & 3, c = (unit >> 2) & 63, n = unit >> 8;
    const int R0 = n * SEQ + c * 128;
#pragma unroll
    for (int i = 0; i < 4; ++i) {
        const int ch = tid + 512 * i, j = ch >> 4, c8 = ch & 15;
        R.kv[i] = *(const u32x4*)(P + (size_t)(R0 + j) * NIN + 1792 + 128 * h + 8 * c8);
        R.sv[i] = __builtin_nontemporal_load((const u32x4*)(SPT + (size_t)unit * 16384 + j * 128 + 8 * c8));
        R.vv[i] = *(const u32x4*)(P + (size_t)(R0 + (tid >> 4) + 32 * i) * NIN + 2304 + 128 * h + 8 * (tid & 15));
    }
}
__device__ __forceinline__ void ret_unit(LAS unsigned char* lds, const RetRegs& R, const bf16_t* P, const bf16_t* SPT, bf16_t* MIX, int unit, int tid) {
    const int h = unit & 3, c = (unit >> 2) & 63, n = unit >> 8;
    const int R0 = n * SEQ + c * 128;
    const float l2g = l2gamma(h);
    LAS bf16_t* Ks = (LAS bf16_t*)lds;
    LAS bf16_t* Vt = (LAS bf16_t*)(lds + 128 * 272);
    LAS bf16_t* Ss = (LAS bf16_t*)(lds + 256 * 272);
    const int lane = tid & 63, w = __builtin_amdgcn_readfirstlane(tid >> 6), fr = lane & 15, fq = lane >> 4;
    const int qi = 16 * w + fr, row = R0 + qi;
    bf16x8 bq[4];
#pragma unroll
    for (int ks = 0; ks < 4; ++ks) bq[ks] = *(const bf16x8*)(P + (size_t)row * NIN + 1280 + 128 * h + 32 * ks + 8 * fq);
    u32x2 gts[8];
#pragma unroll
    for (int dt = 0; dt < 8; ++dt) gts[dt] = *(const u32x2*)(P + (size_t)row * NIN + 2816 + 128 * h + 16 * dt + 4 * fq);
#pragma unroll
    for (int i = 0; i < 4; ++i) {
        const int ch = tid + 512 * i, j = ch >> 4, c8 = ch & 15;
        *(LAS u32x4*)(Ks + j * 136 + 8 * c8) = R.kv[i];
        *(LAS u32x4*)(Ss + j * 136 + 8 * c8) = R.sv[i];
    }
#pragma unroll
    for (int i = 0; i < 4; ++i) tr_write_sw(Vt, 136, tid & 15, 15, (tid >> 4) + 32 * i, R.vv[i], 16, tid);
    __syncthreads();
    f32x4 o[8];
#pragma unroll
    for (int dt = 0; dt < 8; ++dt) {
        f32x4 z = (f32x4){0.f, 0.f, 0.f, 0.f};
#pragma unroll
        for (int ks = 0; ks < 4; ++ks) z = __builtin_amdgcn_mfma_f32_16x16x32_bf16(*(const LAS bf16x8*)(Ss + (16 * dt + fr) * 136 + 32 * ks + 8 * fq), bq[ks], z, 0, 0, 0);
        o[dt] = z * ex2((float)(qi + 1) * l2g);
    }
    f32x4 sc[8];
#pragma unroll
    for (int jt = 0; jt < 8; ++jt) {
        f32x4 z = (f32x4){0.f, 0.f, 0.f, 0.f};
        if (jt <= w) {
#pragma unroll
            for (int ks = 0; ks < 4; ++ks) z = __builtin_amdgcn_mfma_f32_16x16x32_bf16(*(const LAS bf16x8*)(Ks + (16 * jt + fr) * 136 + 32 * ks + 8 * fq), bq[ks], z, 0, 0, 0);
#pragma unroll
            for (int r = 0; r < 4; ++r) { const int j = 16 * jt + 4 * fq + r; z[r] = (qi >= j) ? z[r] * ex2((float)(qi - j) * l2g) : 0.f; }
        }
        sc[jt] = z;
    }
#pragma unroll
    for (int k2 = 0; k2 < 4; ++k2) {
        if (2 * k2 <= w) {
            u32x4 pw; pw.x = pk(sc[2 * k2][0], sc[2 * k2][1]); pw.y = pk(sc[2 * k2][2], sc[2 * k2][3]); pw.z = pk(sc[2 * k2 + 1][0], sc[2 * k2 + 1][1]); pw.w = pk(sc[2 * k2 + 1][2], sc[2 * k2 + 1][3]);
            const bf16x8 pb = __builtin_bit_cast(bf16x8, pw);
#pragma unroll
            for (int dt = 0; dt < 8; ++dt) {
                const u32x2 lo = *(const LAS u32x2*)(Vt + sw_off(16 * dt + fr, 136, 15, 32 * k2 + 4 * fq)), hi = *(const LAS u32x2*)(Vt + sw_off(16 * dt + fr, 136, 15, 32 * k2 + 16 + 4 * fq));
                const u32x4 aw = (u32x4){lo.x, lo.y, hi.x, hi.y};
                o[dt] = __builtin_amdgcn_mfma_f32_16x16x32_bf16(__builtin_bit_cast(bf16x8, aw), pb, o[dt], 0, 0, 0);
            }
        }
    }
    float ss = 0.f;
#pragma unroll
    for (int dt = 0; dt < 8; ++dt) ss += (o[dt][0] * o[dt][0] + o[dt][1] * o[dt][1]) + (o[dt][2] * o[dt][2] + o[dt][3] * o[dt][3]);
    ss += shx(ss, 16, lane); ss += shx(ss, 32, lane);
    const float rn = rsqrtf(ss * (1.0f / 128.0f) + 1e-6f);
#pragma unroll
    for (int dt = 0; dt < 8; ++dt) {
        const u32x2 gt = gts[dt];
        u32x2 wv; wv.x = pk(o[dt][0] * rn * bflo(gt.x), o[dt][1] * rn * bfhi(gt.x)); wv.y = pk(o[dt][2] * rn * bflo(gt.y), o[dt][3] * rn * bfhi(gt.y));
        *(u32x2*)(MIX + (size_t)row * DM + 512 + 128 * h + 16 * dt + 4 * fq) = wv;
    }
    __syncthreads();
}


#define XB_TMO      128
#define XB_XCNT(j)  (256  + 64 * (j))
#define XB_XSUB(j)  (1280 + 64 * (j))
#define XB_XGEN(j)  (2304 + 64 * (j))
#define XB_TOP      3328
#define XB_TOPGEN   3392
#define XCD_BAR_WORDS 3456
#define XB_SPIN_CAP (1u << 22)
__device__ __forceinline__ unsigned xb_ld(unsigned* p)              { return __hip_atomic_load(p, __ATOMIC_RELAXED, __HIP_MEMORY_SCOPE_AGENT); }
__device__ __forceinline__ unsigned xb_add(unsigned* p, unsigned v) { return __hip_atomic_fetch_add(p, v, __ATOMIC_RELAXED, __HIP_MEMORY_SCOPE_AGENT); }
__device__ __forceinline__ unsigned xb_xcc_id() { return (unsigned)__builtin_amdgcn_s_getreg((3 << 11) | 20) & 0xFu; }
#define XB_SPIN(cond, bar) do { unsigned _sp = 0; while (cond) { __builtin_amdgcn_s_sleep(1); \
    if ((++_sp & 255u) == 0u) { if (xb_ld(&(bar)[XB_TMO])) break; if (_sp > XB_SPIN_CAP) { atomicAdd(&(bar)[XB_TMO], 1u); break; } } } } while (0)
struct XcdBarrier { unsigned* bar; unsigned x; volatile LAS unsigned* st; };
__device__ __forceinline__ XcdBarrier xcd_barrier_post(unsigned* bar, volatile LAS unsigned* st) {
    XcdBarrier b; b.bar = bar; b.x = xb_xcc_id(); b.st = st;
    if (threadIdx.x == 0) (void)xb_add(&bar[XB_XCNT(b.x)], 1u);
    return b;
}
__device__ __forceinline__ void xcd_barrier_complete(unsigned* bar, unsigned x, unsigned& nloc, unsigned& nx) {
    const unsigned G = gridDim.x * gridDim.y * gridDim.z;
    unsigned sum, cnt, mine, sp = 0u;
    for (;;) {
        sum = 0u; cnt = 0u; mine = 0u;
#pragma unroll
        for (unsigned j = 0; j < 16; ++j) { const unsigned c = xb_ld(&bar[XB_XCNT(j)]); sum += c; cnt += (c > 0u) ? 1u : 0u; mine = (j == x) ? c : mine; }
        if (sum == G) break;
        __builtin_amdgcn_s_sleep(1);
        if ((++sp & 255u) == 0u) { if (xb_ld(&bar[XB_TMO])) break; if (sp > XB_SPIN_CAP) { atomicAdd(&bar[XB_TMO], 1u); break; } }
    }
    nloc = mine > 0u ? mine : 1u; nx = cnt > 0u ? cnt : 1u;
}
__device__ __forceinline__ void xcd_barrier(const XcdBarrier& b0) {
    XcdBarrier b = b0;
    asm volatile("" : "+s"(b.x));
    asm volatile("s_waitcnt vmcnt(0)" ::: "memory");
    __syncthreads();
    if (threadIdx.x == 0) {
        unsigned* bar = b.bar;
        asm volatile("" : "+s"(bar));
        __builtin_amdgcn_s_waitcnt(0);
        unsigned nloc = b.st[0], nx = b.st[1];
        if (nloc == 0u) { xcd_barrier_complete(bar, b.x, nloc, nx); b.st[0] = nloc; b.st[1] = nx; }
        const unsigned old = xb_add(&bar[XB_XSUB(b.x)], 1u);
        const unsigned gen = old / nloc;
        if (old + 1u == (gen + 1u) * nloc) {
            __builtin_amdgcn_fence(__ATOMIC_RELEASE, "agent");
            asm volatile("s_waitcnt vmcnt(0)" ::: "memory");
            const unsigned og = xb_add(&bar[XB_TOP], 1u);
            const unsigned tg = og / nx;
            if (og + 1u == (tg + 1u) * nx) xb_add(&bar[XB_TOPGEN], 1u);
            else XB_SPIN(xb_ld(&bar[XB_TOPGEN]) == tg, bar);
            __builtin_amdgcn_fence(__ATOMIC_ACQUIRE, "agent");
            xb_add(&bar[XB_XGEN(b.x)], 1u);
            asm volatile("s_waitcnt vmcnt(0)" ::: "memory");
        } else {
            XB_SPIN(xb_ld(&bar[XB_XGEN(b.x)]) == gen, bar);
            __builtin_amdgcn_fence(__ATOMIC_ACQUIRE, "agent");
            asm volatile("s_waitcnt vmcnt(0)" ::: "memory");
        }
    }
    __syncthreads();
}
constexpr int MISC_OFF = 131072 + 320;
__device__ __forceinline__ int launder_tid() { int t = threadIdx.x; asm volatile("" : "+v"(t)); return t; }
__global__ void __launch_bounds__(512, 2) hymba_fwd(Args a) {
    extern __shared__ __attribute__((aligned(16))) unsigned char lds_raw[];
    LAS unsigned char* lds = (LAS unsigned char*)lds_raw;
    const int tid = threadIdx.x, G = gridDim.x;
    unsigned char* ws = a.ws;
    float* out = a.out;
    bf16_t* P = (bf16_t*)(ws + WS_P); bf16_t* MIX = (bf16_t*)(ws + WS_MIX);
    float* UT = (float*)(ws + WS_UT); bf16_t* SPT = (bf16_t*)(ws + WS_SPT);
    unsigned* rowss = (unsigned*)(ws + WS_ROWSS);
    const float* tabB = (const float*)(ws + WS_TABB); const float* tabA = (const float*)(ws + WS_TABA);
    const int lo = a.ph_lo, hi = a.ph_hi;
    volatile LAS unsigned* MISC = (volatile LAS unsigned*)(lds + MISC_OFF);
    if (tid < 32) MISC[tid] = 0u;
    __syncthreads();
    XcdBarrier bar = xcd_barrier_post((unsigned*)ws, MISC + 8);
    if (a.ph_lo < 0) cg::this_grid().sync();
#if MK_MULTI
#define IN(k) (lo <= (k) && (k) < hi)
#else
#define IN(k) true
#endif
#define LT() launder_tid()
#define SEAM(k) do { if (IN(k) && IN((k) + 1)) { xcd_barrier(bar); } } while (0)
#ifndef SKIP_P0
    if (IN(0)) for (int rep = 0; rep < REP_P0; ++rep) { p0_prologue(a, lds, tid, G); if (rep + 1 < REP_P0) xcd_barrier(bar); }
#endif
    SEAM(0);
    for (int l = 0; l < DEPTH; ++l) {
        const int pb = 1 + 5 * l;
        const float* sinks_l = a.in[10] + 8 * l;
        bf16_t* XB = (bf16_t*)(ws + ((l & 1) ? WS_XB2 : WS_XB)); bf16_t* XBn = (bf16_t*)(ws + ((l & 1) ? WS_XB : WS_XB2));
#ifndef SKIP_P1
        if (IN(pb)) for (int rep = 0; rep < REP_P1; ++rep) {
            const int b = (int)blockIdx.x;
            unsigned* cnt = (unsigned*)(ws + 14336) + 64 * l;
            pg8::Gemm g{XB, (const bf16_t*)(ws + WS_WIN) + (size_t)l * NIN * DM, MT, NIN, DM};
            EpiIn E{P, rowss + l * MT, a.in[8] + 64 * l, a.in[9] + 64 * l, tabA, tabB,
                    out + O_KP + (size_t)l * 32768, out + O_VP + (size_t)l * 32768, out + O_KS + (size_t)l * 2097152, out + O_VS + (size_t)l * 2097152};
            {
                SampleFirstOrder S; S.S.init(MP, NIN, G, b); S.cnt = cnt;
                const bool hs = (b >= 64 && b < 90);
                S.spm = hs ? 64 + (b - 64) / 13 : -1; S.spn = hs ? (b - 64) % 13 : 0;
                pg8::gemm_phase<EpiIn, SampleFirstOrder, true, true>(lds, g, S, E, LT());
            }
            if (b >= 90) {
                if (threadIdx.x == 0) {
                    XB_SPIN(xb_ld(cnt) < 26u * (unsigned)(rep + 1), (unsigned*)ws);
                    __builtin_amdgcn_fence(__ATOMIC_ACQUIRE, "agent"); asm volatile("s_waitcnt vmcnt(0)" ::: "memory");
                }
                __syncthreads();
                const float* ck = a.in[2] + (size_t)l * 2097152; const float* cv = a.in[3] + (size_t)l * 2097152;
                float* kso = out + O_KS + (size_t)l * 2097152; float* vso = out + O_VS + (size_t)l * 2097152;
                const float* sin_l = a.in[4] + (size_t)l * 8388608; float* sout_l = out + O_SS + (size_t)l * 8388608;
                {
                    const int stride = G - 90;
                    int u = b - 90;
                    if (u < 512) {
                        SretRegs cur; sret_load(cur, P, sin_l, u, LT());
#pragma unroll 1
                        for (; u < 512; u += stride) {
                            const int nx = u + stride;
                            SretRegs nxt = cur;
                            if (nx < 512) sret_load(nxt, P, sin_l, nx, LT());
                            sret_compute(lds, cur, MIX, sout_l, u, LT());
                            cur = nxt;
                        }
                    }
#pragma unroll 1
                    for (; u < 768; u += stride) sattn_unit(lds, P, MIX, ck, cv, kso, vso, sinks_l, u - 512, LT());
                }
            }
        }
#endif
        SEAM(pb);
#ifndef SKIP_P2
        if (IN(pb + 1)) for (int rep = 0; rep < REP_P2; ++rep) {
            const int b = (int)blockIdx.x;
            UcRegs u1, u2; AttnRegs ar;
            uc_load(u1, P, b, LT());
            uc_load(u2, P, b + 256, LT());
            uc_compute(lds, u1, UT, b, LT());
            attn_load(ar, P, b, LT());
            uc_compute(lds, u2, UT, b + 256, LT());
            attn_compute(lds, ar, P, MIX, sinks_l, b, LT());
        }
#endif
        SEAM(pb + 1);
#ifndef SKIP_SCAN
        if (IN(pb + 2)) for (int rep = 0; rep < REP_P3; ++rep) {
            const bool lastl = (l == DEPTH - 1);
            sample_outproj_slice(lds, MIX, (const bf16_t*)(ws + WS_WOUT) + (size_t)l * DM * DM, l == 0 ? a.in[1] : nullptr, XB, XBn, lastl ? out : nullptr,
                                 lastl ? nullptr : (rep == 0 ? rowss + (l + 1) * MT : (unsigned*)(ws + WS_DUMMY)), (int)blockIdx.x, LT());
            scan_phase(UT, SPT, out + O_SP + (size_t)l * 131072, LT(), G);
        }
#endif
        SEAM(pb + 2);
#ifndef SKIP_RET
        if (IN(pb + 3)) for (int rep = 0; rep < REP_P4; ++rep) {
            const int u0 = (int)blockIdx.x;
            RetRegs r0, r1;
            ret_load(r0, P, SPT, u0, LT());
            ret_load(r1, P, SPT, u0 + 256, LT());
            ret_unit(lds, r0, P, SPT, MIX, u0, LT());
            ret_unit(lds, r1, P, SPT, MIX, u0 + 256, LT());
        }
#endif
        SEAM(pb + 3);
#ifndef SKIP_P5
        if (IN(pb + 4)) for (int rep = 0; rep < REP_P5; ++rep) {
            pg8::Gemm g{MIX, (const bf16_t*)(ws + WS_WOUT) + (size_t)l * DM * DM, MP, DM, DM};
            pg8::StaticOrder S; S.init(MP, DM, G, (int)blockIdx.x);
            const bool lastl = (l == DEPTH - 1);
            EpiOut E{l == 0 ? a.in[0] : nullptr, l == 0 ? a.in[1] : nullptr, lastl ? out : nullptr, XB, XBn, lastl ? nullptr : (rep == 0 ? rowss + (l + 1) * MT : (unsigned*)(ws + WS_DUMMY))};
            pg8::gemm_phase<EpiOut, pg8::StaticOrder, true, true>(lds, g, S, E, LT());
        }
#endif
        SEAM(pb + 4);
    }
#undef IN
#undef SEAM
}

extern "C" void kernel_launch(void* const* d_in, const int* in_sizes, int n_in, void* d_out, int out_size, void* d_ws, size_t ws_size, hipStream_t stream) {
    static int grid = 0;
    if (grid == 0) {
        int dev = 0, cus = 0, per_cu = 0;
        if (n_in != 11 || ws_size < WS_END) { fprintf(stderr, "kernel_launch: unexpected n_in %d / ws %zu\n", n_in, ws_size); grid = -1; return; }
        if (hipGetDevice(&dev) != hipSuccess || hipDeviceGetAttribute(&cus, hipDeviceAttributeMultiprocessorCount, dev) != hipSuccess) { grid = -1; return; }
        if (hipFuncSetAttribute((const void*)hymba_fwd, hipFuncAttributeMaxDynamicSharedMemorySize, LDS_BYTES) != hipSuccess) { fprintf(stderr, "kernel_launch: hipFuncSetAttribute failed\n"); grid = -1; return; }
        if (hipOccupancyMaxActiveBlocksPerMultiprocessor(&per_cu, (const void*)hymba_fwd, 512, LDS_BYTES) != hipSuccess || per_cu < 1) { fprintf(stderr, "kernel_launch: occupancy query says %d\n", per_cu); per_cu = 1; }
        (void)hipGetLastError();
        if (cus < 256) { fprintf(stderr, "kernel_launch: needs 256 CUs, got %d\n", cus); grid = -1; return; }
        grid = 256;
    }
    if (grid < 0) return;
    if (hipMemsetAsync(d_ws, 0, 16384, stream) != hipSuccess) { fprintf(stderr, "kernel_launch: memset failed\n"); return; }
    Args a{};
    for (int i = 0; i < 11; ++i) a.in[i] = (const float*)d_in[i];
    a.out = (float*)d_out; a.ws = (unsigned char*)d_ws;
    a.baseA = std::pow(500000.0, -1.0 / 8.0); a.baseB = std::pow(10000.0, -1.0 / 64.0);
    constexpr int NPH = 1 + 5 * DEPTH;
#if MK_MULTI
    for (int p = 0; p < NPH; ++p) { a.ph_lo = p; a.ph_hi = p + 1; hipLaunchKernelGGL(hymba_fwd, dim3(grid), dim3(512), LDS_BYTES, stream, a); }
#else
    a.ph_lo = 0; a.ph_hi = NPH;
    void* args[] = {&a};
    hipError_t e = hipLaunchCooperativeKernel((const void*)hymba_fwd, dim3(grid), dim3(512), args, LDS_BYTES, stream);
    if (e != hipSuccess) fprintf(stderr, "cooperative launch failed: %s (grid %d)\n", hipGetErrorString(e), grid);
#endif
}
```
